# Optimizing an MI355X kernel written in HIP

```python
import jax, jax.numpy as jnp
from jax import lax
import numpy as np

D_MODEL = 2048
BATCH = 2
SEQ = 8192
DEPTH = 2

GRID_W = 64
CTX_LEN = 256
N_MOD = 6
SGU_WIDTH = 1024
SGU_CHUNK = 128
SGU_GROUPS = 8
SGU_GROUP_CH = SGU_WIDTH // SGU_GROUPS
NA_HEADS = 8
HEAD_DIM = 128
NA_WIDTH = NA_HEADS * HEAD_DIM
WIN_ROWS = 8
WIN_COLS = 16
ROPE_THETA = 10000.0
ROPE_PAIRS = HEAD_DIM // 4
IN_PROJ_WIDTH = 2 * SGU_WIDTH + 3 * NA_WIDTH
N_GROUPS = 4
EXPERTS_PER_GROUP = 8
N_EXPERTS = N_GROUPS * EXPERTS_PER_GROUP
TOP_K = 2
D_EXPERT = 512
RMS_EPS = 1e-6

kernel_name = "hybrid_sgu_natten_hmoe_dit"


def rms_norm(x, w):
    xf = x.astype(jnp.float32)
    y = xf * lax.rsqrt(jnp.mean(xf * xf, axis=-1, keepdims=True) + RMS_EPS)
    return (y * w.astype(jnp.float32)).astype(x.dtype)


def modulate(h, shift, scale):
    return h * (1 + scale) + shift


def axial_rope(x):
    B, S, H, hd = x.shape
    t = jnp.arange(S, dtype=jnp.int32)
    pos = jnp.stack([t // GRID_W, t % GRID_W], axis=-1).astype(jnp.float32)
    inv_freq = ROPE_THETA ** (-jnp.arange(ROPE_PAIRS, dtype=jnp.float32) / ROPE_PAIRS)
    ang = pos[:, :, None] * inv_freq
    cos = jnp.cos(ang)[None, :, None]
    sin = jnp.sin(ang)[None, :, None]
    xf = x.astype(jnp.float32).reshape(B, S, H, 2, 2, ROPE_PAIRS)
    x1, x2 = xf[..., 0, :], xf[..., 1, :]
    out = jnp.stack([x1 * cos - x2 * sin, x2 * cos + x1 * sin], axis=-2)
    return out.reshape(B, S, H, hd).astype(x.dtype)


def sgu_branch(p, norm_w, w_s, b_s):
    B, L, _ = p.shape
    u, v = jnp.split(jax.nn.gelu(p[..., :2 * SGU_WIDTH]), 2, axis=-1)
    v = rms_norm(v, norm_w)
    vc = v.reshape(B, L // SGU_CHUNK, SGU_CHUNK, SGU_GROUPS, SGU_GROUP_CH)
    z = jnp.einsum('gnm,bkmgc->bkngc', w_s, vc) + b_s.T[None, None, :, :, None]
    return u * z.reshape(B, L, SGU_WIDTH)


def qkv_heads(p):
    B, L, _ = p.shape
    q, k, v = jnp.split(p[..., 2 * SGU_WIDTH:], 3, axis=-1)
    return (q.reshape(B, L, NA_HEADS, HEAD_DIM),
            k.reshape(B, L, NA_HEADS, HEAD_DIM),
            v.reshape(B, L, NA_HEADS, HEAD_DIM))


def neighbourhood_attention(q_rot, q_plain, k_rot, v, k_ctx, v_ctx, rpb):
    B, S, H, hd = q_rot.shape
    rows = S // GRID_W
    wr = min(WIN_ROWS, rows)
    n_loc = wr * WIN_COLS
    scale = hd ** -0.5
    qg = q_rot.reshape(B, rows, GRID_W, H, hd)
    qpg = q_plain.reshape(B, rows, GRID_W, H, hd)
    kg = k_rot.reshape(B, rows, GRID_W, H, hd)
    vg = v.reshape(B, rows, GRID_W, H, hd)
    col = jnp.arange(GRID_W, dtype=jnp.int32)
    col_start = jnp.clip(col - WIN_COLS // 2, 0, GRID_W - WIN_COLS)
    col_idx = col_start[:, None] + jnp.arange(WIN_COLS, dtype=jnp.int32)
    col_bias_idx = col_idx - col[:, None] + (WIN_COLS - 1)

    def one_row(r):
        r0 = jnp.clip(r - wr // 2, 0, rows - wr)
        k_blk = lax.dynamic_slice_in_dim(kg, r0, wr, axis=1)
        v_blk = lax.dynamic_slice_in_dim(vg, r0, wr, axis=1)
        k_win = k_blk[:, :, col_idx]
        v_win = v_blk[:, :, col_idx]
        q_r = lax.dynamic_index_in_dim(qg, r, axis=1, keepdims=False)
        qp_r = lax.dynamic_index_in_dim(qpg, r, axis=1, keepdims=False)
        row_bias_idx = r0 + jnp.arange(wr, dtype=jnp.int32) - r + (WIN_ROWS - 1)
        bias = rpb[:, row_bias_idx][:, :, col_bias_idx].transpose(0, 2, 1, 3)
        s_loc = jnp.einsum('bchd,brcwhd->bhcrw', q_r, k_win).astype(jnp.float32) * scale
        s_loc = s_loc + bias[None].astype(jnp.float32)
        s_ctx = jnp.einsum('bchd,bjhd->bhcj', qp_r, k_ctx).astype(jnp.float32) * scale
        s = jnp.concatenate([s_loc.reshape(B, H, GRID_W, n_loc), s_ctx], axis=-1)
        p = jax.nn.softmax(s, axis=-1).astype(v.dtype)
        p_loc = p[..., :n_loc].reshape(B, H, GRID_W, wr, WIN_COLS)
        p_ctx = p[..., n_loc:]
        return (jnp.einsum('bhcrw,brcwhd->bchd', p_loc, v_win)
                + jnp.einsum('bhcj,bjhd->bchd', p_ctx, v_ctx))

    out = lax.map(one_row, jnp.arange(rows, dtype=jnp.int32))
    return out.transpose(1, 0, 2, 3, 4).reshape(B, S, H * hd)


def context_attention(q, k, v):
    B, L, H, hd = q.shape
    s = jnp.einsum('bihd,bjhd->bhij', q, k).astype(jnp.float32) * (hd ** -0.5)
    p = jax.nn.softmax(s, axis=-1).astype(v.dtype)
    return jnp.einsum('bhij,bjhd->bihd', p, v).reshape(B, L, H * hd)


def merge_branches(h, a, o, w_gate, b_gate, w_a, w_b, w_o):
    g_a, g_b = jnp.split(jax.nn.sigmoid(h @ w_gate + b_gate), 2, axis=-1)
    return (g_a * (a @ w_a) + g_b * (o @ w_b)) @ w_o


def hierarchical_moe(h, w_rg, b_rg, w_re, b_re, w_gate, w_up, w_down):
    shp = h.shape
    t = h.reshape(-1, shp[-1])
    g_prob = jax.nn.softmax((t @ w_rg + b_rg).astype(jnp.float32), axis=-1)
    g_top_p, g_idx = lax.top_k(g_prob, 1)
    e_logits = (t @ w_re + b_re).astype(jnp.float32).reshape(-1, N_GROUPS, EXPERTS_PER_GROUP)
    e_in_group = jnp.take_along_axis(e_logits, g_idx[:, :, None], axis=1)[:, 0]
    e_top, e_idx = lax.top_k(e_in_group, TOP_K)
    e_w = jax.nn.softmax(e_top, axis=-1) * g_top_p
    expert_id = g_idx * EXPERTS_PER_GROUP + e_idx
    combine = jnp.sum(jax.nn.one_hot(expert_id, N_EXPERTS, dtype=jnp.float32) * e_w[..., None],
                      axis=1).astype(t.dtype)
    y = jnp.zeros_like(t)
    for e in range(N_EXPERTS):
        hid = jax.nn.silu(t @ w_gate[e]) * (t @ w_up[e])
        y = y + combine[:, e:e + 1] * (hid @ w_down[e])
    return y.reshape(shp)


def setup_inputs(seed: int = 0) -> dict:
    key = jax.random.key(seed)
    ks = jax.random.split(key, 26)
    L, D = DEPTH, D_MODEL
    f32 = jnp.float32

    def nrm(k, shape, fan_in, gain=1.0):
        return jax.random.normal(k, shape, f32) * (gain * fan_in ** -0.5)

    def small(k, shape, s):
        return jax.random.normal(k, shape, f32) * s

    def gains(k, shape):
        return 1.0 + 0.05 * jax.random.normal(k, shape, f32)

    return {
        "x": jax.random.normal(ks[0], (BATCH, SEQ, D), f32),
        "c": jax.random.normal(ks[1], (BATCH, D), f32),
        "ctx": jax.random.normal(ks[2], (BATCH, CTX_LEN, D), f32),
        "c_ctx": jax.random.normal(ks[3], (D,), f32),
        "w_ada": nrm(ks[4], (L, D, N_MOD * D), D),
        "b_ada": small(ks[5], (L, N_MOD * D), 0.02),
        "norm_mix_w": gains(ks[6], (L, D)),
        "norm_ffn_w": gains(ks[7], (L, D)),
        "w_in": nrm(ks[8], (L, D, IN_PROJ_WIDTH), D),
        "sgu_norm_w": gains(ks[9], (L, SGU_WIDTH)),
        "sgu_w_s": nrm(ks[10], (L, SGU_GROUPS, SGU_CHUNK, SGU_CHUNK), SGU_CHUNK, 0.5),
        "sgu_b_s": gains(ks[11], (L, SGU_GROUPS, SGU_CHUNK)),
        "na_rpb": small(ks[12], (L, NA_HEADS, 2 * WIN_ROWS - 1, 2 * WIN_COLS - 1), 0.02),
        "w_merge_gate": nrm(ks[13], (L, D, 2 * D), D),
        "b_merge_gate": small(ks[14], (L, 2 * D), 0.02),
        "w_branch_a": nrm(ks[15], (L, SGU_WIDTH, D), SGU_WIDTH),
        "w_branch_b": nrm(ks[16], (L, NA_WIDTH, D), NA_WIDTH),
        "w_out": nrm(ks[17], (L, D, D), D),
        "w_router_group": nrm(ks[18], (L, D, N_GROUPS), D),
        "b_router_group": small(ks[19], (L, N_GROUPS), 0.01),
        "w_router_expert": nrm(ks[20], (L, D, N_EXPERTS), D),
        "b_router_expert": small(ks[21], (L, N_EXPERTS), 0.01),
        "w_exp_gate": nrm(ks[22], (L, N_EXPERTS, D, D_EXPERT), D),
        "w_exp_up": nrm(ks[23], (L, N_EXPERTS, D, D_EXPERT), D),
        "w_exp_down": nrm(ks[24], (L, N_EXPERTS, D_EXPERT, D), D_EXPERT),
        "final_norm_w": gains(ks[25], (D,)),
    }


def reference(x, c, ctx, c_ctx, w_ada, b_ada, norm_mix_w, norm_ffn_w, w_in, sgu_norm_w, sgu_w_s,
              sgu_b_s, na_rpb, w_merge_gate, b_merge_gate, w_branch_a, w_branch_b, w_out,
              w_router_group, b_router_group, w_router_expert, b_router_expert,
              w_exp_gate, w_exp_up, w_exp_down, final_norm_w):
    B = x.shape[0]
    for l in range(DEPTH):
        mod_x = (jax.nn.silu(c) @ w_ada[l] + b_ada[l]).reshape(B, N_MOD, D_MODEL)[:, :, None, :]
        mod_c = (jax.nn.silu(c_ctx) @ w_ada[l] + b_ada[l]).reshape(N_MOD, D_MODEL)

        hx = modulate(rms_norm(x, norm_mix_w[l]), mod_x[:, 0], mod_x[:, 1])
        hc = modulate(rms_norm(ctx, norm_mix_w[l]), mod_c[0], mod_c[1])
        px = hx @ w_in[l]
        pc = hc @ w_in[l]
        qx, kx, vx = qkv_heads(px)
        qc, kc, vc = qkv_heads(pc)
        a_x = sgu_branch(px, sgu_norm_w[l], sgu_w_s[l], sgu_b_s[l])
        o_x = neighbourhood_attention(axial_rope(qx), qx, axial_rope(kx), vx, kc, vc, na_rpb[l])
        x = x + mod_x[:, 2] * merge_branches(hx, a_x, o_x, w_merge_gate[l], b_merge_gate[l],
                                             w_branch_a[l], w_branch_b[l], w_out[l])
        hx = modulate(rms_norm(x, norm_ffn_w[l]), mod_x[:, 3], mod_x[:, 4])
        x = x + mod_x[:, 5] * hierarchical_moe(hx, w_router_group[l], b_router_group[l],
                                               w_router_expert[l], b_router_expert[l],
                                               w_exp_gate[l], w_exp_up[l], w_exp_down[l])

        if l < DEPTH - 1:
            a_c = sgu_branch(pc, sgu_norm_w[l], sgu_w_s[l], sgu_b_s[l])
            o_c = context_attention(qc, kc, vc)
            ctx = ctx + mod_c[2] * merge_branches(hc, a_c, o_c, w_merge_gate[l], b_merge_gate[l],
                                                  w_branch_a[l], w_branch_b[l], w_out[l])
            hc = modulate(rms_norm(ctx, norm_ffn_w[l]), mod_c[3], mod_c[4])
            ctx = ctx + mod_c[5] * hierarchical_moe(hc, w_router_group[l], b_router_group[l],
                                                    w_router_expert[l], b_router_expert[l],
                                                    w_exp_gate[l], w_exp_up[l], w_exp_down[l])
    return rms_norm(x, final_norm_w)
```

```cpp
#include <hip/hip_runtime.h>
#include <cstdio>
#include <cstdint>

#ifndef MK_PER_PHASE
#define MK_PER_PHASE 0
#endif
#ifndef MK_I8GATE
#define MK_I8GATE 1
#endif
#ifndef MK_I8IN
#define MK_I8E 3
#define MK_I8O 3
#define I8SEL(mask, l) ((mask) == 3 ? true : ((mask) == 0 ? false : ((((mask) >> (l)) & 1) != 0)))
#define MK_I8M 3
#define MK_I8D 3
#define MK_I8IN 1
#endif
#ifndef MK_DUP
#define MK_DUP 0
#endif
#define DUPN(k) (1 + ((MK_DUP >> (k)) & 1))
#ifndef MK_BUILD
#define MK_BUILD 0xFFFF
#endif
#ifndef MK_MASK
#define MK_MASK 15
#endif

#define LAS __attribute__((address_space(3)))
typedef unsigned short bf16_t;
typedef short bf16x8 __attribute__((ext_vector_type(8)));
typedef short s16x4 __attribute__((ext_vector_type(4)));
typedef float f32x4 __attribute__((ext_vector_type(4)));
typedef float f32x2 __attribute__((ext_vector_type(2)));
typedef unsigned u32x4 __attribute__((ext_vector_type(4)));
typedef unsigned u32x2 __attribute__((ext_vector_type(2)));

constexpr int D = 2048, SEQ = 8192, GRID_W = 64, GROWS = 128, CTXL = 256;
constexpr int MLAT = 16384, MCTX = 512, MALL = 16896;
constexpr int SGUW = 1024, NH = 8, HDIM = 128, INW = 5120, GATEW = 4096, NCOMB = 9216;
constexpr int NEXP = 32, DEXP = 512, SLOTS = 41984;
constexpr float RMS_EPS = 1e-6f;
constexpr int NWAVES = 8, NTHR = 512;
#ifndef CQ_SET
#define CQ_SET 0
#endif
#if CQ_SET == 0
constexpr int CQ_A0 = 7500, CQ_C1A = 0, CQ_C1B = 22500, CQ_C2 = 38500, CQ_E0 = 43500, CQ_F0 = 45500, CQ_A1 = 55808;
#elif CQ_SET == 1
constexpr int CQ_A0 = 7000, CQ_C1A = 10000, CQ_C1B = 13000, CQ_C2 = 24576, CQ_E0 = 30000, CQ_F0 = 32000, CQ_A1 = 42000;
#else
constexpr int CQ_A0 = 13000, CQ_C1A = 19000, CQ_C1B = 25000, CQ_C2 = 39000, CQ_E0 = 49000, CQ_F0 = 53000, CQ_A1 = 55808;
#endif

constexpr size_t MiB = 1u << 20;
constexpr size_t WS_CTL = 0, CTL_BYTES = 1 * MiB;
constexpr size_t WS_WC = 1 * MiB;
constexpr size_t WS_WA = WS_WC + 36 * MiB;
constexpr size_t WS_WB = WS_WA + 4 * MiB;
constexpr size_t WS_WO = WS_WB + 4 * MiB;
constexpr size_t WS_WGU = WS_WO + 8 * MiB;
constexpr size_t WS_WD = WS_WGU + 128 * MiB;
constexpr size_t WS_WR = WS_WD + 64 * MiB;
constexpr size_t WSET_BYTES = 245 * MiB;
constexpr size_t WS_XS = WS_WR + 1 * MiB + WSET_BYTES;
constexpr size_t WS_HX = WS_XS + 132 * MiB;
constexpr size_t WS_P = WS_HX + 66 * MiB;
constexpr size_t WS_G = WS_P + 165 * MiB;
constexpr size_t WS_A = WS_G + 132 * MiB;
constexpr size_t WS_O = WS_A + 33 * MiB;
constexpr size_t WS_T = WS_O + 33 * MiB;
constexpr size_t WS_HID = WS_T + 66 * MiB;
constexpr size_t WS_ROUTE = WS_HID + 41 * MiB;
constexpr size_t WS_ROPE = WS_ROUTE + 2 * MiB;
constexpr size_t WS_HX8 = WS_ROPE + 1 * MiB;
constexpr size_t WS_SX = WS_HX8 + 33 * MiB;
constexpr size_t WS_END = WS_SX + 1 * MiB;
constexpr int CW_BAR = 4096;
constexpr int CW_CNT = 8192;
constexpr int CW_PDONE = 12288;
constexpr int CW_EMAX = 12288 + 512;
constexpr float GMAX_MARGIN = 1.1f;
constexpr float EMAX_MARGIN = 1.2f;
constexpr int CW_DMAX = 12288 + 640;
constexpr int CW_PD8 = 12288 + 1280;
constexpr int CW_GMAX = 12288 + 256;
constexpr int CW_QB = 12288 + 128;
constexpr size_t CTL_MOD = 65536;
constexpr size_t RT_E = 0, RT_W = RT_E + 2 * MALL * 4, RT_P = RT_W + 2 * MALL * 4, RT_TS = RT_P + 2 * MALL * 4, RT_WS = RT_TS + SLOTS * 4;
static_assert(RT_WS + SLOTS * 4 <= 2 * MiB, "route map");

constexpr int RING_BYTES = 131072;
constexpr int LDSCTL_OFF = 139264;
constexpr int LDS_TP = LDSCTL_OFF + 0;
constexpr int LDS_MISC = LDSCTL_OFF + 256;
constexpr int LDS_LCNT = LDSCTL_OFF + 512;
constexpr int LDS_BYTES = 147456;

#define LDS_WAIT() asm volatile("s_waitcnt lgkmcnt(0)" ::: "memory")
#define VM_WAIT() asm volatile("s_waitcnt vmcnt(0)" ::: "memory")
__device__ __forceinline__ unsigned cvt_pk_bf16(float lo, float hi) { unsigned r; asm volatile("v_cvt_pk_bf16_f32 %0, %1, %2" : "=v"(r) : "v"(lo), "v"(hi)); return r; }
__device__ __forceinline__ float bflo(unsigned w) { return __uint_as_float(w << 16); }
__device__ __forceinline__ float bfhi(unsigned w) { return __uint_as_float(w & 0xffff0000u); }
__device__ __forceinline__ float wave_sum(float v) {
#pragma unroll
    for (int o = 1; o < 64; o <<= 1) v += __shfl_xor(v, o);
    return v;
}
__device__ __forceinline__ float fast_sigmoid(float x) { return __builtin_amdgcn_rcpf(1.0f + __builtin_amdgcn_exp2f(-1.44269504f * x)); }
__device__ __forceinline__ float gelu_tanh(float x) { const float u = 0.7978845608f * (x + 0.044715f * x * x * x); return x * fast_sigmoid(2.0f * u); }
__device__ __forceinline__ float silu_f(float x) { return x * fast_sigmoid(x); }
__device__ __forceinline__ unsigned offb(unsigned row, unsigned ch) { return 256u * row + 16u * (ch ^ (((row & 3u) << 2) | ((row >> 2) & 3u))); }
__device__ __forceinline__ bf16x8 tr_frag(unsigned tile_base, unsigned rowbase, unsigned c, unsigned lane) {
    const unsigned g = lane >> 4, q = (lane & 15u) >> 2, p = lane & 3u;
    const unsigned a0 = tile_base + offb(rowbase + 8u * g + q, 2u * c + (p >> 1)) + 8u * (p & 1u);
    const unsigned a1 = tile_base + offb(rowbase + 8u * g + 4u + q, 2u * c + (p >> 1)) + 8u * (p & 1u);
    s16x4 r0, r1;
    asm volatile("ds_read_b64_tr_b16 %0, %2\n\tds_read_b64_tr_b16 %1, %3\n\ts_waitcnt lgkmcnt(0)" : "=&v"(r0), "=&v"(r1) : "v"(a0), "v"(a1) : "memory");
    bf16x8 f; f[0] = r0[0]; f[1] = r0[1]; f[2] = r0[2]; f[3] = r0[3]; f[4] = r1[0]; f[5] = r1[1]; f[6] = r1[2]; f[7] = r1[3];
    return f;
}

#define XB_TMO      128
#define XB_XCNT(j)  (256  + 64 * (j))
#define XB_XSUB(j)  (1280 + 64 * (j))
#define XB_XGEN(j)  (2304 + 64 * (j))
#define XB_TOP      3328
#define XB_TOPGEN   3392
#define XCD_BAR_WORDS 3456
#define XB_SPIN_CAP (1u << 24)

__device__ __forceinline__ unsigned xb_ld(unsigned* p)              { return __hip_atomic_load(p, __ATOMIC_RELAXED, __HIP_MEMORY_SCOPE_AGENT); }
__device__ __forceinline__ unsigned xb_add(unsigned* p, unsigned v) { return __hip_atomic_fetch_add(p, v, __ATOMIC_RELAXED, __HIP_MEMORY_SCOPE_AGENT); }
__device__ __forceinline__ unsigned xb_xcc_id() { return (unsigned)__builtin_amdgcn_s_getreg((3 << 11) | 20) & 0xFu; }
#define XB_SPIN(cond, bar) do { unsigned _sp = 0; while (cond) { __builtin_amdgcn_s_sleep(1); \
    if ((++_sp & 255u) == 0u) { if (xb_ld(&(bar)[XB_TMO])) break; if (_sp > XB_SPIN_CAP) { atomicAdd(&(bar)[XB_TMO], 1u); break; } } } } while (0)

struct XcdBarrier {
    unsigned* bar; unsigned x;
    volatile LAS unsigned* st;
};

__device__ __forceinline__ XcdBarrier xcd_barrier_post(unsigned* bar, volatile LAS unsigned* st) {
    XcdBarrier b; b.bar = bar; b.x = xb_xcc_id(); b.st = st;
    if (threadIdx.x == 0) (void)xb_add(&bar[XB_XCNT(b.x)], 1u);
    return b;
}
__device__ __forceinline__ void xcd_barrier_complete(unsigned* bar, unsigned x, unsigned& nloc, unsigned& nx) {
    const unsigned G = gridDim.x * gridDim.y * gridDim.z;
    unsigned sum, cnt, mine, sp = 0u;
    for (;;) {
        sum = 0u; cnt = 0u; mine = 0u;
#pragma unroll
        for (unsigned j = 0; j < 16; ++j) { const unsigned c = xb_ld(&bar[XB_XCNT(j)]); sum += c; cnt += (c > 0u) ? 1u : 0u; mine = (j == x) ? c : mine; }
        if (sum == G) break;
        __builtin_amdgcn_s_sleep(1);
        if ((++sp & 255u) == 0u) { if (xb_ld(&bar[XB_TMO])) break; if (sp > XB_SPIN_CAP) { atomicAdd(&bar[XB_TMO], 1u); break; } }
    }
    nloc = mine > 0u ? mine : 1u; nx = cnt > 0u ? cnt : 1u;
}

__device__ __forceinline__ void xcd_barrier(const XcdBarrier& b) {
    asm volatile("s_waitcnt vmcnt(0)" ::: "memory");
    __syncthreads();
    if (threadIdx.x == 0) {
        unsigned* bar = b.bar;
        __builtin_amdgcn_s_waitcnt(0);
        unsigned nloc = b.st[0], nx = b.st[1];
        if (nloc == 0u) { xcd_barrier_complete(bar, b.x, nloc, nx); b.st[0] = nloc; b.st[1] = nx; }
        const unsigned old = xb_add(&bar[XB_XSUB(b.x)], 1u);
        const unsigned gen = old / nloc;
        if (old + 1u == (gen + 1u) * nloc) {
            __builtin_amdgcn_fence(__ATOMIC_RELEASE, "agent");
            asm volatile("s_waitcnt vmcnt(0)" ::: "memory");
            const unsigned og = xb_add(&bar[XB_TOP], 1u);
            const unsigned tg = og / nx;
            if (og + 1u == (tg + 1u) * nx) xb_add(&bar[XB_TOPGEN], 1u);
            else XB_SPIN(xb_ld(&bar[XB_TOPGEN]) == tg, bar);
            __builtin_amdgcn_fence(__ATOMIC_ACQUIRE, "agent");
            xb_add(&bar[XB_XGEN(b.x)], 1u);
            asm volatile("s_waitcnt vmcnt(0)" ::: "memory");
        } else {
            XB_SPIN(xb_ld(&bar[XB_XGEN(b.x)]) == gen, bar);
            __builtin_amdgcn_fence(__ATOMIC_ACQUIRE, "agent");
            asm volatile("s_waitcnt vmcnt(0)" ::: "memory");
        }
    }
    __syncthreads();
}

namespace pg8 {
constexpr int BM = 256, BK = 64, HALF = 128, HTB = HALF * BK * 2, STAGE_BYTES = 8 * HTB, NXCD = 8, WGM = 8;
__host__ __device__ __forceinline__ int lds_byte(int r, int c) { const int st = (r >> 4) * 2 + (c >> 5), rr = r & 15, cc = c & 31, ob = rr * 64 + cc * 2; return st * 1024 + (ob ^ (((ob >> 9) & 1) << 5)); }
__host__ __device__ __forceinline__ void stage_rc(int b, int& R, int& C) { const int st = b / 1024, sb = b % 1024, swz = sb ^ (((sb >> 9) & 1) << 5); R = (st >> 1) * 16 + swz / 64; C = (st & 1) * 32 + (swz % 64) / 2; }
__host__ __device__ __forceinline__ int perm32(int rho) { const int n = rho >> 4, i = rho & 15; return 8 * (i >> 2) + 4 * n + (i & 3); }

struct Unit { int pm, pn, e; };
struct Gemm { const bf16_t* A; int lda; const bf16_t* Bt; size_t bstride; int K; };

__device__ __forceinline__ int xcd_remap(int wgid, int nwg) { const int q = nwg / NXCD, r = nwg % NXCD, xcd = wgid % NXCD, off = wgid / NXCD; return (xcd < r ? xcd * (q + 1) : r * (q + 1) + (xcd - r) * q) + off; }
struct StaticOrder {
    int nM, nN, nwg, G, c;
    __device__ __forceinline__ void init(int M, int N, int G_, int c_) { nM = M / BM; nN = N / BM; nwg = nM * nN; G = G_; c = c_; }
    __device__ __forceinline__ bool next(int i, Unit& u) const {
        const long L = (long)i * G + c; if (L >= nwg) return false;
        const int wgid = xcd_remap((int)L, nwg);
        const int nig = WGM * nN, gid = wgid / nig, fm = gid * WGM, gsz = (nM - fm) < WGM ? (nM - fm) : WGM;
        u.pm = fm + ((wgid % nig) % gsz); u.pn = (wgid % nig) / gsz; u.e = 0; return true;
    }
};
struct SplitOrder {
    int nM, nN1, nN2, nwg1, nwg2, G, c;
    __device__ __forceinline__ void init(int M, int N1, int N2, int G_, int c_) { nM = M / BM; nN1 = N1 / BM; nN2 = N2 / BM; nwg1 = nM * nN1; nwg2 = nM * nN2; G = G_; c = c_; }
    __device__ __forceinline__ void map(int L, int nwg, int nN, Unit& u) const {
        const int wgid = xcd_remap(L, nwg);
        const int nig = WGM * nN, gid = wgid / nig, fm = gid * WGM, gsz = (nM - fm) < WGM ? (nM - fm) : WGM;
        u.pm = fm + ((wgid % nig) % gsz); u.pn = (wgid % nig) / gsz; u.e = 0; }
    __device__ __forceinline__ bool next(int i, Unit& u) const {
        const long L = (long)i * G + c; if (L >= nwg1 + nwg2) return false;
        if (L < nwg1) map((int)L, nwg1, nN1, u); else { map((int)L - nwg1, nwg2, nN2, u); u.pn += nN1; }
        return true;
    }
};
struct GroupedOrder {
    const LAS int* tp; int nN, nwg, G, c;
    __device__ __forceinline__ void init(const LAS int* tp_, int N, int G_, int c_) { tp = tp_; nN = N / BM; nwg = tp_[32] * nN; G = G_; c = c_; }
    __device__ __forceinline__ bool next(int i, Unit& u) const {
        const long L = (long)i * G + c; if (L >= nwg) return false;
        const int wgid = xcd_remap((int)L, nwg);
        const int mt = wgid / nN; u.pm = mt; u.pn = wgid % nN;
        int e = 0;
        for (int j = 1; j < 32; ++j) e += (tp[j] <= mt) ? 1 : 0;
        u.e = e; return true;
    }
};

typedef int i32x4v __attribute__((ext_vector_type(4)));
template <class Epi, class Sched, bool GATHER = false, bool INT8 = false>
__device__ __forceinline__ void gemm_phase(LAS unsigned char* lds, const Gemm g, const Sched& S, const Epi& E, const int* rowmap = nullptr) {
    int tid_ = threadIdx.x; asm volatile("" : "+v"(tid_));
    const int tid = tid_, wid = __builtin_amdgcn_readfirstlane(tid >> 6), lane = tid & 63, wr = wid >> 2, wc = wid & 3, fr = lane & 15, fq = lane >> 4;
    const int K = g.K, nt = K / BK, lda = g.lda;
    unsigned voffA[2], voffB[2];
#pragma unroll
    for (int i = 0; i < 2; ++i) { int R, C; stage_rc(tid * 16 + i * 8192, R, C); const int Rb = Epi::PERM ? ((R & ~31) + perm32(R & 31)) : R;
        voffA[i] = (unsigned)(R * lda + C) * 2u; voffB[i] = (unsigned)(Rb * K + C) * 2u; }
    const size_t kstep = (size_t)(BK * 2);
    const size_t hstepA = GATHER ? (size_t)0 : (size_t)HALF * lda * 2, tstepA = 2 * hstepA;
    unsigned gcur[2][2], gnxt[2][2];
    auto gather_offs = [&](int pm, unsigned (&o)[2][2]) {
#pragma unroll
        for (int h = 0; h < 2; ++h)
#pragma unroll
            for (int i = 0; i < 2; ++i) { int R, C; stage_rc(tid * 16 + i * 8192, R, C); const int ts = rowmap[256 * pm + 128 * h + R]; const int row = ts < 0 ? 0 : (ts >> 1);
                o[h][i] = (unsigned)(row * lda + C) * 2u; }
    };
    const size_t hstepB = (size_t)HALF * K * 2, tstepB = 2 * hstepB;
    const unsigned ldsw = (unsigned)wid * 1024u;
    const int aoff = lds_byte(wr * 64 + fr, fq * 8), boff = lds_byte(wc * 32 + fr, fq * 8);
#define PG8_SA(b, h) (((b) * 2 + (h)) * HTB)
#define PG8_SB(b, h) ((4 + (b) * 2 + (h)) * HTB)
#define PG8_STAGE(bufoff, gbase, voff) do { _Pragma("unroll") for (int _i = 0; _i < 2; ++_i) \
        __builtin_amdgcn_global_load_lds((const unsigned*)((const char*)(gbase) + (voff)[_i]), (LAS unsigned*)(lds + (bufoff) + ldsw + _i * 8192), 16, 0, 0); } while (0)
#define PG8_LDA(dst, b, h) do { _Pragma("unroll") for (int m = 0; m < 4; ++m) _Pragma("unroll") for (int k = 0; k < 2; ++k) dst[m][k] = *(const LAS bf16x8*)(lds + PG8_SA(b, h) + aoff + m * 2048 + k * 1024); } while (0)
#define PG8_LDB(dst, b, h) do { _Pragma("unroll") for (int n = 0; n < 2; ++n) _Pragma("unroll") for (int k = 0; k < 2; ++k) dst[n][k] = *(const LAS bf16x8*)(lds + PG8_SB(b, h) + boff + n * 2048 + k * 1024); } while (0)
#define PG8_MMA(ai, bj, At, Bt) do { __builtin_amdgcn_s_setprio(1); _Pragma("unroll") for (int m = 0; m < 4; ++m) _Pragma("unroll") for (int n = 0; n < 2; ++n) _Pragma("unroll") for (int k = 0; k < 2; ++k) { \
        if constexpr (INT8) acc[ai][bj][m][n] = __builtin_bit_cast(f32x4, __builtin_amdgcn_mfma_i32_16x16x64_i8(__builtin_bit_cast(i32x4v, Bt[n][k]), __builtin_bit_cast(i32x4v, At[m][k]), __builtin_bit_cast(i32x4v, acc[ai][bj][m][n]), 0, 0, 0)); \
        else acc[ai][bj][m][n] = __builtin_amdgcn_mfma_f32_16x16x32_bf16(Bt[n][k], At[m][k], acc[ai][bj][m][n], 0, 0, 0); } __builtin_amdgcn_s_setprio(0); } while (0)
#define PG8_WAIT_V(n) asm volatile("s_waitcnt vmcnt(" #n ")" ::: "memory")
#define PG8_WAIT_L(n) asm volatile("s_waitcnt lgkmcnt(" #n ")" ::: "memory")
#define PG8_BAR __builtin_amdgcn_s_barrier()
#define PG8_SCHED __builtin_amdgcn_sched_barrier(0)
    Unit cur, nxt; int ui = 0; bool pend = false;
    if (!S.next(0, cur)) return;
    f32x4 acc[2][2][4][2];
#pragma unroll
    for (int a = 0; a < 2; ++a)
#pragma unroll
        for (int b = 0; b < 2; ++b)
#pragma unroll
            for (int m = 0; m < 4; ++m)
#pragma unroll
                for (int n = 0; n < 2; ++n) acc[a][b][m][n] = (f32x4){0.f, 0.f, 0.f, 0.f};
    bf16x8 At[4][2], B0[2][2], B1[2][2];
    const char* cA = (const char*)g.A + (size_t)cur.pm * tstepA; const char* cB = (const char*)g.Bt + (size_t)cur.e * g.bstride * 2 + (size_t)cur.pn * tstepB;
    if constexpr (GATHER) gather_offs(cur.pm, gcur);
#define PG8_OC(h) (GATHER ? gcur[h] : voffA)
    PG8_STAGE(PG8_SB(0, 0), cB, voffB); PG8_STAGE(PG8_SB(0, 1), cB + hstepB, voffB); PG8_STAGE(PG8_SA(0, 0), cA, PG8_OC(0)); PG8_STAGE(PG8_SA(0, 1), cA + hstepA, PG8_OC(1));
    if (wr == 1) PG8_BAR;
    PG8_WAIT_V(2); PG8_BAR;
    PG8_STAGE(PG8_SB(1, 0), cB + kstep, voffB); PG8_STAGE(PG8_SA(1, 0), cA + kstep, PG8_OC(0)); PG8_STAGE(PG8_SB(1, 1), cB + hstepB + kstep, voffB);
    PG8_WAIT_V(6); PG8_BAR;
    for (;;) {
        const bool has_next = S.next(ui + 1, nxt);
        const char* nA = has_next ? (const char*)g.A + (size_t)nxt.pm * tstepA : cA;
        const char* nB = has_next ? (const char*)g.Bt + (size_t)nxt.e * g.bstride * 2 + (size_t)nxt.pn * tstepB : cB;
        if constexpr (GATHER) { if (has_next) gather_offs(nxt.pm, gnxt); else {
#pragma unroll
            for (int h = 0; h < 2; ++h)
#pragma unroll
                for (int i = 0; i < 2; ++i) gnxt[h][i] = gcur[h][i]; } }
        for (int t = 0; t < nt; t += 2) {
            if constexpr (Epi::MID) { if (t == nt / 2) E.mid(acc, cur, wr, wc, fr, fq); }
            const bool last = (t == nt - 2);
            const char* a1 = cA + (size_t)(t + 1) * kstep;
            const char* a2 = last ? nA : cA + (size_t)(t + 2) * kstep; const char* b2 = last ? nB : cB + (size_t)(t + 2) * kstep;
            const char* a3 = a2 + kstep; const char* b3 = b2 + kstep;
            unsigned osel[2][2];
#pragma unroll
            for (int h = 0; h < 2; ++h)
#pragma unroll
                for (int i = 0; i < 2; ++i) osel[h][i] = GATHER ? (last ? gnxt[h][i] : gcur[h][i]) : voffA[i];
            PG8_LDB(B0, 0, 0); PG8_LDB(B1, 0, 1); PG8_SCHED; PG8_LDA(At, 0, 0); PG8_STAGE(PG8_SA(1, 1), a1 + hstepA, PG8_OC(1));
            PG8_WAIT_V(8); PG8_WAIT_L(0); PG8_BAR; PG8_MMA(0, 0, At, B0); PG8_MMA(0, 1, At, B1); PG8_BAR; PG8_SCHED;
            PG8_LDA(At, 0, 1); PG8_STAGE(PG8_SB(0, 0), b2, voffB); PG8_STAGE(PG8_SB(0, 1), b2 + hstepB, voffB); PG8_STAGE(PG8_SA(0, 0), a2, osel[0]);
            PG8_WAIT_V(8); PG8_WAIT_L(0); PG8_BAR; PG8_MMA(1, 0, At, B0); PG8_MMA(1, 1, At, B1); PG8_BAR; PG8_SCHED;
            PG8_LDB(B0, 1, 0); PG8_LDB(B1, 1, 1); PG8_SCHED; PG8_LDA(At, 1, 0); PG8_STAGE(PG8_SA(0, 1), a2 + hstepA, osel[1]);
            PG8_WAIT_V(8); PG8_WAIT_L(0); PG8_BAR; PG8_MMA(0, 0, At, B0); PG8_MMA(0, 1, At, B1); PG8_BAR; PG8_SCHED;
            PG8_LDA(At, 1, 1); PG8_STAGE(PG8_SB(1, 0), b3, voffB); PG8_STAGE(PG8_SB(1, 1), b3 + hstepB, voffB); PG8_STAGE(PG8_SA(1, 0), a3, osel[0]);
            PG8_WAIT_V(8); PG8_WAIT_L(0); PG8_BAR; PG8_MMA(1, 0, At, B0); PG8_MMA(1, 1, At, B1); PG8_BAR; PG8_SCHED;
        }
        if (wr == 0) PG8_BAR;
        if constexpr (Epi::SIGNAL) { if (pend) E.signal(lane); }
        E(acc, cur, wr, wc, fr, fq);
        if constexpr (Epi::SIGNAL) pend = E.wants(cur);
        if (!has_next) break;
#pragma unroll
        for (int a = 0; a < 2; ++a)
#pragma unroll
            for (int b = 0; b < 2; ++b)
#pragma unroll
                for (int m = 0; m < 4; ++m)
#pragma unroll
                    for (int n = 0; n < 2; ++n) acc[a][b][m][n] = (f32x4){0.f, 0.f, 0.f, 0.f};
        cur = nxt; cA = nA; cB = nB; ++ui;
        if constexpr (GATHER) {
#pragma unroll
            for (int h = 0; h < 2; ++h)
#pragma unroll
                for (int i = 0; i < 2; ++i) gcur[h][i] = gnxt[h][i]; }
        if (wr == 1) PG8_BAR;
    }
    PG8_WAIT_V(0);
    if constexpr (Epi::SIGNAL) { if (pend) E.signal(lane); }
    PG8_BAR;
#undef PG8_OC
#undef PG8_SA
#undef PG8_SB
#undef PG8_STAGE
#undef PG8_LDA
#undef PG8_LDB
#undef PG8_MMA
#undef PG8_WAIT_V
#undef PG8_WAIT_L
#undef PG8_BAR
#undef PG8_SCHED
}

__device__ __forceinline__ u32x4 pack8(const f32x4 v0, const f32x4 v1) { u32x4 w; w.x = cvt_pk_bf16(v0[0], v0[1]); w.y = cvt_pk_bf16(v0[2], v0[3]); w.z = cvt_pk_bf16(v1[0], v1[1]); w.w = cvt_pk_bf16(v1[2], v1[3]); return w; }
__device__ __forceinline__ void unpack8(const u32x4 w, f32x4& v0, f32x4& v1) { v0 = (f32x4){bflo(w.x), bfhi(w.x), bflo(w.y), bfhi(w.y)}; v1 = (f32x4){bflo(w.z), bfhi(w.z), bflo(w.w), bfhi(w.w)}; }

struct EpiInProj {
    static constexpr bool PERM = true, MID = false, SIGNAL = true;
    bf16_t* P; bf16_t* G; const float* bgate; const f32x2* rope; unsigned* pdone; const float* sx; float sw;
    __device__ __forceinline__ void stP(const __amdgpu_buffer_rsrc_t rs, size_t elem, const u32x4 v) const { __builtin_amdgcn_raw_buffer_store_b128(v, rs, (unsigned)(elem * 2), 0, 16); }
    __device__ __forceinline__ bool wants(const Unit& u) const { return u.pn < 20; }
    __device__ __forceinline__ void signal(int lane) const { if (lane == 0) { const int w_ = __builtin_amdgcn_readfirstlane((int)(threadIdx.x >> 6)); __hip_atomic_fetch_add(pdone + 16 * w_, 1u, __ATOMIC_RELAXED, __HIP_MEMORY_SCOPE_AGENT); } }
    __device__ __forceinline__ void operator()(const f32x4 (&acc)[2][2][4][2], const Unit& u, int wr, int wc, int fr, int fq) const {
        const int row0 = u.pm * BM + wr * 64 + fr, colt = u.pn * BM + wc * 32 + 8 * fq;
        const int mode = (u.pn < 8) ? 0 : (u.pn < 12 ? 1 : (u.pn < 16 ? 3 : (u.pn < 20 ? 1 : 2)));
        const __amdgpu_buffer_rsrc_t prs = __builtin_amdgcn_make_buffer_rsrc(P, 0, (unsigned)((size_t)MALL * INW * 2), 0x00020000);
        float scv[2][4];
#pragma unroll
        for (int ai = 0; ai < 2; ++ai)
#pragma unroll
            for (int m = 0; m < 4; ++m) scv[ai][m] = sx ? sx[row0 + ai * HALF + m * 16] * sw : 0.f;
        asm volatile("" ::: "memory");
        if (mode == 3) {
            const int hh = wc >> 1, ax = wc & 1, c1 = u.pn * BM + 128 * hh + 64 * ax + 8 * fq;
#pragma unroll
            for (int ai = 0; ai < 2; ++ai)
#pragma unroll
                for (int m = 0; m < 4; ++m) {
                    const int row = row0 + ai * HALF + m * 16;
                    f32x4 x1a = acc[ai][0][m][0], x1b = acc[ai][0][m][1], x2a = acc[ai][1][m][0], x2b = acc[ai][1][m][1];
                    if (sx) { const float sc = scv[ai][m];
#pragma unroll
                        for (int j = 0; j < 4; ++j) { x1a[j] = (float)__float_as_int(x1a[j]) * sc; x1b[j] = (float)__float_as_int(x1b[j]) * sc; x2a[j] = (float)__float_as_int(x2a[j]) * sc; x2b[j] = (float)__float_as_int(x2b[j]) * sc; } }
                    if (row < MLAT) {
                        const int t = row & (SEQ - 1), pos = ax ? (t & 63) : (t >> 6);
                        const f32x4* tp = (const f32x4*)(rope + pos * 32 + 8 * fq);
                        const f32x4 t0 = tp[0], t1 = tp[1], t2 = tp[2], t3 = tp[3];
                        const f32x4 ca = (f32x4){t0[0], t0[2], t1[0], t1[2]}, sa = (f32x4){t0[1], t0[3], t1[1], t1[3]};
                        const f32x4 cb = (f32x4){t2[0], t2[2], t3[0], t3[2]}, sb = (f32x4){t2[1], t2[3], t3[1], t3[3]};
                        const f32x4 y1a = x1a * ca - x2a * sa, y2a = x2a * ca + x1a * sa, y1b = x1b * cb - x2b * sb, y2b = x2b * cb + x1b * sb;
                        x1a = y1a; x2a = y2a; x1b = y1b; x2b = y2b;
                    }
                    stP(prs, (size_t)row * INW + c1, pack8(x1a, x1b)); stP(prs, (size_t)row * INW + c1 + 32, pack8(x2a, x2b));
                }
            return;
        }
        if (mode == 2) {
            const int cc = 128 * (u.pn - 20) + wc * 32 + 8 * fq;
            f32x4 ba[2], bb[2];
#pragma unroll
            for (int n = 0; n < 2; ++n) { ba[n] = *(const f32x4*)(bgate + cc + 4 * n); bb[n] = *(const f32x4*)(bgate + D + cc + 4 * n); }
#pragma unroll
            for (int ai = 0; ai < 2; ++ai)
#pragma unroll
                for (int m = 0; m < 4; ++m) {
                    const size_t row = (size_t)(row0 + ai * HALF + m * 16);
                    f32x4 rr[2], gb[2];
#pragma unroll
                    for (int n = 0; n < 2; ++n)
#pragma unroll
                        for (int j = 0; j < 4; ++j) { const float ga = fast_sigmoid(acc[ai][0][m][n][j] + ba[n][j]); const float g2 = fmaxf(fast_sigmoid(acc[ai][1][m][n][j] + bb[n][j]), 5.9604645e-8f);
                            gb[n][j] = g2; rr[n][j] = ga * __builtin_amdgcn_rcpf(g2); }
                    *(u32x4*)(G + row * GATEW + cc) = pack8(rr[0], rr[1]); *(u32x4*)(G + row * GATEW + D + cc) = pack8(gb[0], gb[1]);
                }
            return;
        }
        f32x4 bv[2][2];
#pragma unroll
        for (int bj = 0; bj < 2; ++bj)
#pragma unroll
            for (int n = 0; n < 2; ++n) bv[bj][n] = (f32x4){0.f, 0.f, 0.f, 0.f};
#pragma unroll
        for (int ai = 0; ai < 2; ++ai)
#pragma unroll
            for (int m = 0; m < 4; ++m) {
                const size_t row = (size_t)(row0 + ai * HALF + m * 16); const float sc = scv[ai][m];
#pragma unroll
                for (int bj = 0; bj < 2; ++bj) { f32x4 v0 = acc[ai][bj][m][0] + bv[bj][0], v1 = acc[ai][bj][m][1] + bv[bj][1];
                    if (sx) {
#pragma unroll
                        for (int j = 0; j < 4; ++j) { v0[j] = (float)__float_as_int(acc[ai][bj][m][0][j]) * sc; v1[j] = (float)__float_as_int(acc[ai][bj][m][1][j]) * sc; } }
                    if (mode == 0) {
#pragma unroll
                        for (int j = 0; j < 4; ++j) { v0[j] = gelu_tanh(v0[j]); v1[j] = gelu_tanh(v1[j]); } }
                    stP(prs, row * INW + colt + bj * HALF, pack8(v0, v1)); } }
    }
};
struct EpiGate8 {
    static constexpr bool PERM = true, MID = false, SIGNAL = false;
    bf16_t* G; const float* bgate; const float* sx; float sw;
    __device__ __forceinline__ void operator()(const f32x4 (&acc)[2][2][4][2], const Unit& u, int wr, int wc, int fr, int fq) const {
        const int row0 = u.pm * BM + wr * 64 + fr, cc = 128 * u.pn + wc * 32 + 8 * fq;
        f32x4 ba[2], bb[2];
#pragma unroll
        for (int n = 0; n < 2; ++n) { ba[n] = *(const f32x4*)(bgate + cc + 4 * n); bb[n] = *(const f32x4*)(bgate + D + cc + 4 * n); }
        float scv[2][4];
#pragma unroll
        for (int ai = 0; ai < 2; ++ai)
#pragma unroll
            for (int m = 0; m < 4; ++m) scv[ai][m] = sx[row0 + ai * HALF + m * 16] * sw;
        asm volatile("" ::: "memory");
#pragma unroll
        for (int ai = 0; ai < 2; ++ai)
#pragma unroll
            for (int m = 0; m < 4; ++m) {
                const size_t row = (size_t)(row0 + ai * HALF + m * 16); const float sc = scv[ai][m];
                f32x4 rr[2], gb[2];
#pragma unroll
                for (int n = 0; n < 2; ++n)
#pragma unroll
                    for (int j = 0; j < 4; ++j) { const float za = (float)__float_as_int(acc[ai][0][m][n][j]) * sc + ba[n][j], zb = (float)__float_as_int(acc[ai][1][m][n][j]) * sc + bb[n][j];
                        const float ta = 1.0f + __builtin_amdgcn_exp2f(-1.44269504f * za), tb = fminf(1.0f + __builtin_amdgcn_exp2f(-1.44269504f * zb), 16777216.0f);
                        gb[n][j] = __builtin_amdgcn_rcpf(tb); rr[n][j] = tb * __builtin_amdgcn_rcpf(ta); }
                *(u32x4*)(G + row * GATEW + cc) = pack8(rr[0], rr[1]); *(u32x4*)(G + row * GATEW + D + cc) = pack8(gb[0], gb[1]);
            }
    }
};
struct EpiMergeF {
    static constexpr bool PERM = true, MID = true, SIGNAL = false;
    bf16_t* T; const bf16_t* G;
    __device__ __forceinline__ void mid(f32x4 (&acc)[2][2][4][2], const Unit& u, int wr, int wc, int fr_, int fq_) const {
        int fr = fr_, fq = fq_; asm volatile("" : "+v"(fr), "+v"(fq));
        const int row0 = u.pm * BM + wr * 64 + fr, colt = u.pn * BM + wc * 32 + 8 * fq;
#pragma unroll
        for (int ai = 0; ai < 2; ++ai)
#pragma unroll
            for (int mh = 0; mh < 2; ++mh) {
                u32x4 raw[2][2];
#pragma unroll
                for (int mm = 0; mm < 2; ++mm)
#pragma unroll
                    for (int bj = 0; bj < 2; ++bj) raw[mm][bj] = __builtin_nontemporal_load((const u32x4*)(G + (size_t)(row0 + ai * HALF + (2 * mh + mm) * 16) * GATEW + colt + bj * HALF));
#pragma unroll
                for (int mm = 0; mm < 2; ++mm)
#pragma unroll
                    for (int bj = 0; bj < 2; ++bj) { f32x4 r0, r1; unpack8(raw[mm][bj], r0, r1); acc[ai][bj][2 * mh + mm][0] *= r0; acc[ai][bj][2 * mh + mm][1] *= r1; }
                asm volatile("" ::: "memory");
            }
    }
    __device__ __forceinline__ void operator()(const f32x4 (&acc)[2][2][4][2], const Unit& u, int wr, int wc, int fr, int fq) const {
        const int row0 = u.pm * BM + wr * 64 + fr, colt = u.pn * BM + wc * 32 + 8 * fq;
#pragma unroll
        for (int ai = 0; ai < 2; ++ai) {
            u32x4 gb[4][2];
#pragma unroll
            for (int m = 0; m < 4; ++m)
#pragma unroll
                for (int bj = 0; bj < 2; ++bj) gb[m][bj] = __builtin_nontemporal_load((const u32x4*)(G + (size_t)(row0 + ai * HALF + m * 16) * GATEW + D + colt + bj * HALF));
            asm volatile("" ::: "memory");
#pragma unroll
            for (int m = 0; m < 4; ++m) {
                bf16_t* tp = T + (size_t)(row0 + ai * HALF + m * 16) * D + colt;
#pragma unroll
                for (int bj = 0; bj < 2; ++bj) { f32x4 g0, g1; unpack8(gb[m][bj], g0, g1);
                    *(u32x4*)(tp + bj * HALF) = pack8(acc[ai][bj][m][0] * g0, acc[ai][bj][m][1] * g1); } }
            asm volatile("" ::: "memory");
        }
    }
};
struct EpiMergeI8 {
    static constexpr bool PERM = true, MID = true, SIGNAL = false;
    bf16_t* T; const bf16_t* G; const float* cab; const float* sob;
    __device__ __forceinline__ void mid(f32x4 (&acc)[2][2][4][2], const Unit& u, int wr, int wc, int fr_, int fq_) const {
        int fr = fr_, fq = fq_; asm volatile("" : "+v"(fr), "+v"(fq));
        const int row0 = u.pm * BM + wr * 64 + fr, colt = u.pn * BM + wc * 32 + 8 * fq;
#pragma unroll
        for (int ai = 0; ai < 2; ++ai)
#pragma unroll
            for (int mh = 0; mh < 2; ++mh) {
                u32x4 raw[2][2]; float c[2];
#pragma unroll
                for (int mm = 0; mm < 2; ++mm) { c[mm] = cab[row0 + ai * HALF + (2 * mh + mm) * 16];
#pragma unroll
                    for (int bj = 0; bj < 2; ++bj) raw[mm][bj] = __builtin_nontemporal_load((const u32x4*)(G + (size_t)(row0 + ai * HALF + (2 * mh + mm) * 16) * GATEW + colt + bj * HALF)); }
#pragma unroll
                for (int mm = 0; mm < 2; ++mm)
#pragma unroll
                    for (int bj = 0; bj < 2; ++bj) { f32x4 r0, r1; unpack8(raw[mm][bj], r0, r1);
#pragma unroll
                        for (int j = 0; j < 4; ++j) {
                            acc[ai][bj][2 * mh + mm][0][j] = __int_as_float((int)__builtin_amdgcn_fmed3f((float)__float_as_int(acc[ai][bj][2 * mh + mm][0][j]) * c[mm] * r0[j], -1.0e9f, 1.0e9f));
                            acc[ai][bj][2 * mh + mm][1][j] = __int_as_float((int)__builtin_amdgcn_fmed3f((float)__float_as_int(acc[ai][bj][2 * mh + mm][1][j]) * c[mm] * r1[j], -1.0e9f, 1.0e9f)); } }
                asm volatile("" ::: "memory");
            }
    }
    __device__ __forceinline__ void operator()(const f32x4 (&acc)[2][2][4][2], const Unit& u, int wr, int wc, int fr, int fq) const {
        const int row0 = u.pm * BM + wr * 64 + fr, colt = u.pn * BM + wc * 32 + 8 * fq;
#pragma unroll
        for (int ai = 0; ai < 2; ++ai) {
            u32x4 gb[4][2]; float sc[4];
#pragma unroll
            for (int m = 0; m < 4; ++m) { sc[m] = sob[row0 + ai * HALF + m * 16];
#pragma unroll
                for (int bj = 0; bj < 2; ++bj) gb[m][bj] = __builtin_nontemporal_load((const u32x4*)(G + (size_t)(row0 + ai * HALF + m * 16) * GATEW + D + colt + bj * HALF)); }
            asm volatile("" ::: "memory");
#pragma unroll
            for (int m = 0; m < 4; ++m) {
                bf16_t* tp = T + (size_t)(row0 + ai * HALF + m * 16) * D + colt;
#pragma unroll
                for (int bj = 0; bj < 2; ++bj) { f32x4 g0, g1; unpack8(gb[m][bj], g0, g1); f32x4 a0, a1;
#pragma unroll
                    for (int j = 0; j < 4; ++j) { a0[j] = (float)__float_as_int(acc[ai][bj][m][0][j]) * sc[m] * g0[j]; a1[j] = (float)__float_as_int(acc[ai][bj][m][1][j]) * sc[m] * g1[j]; }
                    *(u32x4*)(tp + bj * HALF) = pack8(a0, a1); } }
            asm volatile("" ::: "memory");
        }
    }
};
template <bool FIRST> struct EpiOut {
    static constexpr bool PERM = true, MID = false, SIGNAL = false;
    const float* xlat; const float* xctx; bf16_t* xs; const float* mod;
    const float* sx; float sw;
    __device__ __forceinline__ void operator()(const f32x4 (&acc)[2][2][4][2], const Unit& u, int wr, int wc, int fr, int fq) const {
        const int row0 = u.pm * BM + wr * 64 + fr, colt = u.pn * BM + wc * 32 + 8 * fq;
        const int cls = (u.pm < 32) ? 0 : (u.pm < 64 ? 1 : 2);
        const float* gate = mod + cls * 12288 + 2 * D;
        f32x4 gv[2][2];
#pragma unroll
        for (int bj = 0; bj < 2; ++bj)
#pragma unroll
            for (int n = 0; n < 2; ++n) gv[bj][n] = *(const f32x4*)(gate + colt + bj * HALF + 4 * n);
        constexpr int MB = FIRST ? 2 : 4;
#pragma unroll
        for (int ai = 0; ai < 2; ++ai)
#pragma unroll
        for (int mb = 0; mb < 4; mb += MB) {
            f32x4 xf[MB][2][2]; u32x4 xb[MB][2]; float sc[MB];
#pragma unroll
            for (int mm = 0; mm < MB; ++mm) {
                const int row = row0 + ai * HALF + (mb + mm) * 16;
                if (sx) sc[mm] = sx[row];
#pragma unroll
                for (int bj = 0; bj < 2; ++bj) {
                    if (FIRST) { const float* xr = ((row < MLAT) ? (xlat + (size_t)row * D) : (xctx + (size_t)(row - MLAT) * D)) + colt + bj * HALF; xf[mm][bj][0] = __builtin_nontemporal_load((const f32x4*)xr); xf[mm][bj][1] = __builtin_nontemporal_load((const f32x4*)(xr + 4)); }
                    else xb[mm][bj] = *(const u32x4*)(xs + (size_t)row * D + colt + bj * HALF); } }
            asm volatile("" ::: "memory");
#pragma unroll
            for (int mm = 0; mm < MB; ++mm) {
                const int m = mb + mm, row = row0 + ai * HALF + m * 16;
                bf16_t* op = xs + (size_t)row * D + colt;
#pragma unroll
                for (int bj = 0; bj < 2; ++bj) { f32x4 x0, x1;
                    if (FIRST) { x0 = xf[mm][bj][0]; x1 = xf[mm][bj][1]; } else unpack8(xb[mm][bj], x0, x1);
                    if (sx) { const float s_ = sc[mm] * sw; f32x4 a0, a1;
#pragma unroll
                        for (int j = 0; j < 4; ++j) { a0[j] = (float)__float_as_int(acc[ai][bj][m][0][j]) * s_; a1[j] = (float)__float_as_int(acc[ai][bj][m][1][j]) * s_; }
                        *(u32x4*)(op + bj * HALF) = pack8(x0 + gv[bj][0] * a0, x1 + gv[bj][1] * a1);
                    } else
                    *(u32x4*)(op + bj * HALF) = pack8(x0 + gv[bj][0] * acc[ai][bj][m][0], x1 + gv[bj][1] * acc[ai][bj][m][1]); } }
            asm volatile("" ::: "memory");
        }
    }
};
struct EpiGateUp {
    static constexpr bool PERM = true, MID = false, SIGNAL = false;
    bf16_t* HID;
    __device__ __forceinline__ void operator()(const f32x4 (&acc)[2][2][4][2], const Unit& u, int wr, int wc, int fr, int fq) const {
        const int row0 = u.pm * BM + wr * 64 + fr, col0 = u.pn * 128 + wc * 32 + 8 * fq;
#pragma unroll
        for (int ai = 0; ai < 2; ++ai)
#pragma unroll
            for (int m = 0; m < 4; ++m) {
                const size_t row = (size_t)(row0 + ai * HALF + m * 16);
                f32x4 v0, v1;
#pragma unroll
                for (int j = 0; j < 4; ++j) { v0[j] = silu_f(acc[ai][0][m][0][j]) * acc[ai][1][m][0][j]; v1[j] = silu_f(acc[ai][0][m][1][j]) * acc[ai][1][m][1][j]; }
                *(u32x4*)(HID + row * DEXP + col0) = pack8(v0, v1); }
    }
};
struct EpiGateUp8 {
    static constexpr bool PERM = true, MID = false, SIGNAL = false;
    bf16_t* HID; const int* ts; const float* sx; const unsigned* emax;
    __device__ __forceinline__ void operator()(const f32x4 (&acc)[2][2][4][2], const Unit& u, int wr, int wc, int fr, int fq) const {
        const int row0 = u.pm * BM + wr * 64 + fr, col0 = u.pn * 128 + wc * 32 + 8 * fq;
        const float sg = __uint_as_float(emax[2 * u.e]) * (1.0f / 127.0f), su = __uint_as_float(emax[2 * u.e + 1]) * (1.0f / 127.0f);
        int tv[2][4]; float scv[2][4];
#pragma unroll
        for (int ai = 0; ai < 2; ++ai)
#pragma unroll
            for (int m = 0; m < 4; ++m) tv[ai][m] = ts[row0 + ai * HALF + m * 16];
#pragma unroll
        for (int ai = 0; ai < 2; ++ai)
#pragma unroll
            for (int m = 0; m < 4; ++m) scv[ai][m] = sx[max(tv[ai][m], 0) >> 1];
        asm volatile("" ::: "memory");
#pragma unroll
        for (int ai = 0; ai < 2; ++ai)
#pragma unroll
            for (int m = 0; m < 4; ++m) {
                const size_t row = (size_t)(row0 + ai * HALF + m * 16);
                const float sc = tv[ai][m] >= 0 ? scv[ai][m] : 0.f; const float cg = sc * sg, cu = sc * su;
                f32x4 v0, v1;
#pragma unroll
                for (int j = 0; j < 4; ++j) { v0[j] = silu_f((float)__float_as_int(acc[ai][0][m][0][j]) * cg) * ((float)__float_as_int(acc[ai][1][m][0][j]) * cu);
                                              v1[j] = silu_f((float)__float_as_int(acc[ai][0][m][1][j]) * cg) * ((float)__float_as_int(acc[ai][1][m][1][j]) * cu); }
                *(u32x4*)(HID + row * DEXP + col0) = pack8(v0, v1); }
    }
};
template <bool I8> struct EpiDown {
    static constexpr bool PERM = true, MID = false, SIGNAL = false;
    bf16_t* Y; const int* tokslot; const float* wslot;
    const unsigned* dmax;
    __device__ __forceinline__ void operator()(const f32x4 (&acc)[2][2][4][2], const Unit& u, int wr, int wc, int fr, int fq) const {
        const int row0 = u.pm * BM + wr * 64 + fr, colt = u.pn * BM + wc * 32 + 8 * fq;
        float swd = 1.0f; if (I8) swd = __uint_as_float(dmax[u.e]) * (1.0f / 127.0f);
        int tv[2][4]; float wv[2][4];
#pragma unroll
        for (int ai = 0; ai < 2; ++ai)
#pragma unroll
            for (int m = 0; m < 4; ++m) { tv[ai][m] = tokslot[row0 + ai * HALF + m * 16]; wv[ai][m] = wslot[row0 + ai * HALF + m * 16]; }
        asm volatile("" ::: "memory");
#pragma unroll
        for (int ai = 0; ai < 2; ++ai)
#pragma unroll
            for (int m = 0; m < 4; ++m) {
                const int ts = tv[ai][m]; const float w = I8 ? wv[ai][m] * swd : wv[ai][m];
                if (ts >= 0) {
                    bf16_t* yp = Y + (size_t)ts * D + colt;
#pragma unroll
                    for (int bj = 0; bj < 2; ++bj) {
                        if (I8) { f32x4 a0, a1;
#pragma unroll
                            for (int j = 0; j < 4; ++j) { a0[j] = (float)__float_as_int(acc[ai][bj][m][0][j]) * w; a1[j] = (float)__float_as_int(acc[ai][bj][m][1][j]) * w; }
                            *(u32x4*)(yp + bj * HALF) = pack8(a0, a1);
                        } else *(u32x4*)(yp + bj * HALF) = pack8(acc[ai][bj][m][0] * w, acc[ai][bj][m][1] * w); } } }
    }
};
}

struct Args {
    const float* in[26];
    float* out; unsigned char* ws;
    int ph_lo, ph_hi;
};
constexpr int NPHASE = 20;

#define CAS __attribute__((address_space(4)))
struct ArgView {
    const CAS unsigned char* kp;
    __device__ __forceinline__ const float* in_(int i) const { return *(const float* const CAS*)(kp + 8 * i); }
    __device__ __forceinline__ float* out_() const { return *(float* const CAS*)(kp + 208); }
    __device__ __forceinline__ unsigned char* ws_() const { return *(unsigned char* const CAS*)(kp + 216); }
};
struct Ctx {
    LAS unsigned char* lds; int tid, lane, wave, G, bid;
    ArgView av;
};
static_assert(sizeof(Args) == 232, "Args layout vs ArgView offsets");

__device__ __forceinline__ void p0_adaln(const Ctx& cx) {
    const ArgView a = cx.av;
    const float* w_ada = a.in_(4); const float* b_ada = a.in_(5); const float* cvec = a.in_(1); const float* cctx = a.in_(3);
    float* mod = (float*)(a.ws_() + WS_CTL + CTL_MOD);
    const int lane = cx.lane, w = cx.wave;
    LAS float* red = (LAS float*)cx.lds;
    for (int task = cx.bid; task < 2 * 96; task += cx.G) {
        const int l = task / 96, cg = task % 96;
        const int k0 = w * 256, n0 = cg * 128 + lane * 2;
        const float* W = w_ada + ((size_t)l * D + k0) * 12288 + n0;
        f32x2 acc[3] = {(f32x2){0.f, 0.f}, (f32x2){0.f, 0.f}, (f32x2){0.f, 0.f}};
        for (int h = 0; h < 4; ++h) {
            const float s0 = silu_f(cvec[k0 + 64 * h + lane]), s1 = silu_f(cvec[D + k0 + 64 * h + lane]), s2 = silu_f(cctx[k0 + 64 * h + lane]);
#pragma unroll
            for (int jb = 0; jb < 2; ++jb) {
                f32x2 wv[32];
#pragma unroll
                for (int j = 0; j < 32; ++j) wv[j] = __builtin_nontemporal_load((const f32x2*)(W + (size_t)(64 * h + 32 * jb + j) * 12288));
                asm volatile("" ::: "memory");
#pragma unroll
                for (int j = 0; j < 32; ++j) {
                    acc[0] += wv[j] * __int_as_float(__builtin_amdgcn_readlane(__float_as_int(s0), 32 * jb + j));
                    acc[1] += wv[j] * __int_as_float(__builtin_amdgcn_readlane(__float_as_int(s1), 32 * jb + j));
                    acc[2] += wv[j] * __int_as_float(__builtin_amdgcn_readlane(__float_as_int(s2), 32 * jb + j));
                }
            }
        }
#pragma unroll
        for (int r = 0; r < 3; ++r) *(LAS f32x2*)(red + (w * 3 + r) * 128 + 2 * lane) = acc[r];
        __syncthreads();
        for (int idx = cx.tid; idx < 384; idx += NTHR) { const int r = idx >> 7, c = idx & 127;
            float sum = b_ada[(size_t)l * 12288 + cg * 128 + c];
#pragma unroll
            for (int ww = 0; ww < 8; ++ww) sum += red[(ww * 3 + r) * 128 + c];
            mod[((size_t)l * 3 + r) * 12288 + cg * 128 + c] = sum; }
        __syncthreads();
    }
    f32x2* tab = (f32x2*)(a.ws_() + WS_ROPE);
    for (int idx = cx.bid * NTHR + cx.tid; idx < 128 * 32; idx += cx.G * NTHR) {
        const int pos = idx >> 5, i = idx & 31;
        const float invf = powf(10000.0f, -(float)i / 32.0f); const float ang = (float)pos * invf;
        tab[idx] = (f32x2){cosf(ang), sinf(ang)};
    }
}

__device__ __forceinline__ void tr_item(const float* src, int N, int k0, int n0, bf16_t* dst, int ldd, int drow0, LAS float* scr, int lane, int shift32 = 0) {
    f32x4 v[16];
    const float* p = src + (size_t)(k0 + (lane >> 4)) * N + n0 + 4 * (lane & 15);
#pragma unroll
    for (int i = 0; i < 16; ++i) v[i] = __builtin_nontemporal_load((const f32x4*)(p + (size_t)(4 * i) * N));
#pragma unroll
    for (int i = 0; i < 16; ++i) { LAS float* s = scr + (4 * i + (lane >> 4)) * 65 + 4 * (lane & 15); s[0] = v[i][0]; s[1] = v[i][1]; s[2] = v[i][2]; s[3] = v[i][3]; }
    LDS_WAIT();
    const int c = lane & 7;
#pragma unroll
    for (int jj = 0; jj < 8; ++jj) { const int n = (lane >> 3) + 8 * jj; const LAS float* s = scr + (8 * c) * 65 + n;
        u32x4 o; o.x = cvt_pk_bf16(s[0], s[65]); o.y = cvt_pk_bf16(s[2 * 65], s[3 * 65]); o.z = cvt_pk_bf16(s[4 * 65], s[5 * 65]); o.w = cvt_pk_bf16(s[6 * 65], s[7 * 65]);
        *(u32x4*)(dst + (size_t)(drow0 + n + (n >= 32 ? shift32 : 0)) * ldd + k0 + 8 * c) = o; }
    LDS_WAIT();
}
__device__ __forceinline__ unsigned pk4_i8(float a, float b, float c, float d) {
    const int q0 = (int)fminf(fmaxf(__builtin_rintf(a), -127.f), 127.f), q1 = (int)fminf(fmaxf(__builtin_rintf(b), -127.f), 127.f);
    const int q2 = (int)fminf(fmaxf(__builtin_rintf(c), -127.f), 127.f), q3 = (int)fminf(fmaxf(__builtin_rintf(d), -127.f), 127.f);
    return (unsigned)(q0 & 255) | ((unsigned)(q1 & 255) << 8) | ((unsigned)(q2 & 255) << 16) | ((unsigned)(q3 & 255) << 24); }
__device__ __forceinline__ void tr_item_i8(const float* src, int N, int k0, int n0, unsigned char* dst, int ldd, int drow0, const unsigned* amaxp, LAS float* scr, int lane, int shift32 = 0) {
    const unsigned ab = __hip_atomic_load(amaxp, __ATOMIC_RELAXED, __HIP_MEMORY_SCOPE_AGENT);
    f32x4 v[16];
    const float* p = src + (size_t)(k0 + (lane >> 4)) * N + n0 + 4 * (lane & 15);
#pragma unroll
    for (int i = 0; i < 16; ++i) v[i] = __builtin_nontemporal_load((const f32x4*)(p + (size_t)(4 * i) * N));
#pragma unroll
    for (int i = 0; i < 16; ++i) { LAS float* s_ = scr + (4 * i + (lane >> 4)) * 65 + 4 * (lane & 15); s_[0] = v[i][0]; s_[1] = v[i][1]; s_[2] = v[i][2]; s_[3] = v[i][3]; }
    LDS_WAIT();
    const float inv = 127.0f / fmaxf(__uint_as_float(ab), 1e-20f);
    const int c = lane & 7;
#pragma unroll
    for (int jj = 0; jj < 8; ++jj) { const int n = (lane >> 3) + 8 * jj; const LAS float* s_ = scr + (8 * c) * 65 + n;
        const u32x2 o = (u32x2){pk4_i8(s_[0] * inv, s_[65] * inv, s_[2 * 65] * inv, s_[3 * 65] * inv), pk4_i8(s_[4 * 65] * inv, s_[5 * 65] * inv, s_[6 * 65] * inv, s_[7 * 65] * inv)};
        *(u32x2*)(dst + (size_t)(drow0 + n + (n >= 32 ? shift32 : 0)) * ldd + k0 + 8 * c) = o; }
    LDS_WAIT();
}
constexpr int CV_IN = 32 * 80, CV_GT = 32 * 64, CV_A = 16 * 32, CV_O = 32 * 32, CV_EG = 32 * 32 * 8, CV_ED = 32 * 8 * 32;
constexpr int CV_DENSE = CV_IN + CV_GT + 2 * CV_A + CV_O, CV_EXP = 2 * CV_EG + CV_ED, CV_LAYER = CV_DENSE + CV_EXP;
static_assert(CV_DENSE == 6656 && CV_LAYER == 31232, "conversion item counts");
constexpr int CQ_TOTAL = CV_EXP + CV_LAYER;
__device__ __forceinline__ void conv_item(const ArgView a, int l, int r, LAS float* scr, int lane) {
    unsigned char* wset = a.ws_() + (size_t)l * WSET_BYTES;
    bf16_t* WC = (bf16_t*)(wset + WS_WC);
    if (r < CV_IN) { const int kb = r / 80, nb = r % 80, n0 = 64 * nb;
        int drow0 = n0, sh = 0;
        if (n0 >= 3072 && n0 < 4096) { const int lo = n0 - 3072; drow0 = 3072 + (lo & ~255) + 64 * ((lo >> 7) & 1) + 32 * ((lo >> 6) & 1); sh = 96; }
        if (MK_I8IN) {
            tr_item_i8(a.in_(8) + (size_t)l * D * INW, INW, 64 * kb, n0, (unsigned char*)(wset + WS_WC), D, drow0, (const unsigned*)(a.ws_() + WS_CTL) + CW_GMAX + 2 + l, scr, lane, sh);
        } else
        tr_item(a.in_(8) + (size_t)l * D * INW, INW, 64 * kb, n0, WC, D, drow0, scr, lane, sh); return; } r -= CV_IN;
    if (r < CV_GT) { const int kb = r / 64, nb = r % 64, n0 = 64 * nb, c = n0 & (D - 1);
        if (MK_I8GATE) {
            tr_item_i8(a.in_(13) + (size_t)l * D * GATEW, GATEW, 64 * kb, n0, (unsigned char*)(wset + WS_WC) + (size_t)INW * D * 2, D, 256 * (c >> 7) + (c & 127) + 128 * (n0 >> 11), (const unsigned*)(a.ws_() + WS_CTL) + CW_GMAX + l, scr, lane);
        } else
        tr_item(a.in_(13) + (size_t)l * D * GATEW, GATEW, 64 * kb, n0, WC, D, INW + 256 * (c >> 7) + (c & 127) + 128 * (n0 >> 11), scr, lane); return; } r -= CV_GT;
    if (r < 2 * CV_A) { const int b = r / CV_A; r %= CV_A; const int kb = r / 32, nb = r % 32;
        if (I8SEL(MK_I8M, l))
            tr_item_i8(a.in_(15 + b) + (size_t)l * SGUW * D, D, 64 * kb, 64 * nb, wset + WS_WA + (size_t)b * SGUW, D, 64 * nb, (const unsigned*)(a.ws_() + WS_CTL) + CW_GMAX + 6 + 2 * l + b, scr, lane);
        else
        tr_item(a.in_(15 + b) + (size_t)l * SGUW * D, D, 64 * kb, 64 * nb, (bf16_t*)(wset + WS_WA) + (size_t)b * SGUW, D, 64 * nb, scr, lane); return; } r -= 2 * CV_A;
    if (r < CV_O) { const int kb = r / 32, nb = r % 32;
        if (I8SEL(MK_I8O, l)) {
            tr_item_i8(a.in_(17) + (size_t)l * D * D, D, 64 * kb, 64 * nb, wset + WS_WO, D, 64 * nb, (const unsigned*)(a.ws_() + WS_CTL) + CW_GMAX + 4 + l, scr, lane);
        } else
        tr_item(a.in_(17) + (size_t)l * D * D, D, 64 * kb, 64 * nb, (bf16_t*)(wset + WS_WO), D, 64 * nb, scr, lane); return; } r -= CV_O;
    if (r < 2 * CV_EG) { const int up = r / CV_EG; r %= CV_EG; const int e = r / 256, q = r % 256, kb = q / 8, nb = q % 8, n0 = 64 * nb;
        const float* src = a.in_(22 + up) + ((size_t)l * NEXP + e) * D * DEXP;
        if (I8SEL(MK_I8E, l)) {
            tr_item_i8(src, DEXP, 64 * kb, n0, wset + WS_WGU + (size_t)e * 1024 * D, D, 256 * (n0 >> 7) + (n0 & 127) + 128 * up, (const unsigned*)(a.ws_() + WS_CTL) + CW_EMAX + 64 * l + 2 * e + up, scr, lane);
        } else
        tr_item(src, DEXP, 64 * kb, n0, (bf16_t*)(wset + WS_WGU) + (size_t)e * 1024 * D, D, 256 * (n0 >> 7) + (n0 & 127) + 128 * up, scr, lane); return; } r -= 2 * CV_EG;
    { const int e = r / 256, q = r % 256, kb = q / 32, nb = q % 32;
      if (I8SEL(MK_I8D, l)) {
          tr_item_i8(a.in_(24) + ((size_t)l * NEXP + e) * DEXP * D, D, 64 * kb, 64 * nb, wset + WS_WD + (size_t)e * D * DEXP, DEXP, 64 * nb, (const unsigned*)(a.ws_() + WS_CTL) + CW_DMAX + 32 * l + e, scr, lane);
      } else
      tr_item(a.in_(24) + ((size_t)l * NEXP + e) * DEXP * D, D, 64 * kb, 64 * nb, (bf16_t*)(wset + WS_WD) + (size_t)e * D * DEXP, DEXP, 64 * nb, scr, lane); }
}
__device__ __forceinline__ void conv_range(const Ctx& cx, int qlo, int qhi, int rank, int nblk) {
    LAS float* scr = (LAS float*)(cx.lds + cx.wave * 16640);
    for (int q = qlo + rank * NWAVES + cx.wave; q < qhi; q += nblk * NWAVES) {
        if (q < CV_EXP) conv_item(cx.av, 0, CV_DENSE + q, scr, cx.lane); else conv_item(cx.av, 1, q - CV_EXP, scr, cx.lane); }
}
__device__ __forceinline__ void conv_tail(const Ctx& cx, int nwg, int qlo, int qhi) {
    const int rem = nwg % cx.G;
    if (rem == 0) conv_range(cx, qlo, qhi, cx.bid, cx.G);
    else if (cx.bid >= rem) conv_range(cx, qlo, qhi, cx.bid - rem, cx.G - rem);
}
__device__ __forceinline__ void conv_gate0(const Ctx& cx) {
    LAS float* scr = (LAS float*)(cx.lds + cx.wave * 16640);
    for (int r = (MK_I8IN ? 0 : CV_IN) + cx.bid * NWAVES + cx.wave; r < CV_IN + CV_GT; r += cx.G * NWAVES) conv_item(cx.av, 0, r, scr, cx.lane);
    if (MK_I8O & 1) for (int r = CV_DENSE - CV_O + cx.bid * NWAVES + cx.wave; r < CV_DENSE; r += cx.G * NWAVES) conv_item(cx.av, 0, r, scr, cx.lane);
    if (MK_I8M & 1) for (int r = CV_IN + CV_GT + cx.bid * NWAVES + cx.wave; r < CV_DENSE - CV_O; r += cx.G * NWAVES) conv_item(cx.av, 0, r, scr, cx.lane);
}
__device__ __forceinline__ int gemm_wgs(int nwg, int G) { const int rounds = (nwg + G - 1) / G; int g = rounds > 0 ? (nwg + rounds - 1) / rounds : G; g = (g + 7) & ~7; return g < G ? g : G; }
__device__ __forceinline__ void conv_side(const Ctx& cx, int Gg, int qlo, int qhi) {
    if (qhi <= qlo) return;
    if (Gg >= cx.G) conv_range(cx, qlo, qhi, cx.bid, cx.G);
    else if (cx.bid >= Gg) conv_range(cx, qlo, qhi, cx.bid - Gg, cx.G - Gg);
}
__device__ __forceinline__ void pw_convert0(const Ctx& cx) {
    const ArgView a = cx.av;
    LAS float* scr = (LAS float*)(cx.lds + cx.wave * 16640);
#define CV_SKIP_GATE(r) ((MK_I8GATE && (r) >= CV_IN && (r) < CV_IN + CV_GT) || (MK_I8IN && (r) < CV_IN) || ((MK_I8O & 1) && (r) >= CV_DENSE - CV_O) || ((MK_I8M & 1) && (r) >= CV_IN + CV_GT && (r) < CV_DENSE - CV_O))
    if (cx.G >= 224) { if (cx.bid >= 192) for (int r = (cx.bid - 192) * NWAVES + cx.wave; r < CV_DENSE; r += (cx.G - 192) * NWAVES) { if (!CV_SKIP_GATE(r)) conv_item(a, 0, r, scr, cx.lane); } }
    else for (int r = cx.bid * NWAVES + cx.wave; r < CV_DENSE; r += cx.G * NWAVES) { if (!CV_SKIP_GATE(r)) conv_item(a, 0, r, scr, cx.lane); }
#undef CV_SKIP_GATE
#define WG_PUSH_MAX(val, word) do { LAS float* r_ = (LAS float*)(cx.lds + LDS_MISC + 128); if (cx.lane == 0) r_[cx.wave] = (val); __syncthreads(); \
        if (cx.tid == 0) { float mm_ = r_[0]; for (int i_ = 1; i_ < NWAVES; ++i_) mm_ = fmaxf(mm_, r_[i_]); \
            __hip_atomic_fetch_max((unsigned*)(a.ws_() + WS_CTL) + (word), __float_as_uint(mm_), __ATOMIC_RELAXED, __HIP_MEMORY_SCOPE_AGENT); } __syncthreads(); } while (0)
    if (MK_I8GATE) {
        for (int l = 0; l < 2; ++l) { const f32x4* w = (const f32x4*)(a.in_(13) + (size_t)l * D * GATEW); float m = 0.f;
            for (int i = cx.bid * NTHR + cx.tid; i < (D / 8) * (GATEW / 4); i += cx.G * NTHR) { const f32x4 v = w[(size_t)(i / (GATEW / 4)) * 8 * (GATEW / 4) + i % (GATEW / 4)]; m = fmaxf(m, fmaxf(fmaxf(fabsf(v[0]), fabsf(v[1])), fmaxf(fabsf(v[2]), fabsf(v[3])))); }
#pragma unroll
            for (int o = 1; o < 64; o <<= 1) m = fmaxf(m, __shfl_xor(m, o));
            WG_PUSH_MAX(m * GMAX_MARGIN, CW_GMAX + l); }
    }
    if (MK_I8IN) {
        for (int l = 0; l < 2; ++l) { const f32x4* w = (const f32x4*)(a.in_(8) + (size_t)l * D * INW); float m = 0.f;
            for (int i = cx.bid * NTHR + cx.tid; i < (D / 8) * (INW / 4); i += cx.G * NTHR) { const f32x4 v = w[(size_t)(i / (INW / 4)) * 8 * (INW / 4) + i % (INW / 4)]; m = fmaxf(m, fmaxf(fmaxf(fabsf(v[0]), fabsf(v[1])), fmaxf(fabsf(v[2]), fabsf(v[3])))); }
#pragma unroll
            for (int o = 1; o < 64; o <<= 1) m = fmaxf(m, __shfl_xor(m, o));
            WG_PUSH_MAX(m * GMAX_MARGIN, CW_GMAX + 2 + l); }
    }
    if (MK_I8M) {
        for (int mb = 0; mb < 4; ++mb) { const int l = mb >> 1, b = mb & 1; const f32x4* w = (const f32x4*)(a.in_(15 + b) + (size_t)l * SGUW * D); float m = 0.f;
            for (int i = cx.bid * NTHR + cx.tid; i < (SGUW / 8) * (D / 4); i += cx.G * NTHR) { const f32x4 v = w[(size_t)(i / (D / 4)) * 8 * (D / 4) + i % (D / 4)]; m = fmaxf(m, fmaxf(fmaxf(fabsf(v[0]), fabsf(v[1])), fmaxf(fabsf(v[2]), fabsf(v[3])))); }
#pragma unroll
            for (int o = 1; o < 64; o <<= 1) m = fmaxf(m, __shfl_xor(m, o));
            WG_PUSH_MAX(m * GMAX_MARGIN, CW_GMAX + 6 + 2 * l + b); }
    }
    if (MK_I8O) {
        for (int l = 0; l < 2; ++l) { const f32x4* w = (const f32x4*)(a.in_(17) + (size_t)l * D * D); float m = 0.f;
            for (int i = cx.bid * NTHR + cx.tid; i < (D / 8) * (D / 4); i += cx.G * NTHR) { const f32x4 v = w[(size_t)(i / (D / 4)) * 8 * (D / 4) + i % (D / 4)]; m = fmaxf(m, fmaxf(fmaxf(fabsf(v[0]), fabsf(v[1])), fmaxf(fabsf(v[2]), fabsf(v[3])))); }
#pragma unroll
            for (int o = 1; o < 64; o <<= 1) m = fmaxf(m, __shfl_xor(m, o));
            WG_PUSH_MAX(m * GMAX_MARGIN, CW_GMAX + 4 + l); }
    }
    if (MK_I8D) {
        for (int uu = cx.bid * NWAVES + cx.wave; uu < 1024; uu += cx.G * NWAVES) {
            const int mat = uu >> 4, part = uu & 15, l = mat >> 5, e = mat & 31;
            if (!(I8SEL(MK_I8D, l))) continue;
            const float* src = a.in_(24) + ((size_t)l * NEXP + e) * DEXP * D + (size_t)(part * 32) * D;
            f32x4 v[8];
#pragma unroll
            for (int j = 0; j < 8; ++j) v[j] = *(const f32x4*)(src + 4 * (j * 64 + cx.lane));
            float m = 0.f;
#pragma unroll
            for (int j = 0; j < 8; ++j) m = fmaxf(m, fmaxf(fmaxf(fabsf(v[j][0]), fabsf(v[j][1])), fmaxf(fabsf(v[j][2]), fabsf(v[j][3]))));
#pragma unroll
            for (int o = 1; o < 64; o <<= 1) m = fmaxf(m, __shfl_xor(m, o));
            if (cx.lane == 0) __hip_atomic_fetch_max((unsigned*)(a.ws_() + WS_CTL) + CW_DMAX + 32 * l + e, __float_as_uint(m * EMAX_MARGIN), __ATOMIC_RELAXED, __HIP_MEMORY_SCOPE_AGENT);
        }
    }
    if (MK_I8E) {
        for (int uu = cx.bid * NWAVES + cx.wave; uu < 2048; uu += cx.G * NWAVES) {
            const int mat = uu >> 4, part = uu & 15, l = mat >> 6, up = (mat >> 5) & 1, e = mat & 31;
            if (!(I8SEL(MK_I8E, l))) continue;
            const float* src = a.in_(22 + up) + ((size_t)l * NEXP + e) * D * DEXP;
            f32x4 v[8];
#pragma unroll
            for (int j = 0; j < 8; ++j) { const int idx = j * 64 + cx.lane; v[j] = *(const f32x4*)(src + (size_t)((part * 4 + (idx >> 7)) * 32) * DEXP + 4 * (idx & 127)); }
            float m = 0.f;
#pragma unroll
            for (int j = 0; j < 8; ++j) m = fmaxf(m, fmaxf(fmaxf(fabsf(v[j][0]), fabsf(v[j][1])), fmaxf(fabsf(v[j][2]), fabsf(v[j][3]))));
#pragma unroll
            for (int o = 1; o < 64; o <<= 1) m = fmaxf(m, __shfl_xor(m, o));
            if (cx.lane == 0) __hip_atomic_fetch_max((unsigned*)(a.ws_() + WS_CTL) + CW_EMAX + 64 * l + 2 * e + up, __float_as_uint(m * EMAX_MARGIN), __ATOMIC_RELAXED, __HIP_MEMORY_SCOPE_AGENT);
        }
    }
    for (int idx = cx.bid * NTHR + cx.tid; idx < 2 * 48 * D; idx += cx.G * NTHR) {
        const int l = idx / (48 * D), id = idx % (48 * D), row = id / D, k = id % D;
        const float* wre = a.in_(20) + (size_t)l * D * NEXP; const float* wrg = a.in_(18) + (size_t)l * D * 4;
        bf16_t* WR = (bf16_t*)(a.ws_() + (size_t)l * WSET_BYTES + WS_WR);
        const float v = row < 32 ? wre[(size_t)k * NEXP + row] : (row < 36 ? wrg[(size_t)k * 4 + (row - 32)] : 0.f);
        const int mt = row >> 4, fr = row & 15, ki = k >> 5, fq = (k >> 3) & 3, j = k & 7;
        WR[(((size_t)mt * 64 + ki) * 64 + fq * 16 + fr) * 8 + j] = (bf16_t)(cvt_pk_bf16(v, 0.f) & 0xffffu);
    }
}

#define ROW_E(jj) (8 * (lane + 64 * ((jj) >> 1)) + 4 * ((jj) & 1))
template <int MODE>
__device__ __forceinline__ void norm_phase(const Ctx& cx, int T) {
    const ArgView a = cx.av;
    const int gw = cx.bid * NWAVES + cx.wave, NGW = cx.G * NWAVES, lane = cx.lane;
    const int t0 = (int)((long)gw * T / NGW), t1 = (int)((long)(gw + 1) * T / NGW);
    bf16_t* xs = (bf16_t*)(a.ws_() + WS_XS); bf16_t* hx = (bf16_t*)(a.ws_() + WS_HX); const bf16_t* yb = (const bf16_t*)(a.ws_() + WS_G);
    const float* modbase = (const float*)(a.ws_() + WS_CTL + CTL_MOD);
    const int lcur = (MODE == 0) ? 0 : 1;
    const float* nw = (MODE == 2) ? a.in_(25) : (a.in_(6) + (size_t)lcur * D);
    const bool do_comb = (MODE == 1) ? ((MK_MASK & 2) != 0) : ((MODE == 2) ? ((MK_MASK & 8) != 0) : false);
    const int lprev = (MODE == 2) ? 1 : 0;
    f32x4 vA[8], vB[8], vG[8]; int curcls = -1;
    f32x4 nxf[8]; u32x4 nxs[4], ny0[4], ny1[4];
    auto fetch = [&](int tk) {
        if (MODE == 0) {
            const float* xr = tk < MLAT ? a.in_(0) + (size_t)tk * D : a.in_(2) + (size_t)(tk - MLAT) * D;
#pragma unroll
            for (int j = 0; j < 8; ++j) nxf[j] = __builtin_nontemporal_load((const f32x4*)(xr + ROW_E(j)));
        } else {
#pragma unroll
            for (int j = 0; j < 4; ++j) nxs[j] = __builtin_nontemporal_load((const u32x4*)(xs + (size_t)tk * D + 8 * (lane + 64 * j)));
            if (do_comb) { const bf16_t* y0 = yb + (size_t)tk * 2 * D;
#pragma unroll
                for (int j = 0; j < 4; ++j) { ny0[j] = __builtin_nontemporal_load((const u32x4*)(y0 + 8 * (lane + 64 * j))); ny1[j] = __builtin_nontemporal_load((const u32x4*)(y0 + D + 8 * (lane + 64 * j))); } }
        }
    };
    if (gw < T) fetch(gw);
    for (int tok = gw; tok < T; tok += NGW) {
        const int cls = tok < SEQ ? 0 : (tok < MLAT ? 1 : 2);
        if (cls != curcls) { curcls = cls;
#define NP_TAB(R) _Pragma("unroll") for (int jj = 0; jj < 8; ++jj) { const int j = (jj + (R)) & 7; const int e = ROW_E(j); const f32x4 w = *(const f32x4*)(nw + e); \
                if (MODE == 2) { vA[j] = w; vB[j] = (f32x4){0.f, 0.f, 0.f, 0.f}; } \
                else { const float* mp = modbase + ((size_t)lcur * 3 + cls) * 12288; vA[j] = w * (*(const f32x4*)(mp + D + e) + 1.0f); vB[j] = *(const f32x4*)(mp + e); } \
                if (MODE != 0) vG[j] = *(const f32x4*)(modbase + ((size_t)lprev * 3 + cls) * 12288 + 5 * D + e); }
            switch (cx.bid & 3) { case 0: NP_TAB(0) break; case 1: NP_TAB(2) break; case 2: NP_TAB(4) break; default: NP_TAB(6) break; }
#undef NP_TAB
        }
        f32x4 v[8]; float ss = 0.f;
        if (MODE == 0) {
#pragma unroll
            for (int j = 0; j < 8; ++j) v[j] = nxf[j];
        } else {
#pragma unroll
            for (int j = 0; j < 4; ++j) pg8::unpack8(nxs[j], v[2 * j], v[2 * j + 1]);
        }
        u32x4 cy0[4], cy1[4];
        if (MODE != 0 && do_comb) {
#pragma unroll
            for (int j = 0; j < 4; ++j) { cy0[j] = ny0[j]; cy1[j] = ny1[j]; }
        }
        if (tok + NGW < T) fetch(tok + NGW);
        asm volatile("" ::: "memory");
        if (MODE != 0 && do_comb) {
#pragma unroll
            for (int j = 0; j < 4; ++j) { const u32x4 p0 = cy0[j], p1 = cy1[j];
                f32x4 a0, a1, b0, b1; pg8::unpack8(p0, a0, a1); pg8::unpack8(p1, b0, b1);
                v[2 * j] += vG[2 * j] * (a0 + b0); v[2 * j + 1] += vG[2 * j + 1] * (a1 + b1); }
            if (MODE == 1) {
#pragma unroll
                for (int j = 0; j < 4; ++j) { const u32x4 pk = pg8::pack8(v[2 * j], v[2 * j + 1]); *(u32x4*)(xs + (size_t)tok * D + 8 * (lane + 64 * j)) = pk;
                    pg8::unpack8(pk, v[2 * j], v[2 * j + 1]); }
            }
        }
#pragma unroll
        for (int j = 0; j < 8; ++j) ss += (v[j][0] * v[j][0] + v[j][1] * v[j][1]) + (v[j][2] * v[j][2] + v[j][3] * v[j][3]);
        const float rstd = 1.0f / sqrtf(wave_sum(ss) * (1.0f / D) + RMS_EPS);
        if (MODE == 2) {
#pragma unroll
            for (int j = 0; j < 8; ++j) *(f32x4*)(a.out_() + (size_t)tok * D + ROW_E(j)) = v[j] * rstd * vA[j];
        } else {
            float hmax = 0.f;
#pragma unroll
            for (int j = 0; j < 8; ++j) { v[j] = v[j] * rstd * vA[j] + vB[j]; hmax = fmaxf(hmax, fmaxf(fmaxf(fabsf(v[j][0]), fabsf(v[j][1])), fmaxf(fabsf(v[j][2]), fabsf(v[j][3])))); }
            if (!(MK_I8GATE && MK_I8IN)) {
#pragma unroll
            for (int j = 0; j < 4; ++j) *(u32x4*)(hx + (size_t)tok * D + 8 * (lane + 64 * j)) = pg8::pack8(v[2 * j], v[2 * j + 1]); }
            if (MK_I8GATE) {
#pragma unroll
                for (int o = 1; o < 64; o <<= 1) hmax = fmaxf(hmax, __shfl_xor(hmax, o));
                hmax = fmaxf(hmax, 1e-20f); const float inv = 127.0f / hmax;
                unsigned char* h8 = a.ws_() + WS_HX8 + (size_t)tok * D;
#pragma unroll
                for (int j = 0; j < 4; ++j) *(u32x2*)(h8 + 8 * (lane + 64 * j)) = (u32x2){pk4_i8(v[2 * j][0] * inv, v[2 * j][1] * inv, v[2 * j][2] * inv, v[2 * j][3] * inv), pk4_i8(v[2 * j + 1][0] * inv, v[2 * j + 1][1] * inv, v[2 * j + 1][2] * inv, v[2 * j + 1][3] * inv)};
                if (lane == 0) ((float*)(a.ws_() + WS_SX))[tok] = hmax * (1.0f / 127.0f);
            }
        }
    }
}

__device__ __forceinline__ void quant_rows2048(const Ctx& cx, const bf16_t* src, unsigned char* dst, float* scale, int nrows) {
    const int gw = cx.bid * NWAVES + cx.wave, NGW = cx.G * NWAVES, lane = cx.lane;
    u32x4 nx[4];
    if (gw < nrows) {
#pragma unroll
        for (int j = 0; j < 4; ++j) nx[j] = *(const u32x4*)(src + (size_t)gw * D + 8 * (lane + 64 * j)); }
    for (int row = gw; row < nrows; row += NGW) {
        f32x4 v[8];
#pragma unroll
        for (int j = 0; j < 4; ++j) pg8::unpack8(nx[j], v[2 * j], v[2 * j + 1]);
        if (row + NGW < nrows) {
#pragma unroll
            for (int j = 0; j < 4; ++j) nx[j] = *(const u32x4*)(src + (size_t)(row + NGW) * D + 8 * (lane + 64 * j)); }
        float hmax = 0.f;
#pragma unroll
        for (int j = 0; j < 8; ++j) hmax = fmaxf(hmax, fmaxf(fmaxf(fabsf(v[j][0]), fabsf(v[j][1])), fmaxf(fabsf(v[j][2]), fabsf(v[j][3]))));
#pragma unroll
        for (int o = 1; o < 64; o <<= 1) hmax = fmaxf(hmax, __shfl_xor(hmax, o));
        hmax = fmaxf(hmax, 1e-20f); const float inv = 127.0f / hmax;
        unsigned char* h8 = dst + (size_t)row * D;
#pragma unroll
        for (int j = 0; j < 4; ++j) *(u32x2*)(h8 + 8 * (lane + 64 * j)) = (u32x2){pk4_i8(v[2 * j][0] * inv, v[2 * j][1] * inv, v[2 * j][2] * inv, v[2 * j][3] * inv), pk4_i8(v[2 * j + 1][0] * inv, v[2 * j + 1][1] * inv, v[2 * j + 1][2] * inv, v[2 * j + 1][3] * inv)};
        if (lane == 0) scale[row] = hmax * (1.0f / 127.0f);
    }
}

__device__ __forceinline__ void quant_rows_ao(const Ctx& cx, const bf16_t* src, unsigned char* dst, float* cab, float* sob, float swa, float swb, int nrows) {
    const int gw = cx.bid * NWAVES + cx.wave, NGW = cx.G * NWAVES, lane = cx.lane;
    u32x4 nx[4];
    if (gw < nrows) {
#pragma unroll
        for (int j = 0; j < 4; ++j) nx[j] = *(const u32x4*)(src + (size_t)gw * D + 8 * (lane + 64 * j)); }
    for (int row = gw; row < nrows; row += NGW) {
        f32x4 v[8];
#pragma unroll
        for (int j = 0; j < 4; ++j) pg8::unpack8(nx[j], v[2 * j], v[2 * j + 1]);
        if (row + NGW < nrows) {
#pragma unroll
            for (int j = 0; j < 4; ++j) nx[j] = *(const u32x4*)(src + (size_t)(row + NGW) * D + 8 * (lane + 64 * j)); }
        float ma = 0.f, mo = 0.f;
#pragma unroll
        for (int j = 0; j < 4; ++j) { ma = fmaxf(ma, fmaxf(fmaxf(fabsf(v[j][0]), fabsf(v[j][1])), fmaxf(fabsf(v[j][2]), fabsf(v[j][3])))); mo = fmaxf(mo, fmaxf(fmaxf(fabsf(v[4 + j][0]), fabsf(v[4 + j][1])), fmaxf(fabsf(v[4 + j][2]), fabsf(v[4 + j][3])))); }
#pragma unroll
        for (int o = 1; o < 64; o <<= 1) { ma = fmaxf(ma, __shfl_xor(ma, o)); mo = fmaxf(mo, __shfl_xor(mo, o)); }
        ma = fmaxf(ma, 1e-20f); mo = fmaxf(mo, 1e-20f); const float ia = 127.0f / ma, io = 127.0f / mo;
        unsigned char* h8 = dst + (size_t)row * D;
#pragma unroll
        for (int j = 0; j < 4; ++j) { const float inv = j < 2 ? ia : io;
            *(u32x2*)(h8 + 8 * (lane + 64 * j)) = (u32x2){pk4_i8(v[2 * j][0] * inv, v[2 * j][1] * inv, v[2 * j][2] * inv, v[2 * j][3] * inv), pk4_i8(v[2 * j + 1][0] * inv, v[2 * j + 1][1] * inv, v[2 * j + 1][2] * inv, v[2 * j + 1][3] * inv)}; }
        if (lane == 0) { const float sa = ma * (1.0f / 127.0f) * swa, so_ = mo * (1.0f / 127.0f) * swb; cab[row] = sa / so_; sob[row] = so_; }
    }
}
__device__ __forceinline__ void quant_rows512(const Ctx& cx, const bf16_t* src, unsigned char* dst, float* scale, const float* wslot, int nrows) {
    const int gw = cx.bid * NWAVES + cx.wave, NGW = cx.G * NWAVES, lane = cx.lane;
    for (int r0 = gw * 4; r0 < nrows; r0 += NGW * 4) {
        u32x4 raw[4];
#pragma unroll
        for (int i = 0; i < 4; ++i) raw[i] = __builtin_nontemporal_load((const u32x4*)(src + (size_t)(r0 + i) * DEXP + 8 * lane));
#pragma unroll
        for (int i = 0; i < 4; ++i) {
            f32x4 a0, a1; pg8::unpack8(raw[i], a0, a1);
            float hmax = fmaxf(fmaxf(fmaxf(fabsf(a0[0]), fabsf(a0[1])), fmaxf(fabsf(a0[2]), fabsf(a0[3]))), fmaxf(fmaxf(fabsf(a1[0]), fabsf(a1[1])), fmaxf(fabsf(a1[2]), fabsf(a1[3]))));
#pragma unroll
            for (int o = 1; o < 64; o <<= 1) hmax = fmaxf(hmax, __shfl_xor(hmax, o));
            hmax = fmaxf(hmax, 1e-20f); const float inv = 127.0f / hmax;
            *(u32x2*)(dst + (size_t)(r0 + i) * DEXP + 8 * lane) = (u32x2){pk4_i8(a0[0] * inv, a0[1] * inv, a0[2] * inv, a0[3] * inv), pk4_i8(a1[0] * inv, a1[1] * inv, a1[2] * inv, a1[3] * inv)};
            if (lane == 0) scale[r0 + i] = hmax * (1.0f / 127.0f) * wslot[r0 + i];
        }
    }
}

__device__ __forceinline__ unsigned offa(unsigned row, unsigned ch);
template <int OFF> __device__ __forceinline__ void tr4(unsigned a0, unsigned a1, bf16x8 (&f)[4]);
__device__ __forceinline__ void sgu_item(const Ctx& cx, int l, int item) {
    const ArgView a = cx.av;
    const int lane = cx.lane, w = cx.wave, fq = lane >> 4, fr = lane & 15;
    int ck, g0, ng;
    if (item < 256) { ck = item >> 1; g0 = 4 * (item & 1); ng = 4; } else { const int ci = item - 256; ck = 128 + (ci >> 3); g0 = ci & 7; ng = 1; }
    const int row0 = ck < 128 ? ck * 128 : MLAT + (ck - 128) * 128;
    const bf16_t* P = (const bf16_t*)(a.ws_() + WS_P); bf16_t* AB = (bf16_t*)(a.ws_() + WS_A);
    const float* nw = a.in_(9) + (size_t)l * SGUW; const float* Ws = a.in_(10) + (size_t)l * 8 * 128 * 128; const float* bs = a.in_(11) + (size_t)l * 8 * 128;
    LAS float* rstdS = (LAS float*)cx.lds; LAS unsigned char* Vt = cx.lds + 1024; const unsigned vt_base = (unsigned)(size_t)Vt;
    auto stage = [&](int g, int buf) {
#pragma unroll
        for (int i = 0; i < 4; ++i) { const unsigned o = 1024u * (4 * w + i) + 16u * lane, srow = 8u * (o >> 11) + ((o >> 6) & 7u), sch = 4u * ((o >> 9) & 3u) + (((o >> 4) & 3u) ^ ((srow >> 2) & 3u));
            __builtin_amdgcn_global_load_lds((const unsigned*)(P + (size_t)(row0 + srow) * INW + SGUW + 128 * g + 8 * sch), (LAS unsigned*)(Vt + buf * 32768 + 1024 * (4 * w + i)), 16, 0, 0); }
    };
    stage(g0, 0);
#pragma unroll 8
    for (int i = 0; i < 16; ++i) { const int m = 16 * w + i; const bf16_t* vp = P + (size_t)(row0 + m) * INW + SGUW + 16 * lane;
        const u32x4 x0 = *(const u32x4*)vp, x1 = *(const u32x4*)(vp + 8); float ss = 0.f;
#pragma unroll
        for (int j = 0; j < 4; ++j) { const float p0 = bflo(x0[j]), p1 = bfhi(x0[j]), p2 = bflo(x1[j]), p3 = bfhi(x1[j]); ss += (p0 * p0 + p1 * p1) + (p2 * p2 + p3 * p3); }
        ss = wave_sum(ss);
        if (lane == 0) rstdS[m] = 1.0f / sqrtf(ss * (1.0f / SGUW) + RMS_EPS); }
    __syncthreads();
    for (int gi = 0; gi < ng; ++gi) {
        const int g = g0 + gi, buf = gi & 1;
        bf16x8 Wf[4];
#pragma unroll
        for (int ks = 0; ks < 4; ++ks) { const float* wp = Ws + ((size_t)g * 128 + 16 * w + fr) * 128 + 32 * ks + 8 * fq;
            const f32x4 r0 = *(const LAS f32x4*)(rstdS + 32 * ks + 8 * fq), r1 = *(const LAS f32x4*)(rstdS + 32 * ks + 8 * fq + 4);
            const f32x4 w0 = *(const f32x4*)wp * r0, w1 = *(const f32x4*)(wp + 4) * r1; const u32x4 pk = pg8::pack8(w0, w1);
            Wf[ks] = __builtin_bit_cast(bf16x8, pk); }
        __syncthreads();
        if (gi + 1 < ng) stage(g + 1, buf ^ 1);
        const int tok = row0 + 16 * w + fr; const float bias = bs[g * 128 + 16 * w + fr];
        u32x2 uuv[8]; f32x4 nvv[8];
#pragma unroll
        for (int ct = 0; ct < 8; ++ct) { const int c = 128 * g + 16 * ct + 4 * fq; uuv[ct] = *(const u32x2*)(P + (size_t)tok * INW + c); nvv[ct] = *(const f32x4*)(nw + c); }
        asm volatile("" ::: "memory");
        f32x4 acc[8];
#pragma unroll
        for (int ct = 0; ct < 8; ++ct) acc[ct] = (f32x4){0.f, 0.f, 0.f, 0.f};
        { unsigned ln = cx.lane; asm volatile("" : "+v"(ln));
          const unsigned fq_o = ln >> 4, q_o = (ln & 15u) >> 2, p_o = ln & 3u;
#pragma unroll
          for (int ks = 0; ks < 4; ++ks)
#pragma unroll
            for (int par = 0; par < 2; ++par) {
                const unsigned vrow0 = 32u * ks + 8u * fq_o + q_o;
                const unsigned a0 = vt_base + buf * 32768 + offa(vrow0, 2u * par + (p_o >> 1)) + 8u * (p_o & 1u);
                const unsigned a1 = vt_base + buf * 32768 + offa(vrow0 + 4u, 2u * par + (p_o >> 1)) + 8u * (p_o & 1u);
                bf16x8 vf[4]; tr4<0>(a0, a1, vf);
#pragma unroll
                for (int i = 0; i < 4; ++i) acc[par + 2 * i] = __builtin_amdgcn_mfma_f32_16x16x32_bf16(vf[i], Wf[ks], acc[par + 2 * i], 0, 0, 0); } }
#pragma unroll
        for (int ct = 0; ct < 8; ++ct) { const int c = 128 * g + 16 * ct + 4 * fq;
            const u32x2 uu = uuv[ct]; const f32x4 nv = nvv[ct];
            const float o0 = bflo(uu.x) * (acc[ct][0] * nv[0] + bias), o1 = bfhi(uu.x) * (acc[ct][1] * nv[1] + bias), o2 = bflo(uu.y) * (acc[ct][2] * nv[2] + bias), o3 = bfhi(uu.y) * (acc[ct][3] * nv[3] + bias);
            *(u32x2*)(AB + (size_t)tok * D + c) = (u32x2){cvt_pk_bf16(o0, o1), cvt_pk_bf16(o2, o3)}; }
    }
}

__device__ __forceinline__ unsigned offa(unsigned row, unsigned ch) { return 2048u * (row >> 3) + 512u * (ch >> 2) + 64u * (row & 7u) + 16u * ((ch & 3u) ^ ((row >> 2) & 3u)); }
template <int OFF>
__device__ __forceinline__ void tr4(unsigned a0, unsigned a1, bf16x8 (&f)[4]) {
    s16x4 r0, r1, r2, r3, r4, r5, r6, r7;
    asm volatile("ds_read_b64_tr_b16 %0, %8 offset:%10\n\tds_read_b64_tr_b16 %1, %9 offset:%10\n\t"
                 "ds_read_b64_tr_b16 %2, %8 offset:%11\n\tds_read_b64_tr_b16 %3, %9 offset:%11\n\t"
                 "ds_read_b64_tr_b16 %4, %8 offset:%12\n\tds_read_b64_tr_b16 %5, %9 offset:%12\n\t"
                 "ds_read_b64_tr_b16 %6, %8 offset:%13\n\tds_read_b64_tr_b16 %7, %9 offset:%13\n\t"
                 "s_waitcnt lgkmcnt(0)"
                 : "=&v"(r0), "=&v"(r1), "=&v"(r2), "=&v"(r3), "=&v"(r4), "=&v"(r5), "=&v"(r6), "=&v"(r7)
                 : "v"(a0), "v"(a1), "i"(OFF), "i"(OFF + 512), "i"(OFF + 1024), "i"(OFF + 1536) : "memory");
    f[0] = (bf16x8){r0[0], r0[1], r0[2], r0[3], r1[0], r1[1], r1[2], r1[3]}; f[1] = (bf16x8){r2[0], r2[1], r2[2], r2[3], r3[0], r3[1], r3[2], r3[3]};
    f[2] = (bf16x8){r4[0], r4[1], r4[2], r4[3], r5[0], r5[1], r5[2], r5[3]}; f[3] = (bf16x8){r6[0], r6[1], r6[2], r6[3], r7[0], r7[1], r7[2], r7[3]};
}
__device__ __forceinline__ void na_item2(const Ctx& cx, int l, int item) {
    const ArgView a = cx.av;
    const int tid = cx.tid, lane = cx.lane, w = cx.wave, fq = lane >> 4, fr = lane & 15;
    const bf16_t* P = (const bf16_t*)(a.ws_() + WS_P); bf16_t* OB = (bf16_t*)(a.ws_() + WS_A) + SGUW;
    const f32x2* rope = (const f32x2*)(a.ws_() + WS_ROPE);
    const bool isctx = item >= 512;
    int b, h, rq = 0;
    if (!isctx) { b = item >> 8; h = (item >> 5) & 7; rq = item & 31; } else { const int it = item - 512; b = it >> 3; h = it & 7; }
    LAS unsigned char* Kt = cx.lds; LAS unsigned char* Vt = cx.lds + 16384; LAS float* biasS = (LAS float*)(cx.lds + 131072);
    const unsigned vt_base = (unsigned)(size_t)Vt;
    const int R0 = 4 * rq, cseg = w & 3, qc = 16 * cseg + fr;
    const int r0a = min(max(R0 - 4, 0), GROWS - 8), r0e = min(max(R0 + 3 - 4, 0), GROWS - 8) + 7;
    const int nloc = isctx ? 0 : (r0e - r0a + 1), ntile = nloc + 4;
    int rA[2], r0w[2], qrow[2];
#pragma unroll
    for (int qt = 0; qt < 2; ++qt) { rA[qt] = R0 + 2 * (w >> 2) + qt; r0w[qt] = min(max(rA[qt] - 4, 0), GROWS - 8);
        qrow[qt] = isctx ? (MLAT + b * CTXL + 32 * w + 16 * qt + fr) : (b * SEQ + rA[qt] * GRID_W + qc); }
    const int cs = (cseg == 0) ? 0 : (cseg == 1 ? 8 : (cseg == 2 ? 24 : 32));
    const int cstart = min(max(qc - 8, 0), GRID_W - 16);
    if (!isctx) { const float* rpb = a.in_(12) + ((size_t)l * NH + h) * 15 * 31; for (int i = tid; i < 465; i += NTHR) biasS[i] = rpb[i] * 1.44269504f; }
    bf16x8 q[2][4];
    if (!isctx) {
#pragma unroll
        for (int qt = 0; qt < 2; ++qt) {
            const bf16_t* qsrc = P + (size_t)qrow[qt] * INW + 2048 + 128 * h + 8 * fq;
            u32x4 raw[4];
#pragma unroll
            for (int ks = 0; ks < 4; ++ks) raw[ks] = *(const u32x4*)(qsrc + 32 * ks);
#pragma unroll
            for (int ax = 0; ax < 2; ++ax) {
                const int pos = ax ? qc : rA[qt]; const f32x2* tp = rope + pos * 32 + 8 * fq;
                f32x4 x1a, x1b, x2a, x2b; pg8::unpack8(raw[2 * ax], x1a, x1b); pg8::unpack8(raw[2 * ax + 1], x2a, x2b);
                f32x4 o1a, o1b, o2a, o2b;
#pragma unroll
                for (int j = 0; j < 4; ++j) { const f32x2 csA = tp[j], csB = tp[4 + j];
                    o1a[j] = x1a[j] * csA.x - x2a[j] * csA.y; o2a[j] = x2a[j] * csA.x + x1a[j] * csA.y;
                    o1b[j] = x1b[j] * csB.x - x2b[j] * csB.y; o2b[j] = x2b[j] * csB.x + x1b[j] * csB.y; }
                const u32x4 p1 = pg8::pack8(o1a, o1b), p2 = pg8::pack8(o2a, o2b);
                q[qt][2 * ax] = __builtin_bit_cast(bf16x8, p1); q[qt][2 * ax + 1] = __builtin_bit_cast(bf16x8, p2);
            }
        }
    }
    auto stage = [&](int ti) {
        const bool loc = ti < nloc; const int buf = ti & 3;
        const size_t row0 = loc ? (size_t)(b * SEQ + (r0a + ti) * GRID_W) : (size_t)(MLAT + b * CTXL + 64 * (ti - nloc));
        unsigned ln = cx.lane; asm volatile("" : "+v"(ln));
#pragma unroll
        for (int i = 0; i < 2; ++i) {
            const unsigned o = 1024u * (2 * w + i) + 16u * ln, srow = 8u * (o >> 11) + ((o >> 6) & 7u), sch = 4u * ((o >> 9) & 3u) + (((o >> 4) & 3u) ^ ((srow >> 2) & 3u));
            const bf16_t* src = P + (row0 + srow) * INW + 3072 + 128 * h + 8 * sch;
            __builtin_amdgcn_global_load_lds((const unsigned*)src, (LAS unsigned*)(Kt + buf * 32768 + 1024 * (2 * w + i)), 16, 0, 0);
            __builtin_amdgcn_global_load_lds((const unsigned*)(src + 1024), (LAS unsigned*)(Vt + buf * 32768 + 1024 * (2 * w + i)), 16, 0, 0);
        }
    };
    float mrun[2] = {-1e30f, -1e30f}, lrun[2] = {0.f, 0.f};
    f32x4 oacc[2][8];
#pragma unroll
    for (int qt = 0; qt < 2; ++qt)
#pragma unroll
        for (int dt = 0; dt < 8; ++dt) oacc[qt][dt] = (f32x4){0.f, 0.f, 0.f, 0.f};
    const float sc_l2 = 0.08838834764831845f * 1.44269504f;

#define NA_SOFTMAX(QT, NT, SARR, PF) do { \
        float lm_ = -INFINITY; \
        _Pragma("unroll") for (int t_ = 0; t_ < NT; ++t_) _Pragma("unroll") for (int j_ = 0; j_ < 4; ++j_) lm_ = fmaxf(lm_, SARR[t_][j_]); \
        if (__any(lm_ > mrun[QT] + 8.0f)) { \
            float tm_ = fmaxf(lm_, __shfl_xor(lm_, 16)); tm_ = fmaxf(tm_, __shfl_xor(tm_, 32)); \
            const float mn_ = fmaxf(mrun[QT], tm_), al_ = __builtin_amdgcn_exp2f(mrun[QT] - mn_); mrun[QT] = mn_; lrun[QT] *= al_; \
            _Pragma("unroll") for (int dt_ = 0; dt_ < 8; ++dt_) oacc[QT][dt_] *= al_; } \
        float ps_ = 0.f; \
        _Pragma("unroll") for (int kb_ = 0; kb_ < NT / 2; ++kb_) { f32x4 p0_, p1_; \
            _Pragma("unroll") for (int j_ = 0; j_ < 4; ++j_) { p0_[j_] = __builtin_amdgcn_exp2f(SARR[2 * kb_][j_] - mrun[QT]); p1_[j_] = __builtin_amdgcn_exp2f(SARR[2 * kb_ + 1][j_] - mrun[QT]); ps_ += p0_[j_] + p1_[j_]; } \
            const u32x4 pk_ = pg8::pack8(p0_, p1_); PF[kb_] = __builtin_bit_cast(bf16x8, pk_); } \
        lrun[QT] += ps_; } while (0)

    stage(0); stage(1); stage(2);
#define NA_TILE_HEAD() \
        const int buf = ti & 3; \
        { const int rem = ntile - 1 - ti; \
          if (rem >= 2) asm volatile("s_waitcnt vmcnt(8) lgkmcnt(0)" ::: "memory"); else if (rem == 1) asm volatile("s_waitcnt vmcnt(4) lgkmcnt(0)" ::: "memory"); else asm volatile("s_waitcnt vmcnt(0) lgkmcnt(0)" ::: "memory"); } \
        __builtin_amdgcn_s_barrier(); asm volatile("" ::: "memory"); \
        if (ti + 3 < ntile) stage(ti + 3);
    for (int ti = 0; ti < nloc; ++ti) {
        NA_TILE_HEAD()
        unsigned lane_o = cx.lane; asm volatile("" : "+v"(lane_o));
        const unsigned fq_o = lane_o >> 4, fr_o = lane_o & 15u, krow_sel = 8u * (fr_o >> 2) + (fr_o & 3u), q_o = fr_o >> 2, p_o = lane_o & 3u;
        const LAS unsigned char* Kb = Kt + buf * 32768;
        const int kr = r0a + ti;
        auto block32 = [&](const unsigned keybase, const bool masked, const bool act0, const bool act1) {
            f32x4 s[2][2];
#pragma unroll
            for (int qt = 0; qt < 2; ++qt)
#pragma unroll
                for (int t = 0; t < 2; ++t) s[qt][t] = (f32x4){0.f, 0.f, 0.f, 0.f};
#pragma unroll
            for (int t = 0; t < 2; ++t) { const LAS unsigned char* kp_ = Kb + offa(keybase + krow_sel + 4 * t, fq_o);
#pragma unroll
                for (int ks = 0; ks < 4; ++ks) { const bf16x8 kf = *(const LAS bf16x8*)(kp_ + 512 * ks);
                    s[0][t] = __builtin_amdgcn_mfma_f32_16x16x32_bf16(kf, q[0][ks], s[0][t], 0, 0, 0);
                    s[1][t] = __builtin_amdgcn_mfma_f32_16x16x32_bf16(kf, q[1][ks], s[1][t], 0, 0, 0); }
                __builtin_amdgcn_sched_barrier(0); }
            bf16x8 pf[2][1];
#pragma unroll
            for (int qt = 0; qt < 2; ++qt) {
                if (masked) {
                    const bool act = qt ? act1 : act0;
                    const LAS float* brow = biasS + (kr - rA[qt] + 7) * 31 + 15 - qc;
#pragma unroll
                    for (int t = 0; t < 2; ++t)
#pragma unroll
                        for (int j = 0; j < 4; ++j) { const int kc = (int)keybase + 8 * (int)fq_o + 4 * t + j; const bool ok = act && (kc >= cstart) && (kc < cstart + 16);
                            const float bv = ok ? brow[kc] : 0.f; s[qt][t][j] = ok ? (s[qt][t][j] * sc_l2 + bv) : -INFINITY; }
                } else {
#pragma unroll
                    for (int t = 0; t < 2; ++t) s[qt][t] *= sc_l2;
                }
                if (qt == 0) NA_SOFTMAX(0, 2, s[0], pf[0]); else NA_SOFTMAX(1, 2, s[1], pf[1]);
            }
            const unsigned vrow0 = keybase + 8u * fq_o + q_o;
#pragma unroll
            for (int par = 0; par < 2; ++par) {
                const unsigned a0 = vt_base + buf * 32768 + offa(vrow0, 2u * par + (p_o >> 1)) + 8u * (p_o & 1u);
                const unsigned a1 = vt_base + buf * 32768 + offa(vrow0 + 4u, 2u * par + (p_o >> 1)) + 8u * (p_o & 1u);
                bf16x8 vf[4]; tr4<0>(a0, a1, vf);
#pragma unroll
                for (int i = 0; i < 4; ++i) { oacc[0][par + 2 * i] = __builtin_amdgcn_mfma_f32_16x16x32_bf16(vf[i], pf[0][0], oacc[0][par + 2 * i], 0, 0, 0);
                                              oacc[1][par + 2 * i] = __builtin_amdgcn_mfma_f32_16x16x32_bf16(vf[i], pf[1][0], oacc[1][par + 2 * i], 0, 0, 0); }
            }
        };
        const bool act0 = (kr >= r0w[0] && kr < r0w[0] + 8), act1 = (kr >= r0w[1] && kr < r0w[1] + 8);
        if (act0 || act1) block32((unsigned)cs, true, act0, act1);
    }
#pragma unroll
    for (int qt = 0; qt < 2; ++qt) { const bf16_t* qsrc = P + (size_t)qrow[qt] * INW + 2048 + 128 * h + 8 * fq;
#pragma unroll
        for (int ks = 0; ks < 4; ++ks) { const u32x4 raw = *(const u32x4*)(qsrc + 32 * ks); q[qt][ks] = __builtin_bit_cast(bf16x8, raw); } }
    for (int ti = nloc; ti < ntile; ++ti) {
        NA_TILE_HEAD()
        unsigned lane_o = cx.lane; asm volatile("" : "+v"(lane_o));
        const unsigned fq_o = lane_o >> 4, fr_o = lane_o & 15u, krow_sel = 8u * (fr_o >> 2) + (fr_o & 3u), q_o = fr_o >> 2, p_o = lane_o & 3u;
        const LAS unsigned char* Kb = Kt + buf * 32768;
        const int kr = r0a + ti;
        auto block32 = [&](const unsigned keybase, const bool masked, const bool act0, const bool act1) {
            f32x4 s[2][2];
#pragma unroll
            for (int qt = 0; qt < 2; ++qt)
#pragma unroll
                for (int t = 0; t < 2; ++t) s[qt][t] = (f32x4){0.f, 0.f, 0.f, 0.f};
#pragma unroll
            for (int t = 0; t < 2; ++t) { const LAS unsigned char* kp_ = Kb + offa(keybase + krow_sel + 4 * t, fq_o);
#pragma unroll
                for (int ks = 0; ks < 4; ++ks) { const bf16x8 kf = *(const LAS bf16x8*)(kp_ + 512 * ks);
                    s[0][t] = __builtin_amdgcn_mfma_f32_16x16x32_bf16(kf, q[0][ks], s[0][t], 0, 0, 0);
                    s[1][t] = __builtin_amdgcn_mfma_f32_16x16x32_bf16(kf, q[1][ks], s[1][t], 0, 0, 0); }
                __builtin_amdgcn_sched_barrier(0); }
            bf16x8 pf[2][1];
#pragma unroll
            for (int qt = 0; qt < 2; ++qt) {
                if (masked) {
                    const bool act = qt ? act1 : act0;
                    const LAS float* brow = biasS + (kr - rA[qt] + 7) * 31 + 15 - qc;
#pragma unroll
                    for (int t = 0; t < 2; ++t)
#pragma unroll
                        for (int j = 0; j < 4; ++j) { const int kc = (int)keybase + 8 * (int)fq_o + 4 * t + j; const bool ok = act && (kc >= cstart) && (kc < cstart + 16);
                            const float bv = ok ? brow[kc] : 0.f; s[qt][t][j] = ok ? (s[qt][t][j] * sc_l2 + bv) : -INFINITY; }
                } else {
#pragma unroll
                    for (int t = 0; t < 2; ++t) s[qt][t] *= sc_l2;
                }
                if (qt == 0) NA_SOFTMAX(0, 2, s[0], pf[0]); else NA_SOFTMAX(1, 2, s[1], pf[1]);
            }
            const unsigned vrow0 = keybase + 8u * fq_o + q_o;
#pragma unroll
            for (int par = 0; par < 2; ++par) {
                const unsigned a0 = vt_base + buf * 32768 + offa(vrow0, 2u * par + (p_o >> 1)) + 8u * (p_o & 1u);
                const unsigned a1 = vt_base + buf * 32768 + offa(vrow0 + 4u, 2u * par + (p_o >> 1)) + 8u * (p_o & 1u);
                bf16x8 vf[4]; tr4<0>(a0, a1, vf);
#pragma unroll
                for (int i = 0; i < 4; ++i) { oacc[0][par + 2 * i] = __builtin_amdgcn_mfma_f32_16x16x32_bf16(vf[i], pf[0][0], oacc[0][par + 2 * i], 0, 0, 0);
                                              oacc[1][par + 2 * i] = __builtin_amdgcn_mfma_f32_16x16x32_bf16(vf[i], pf[1][0], oacc[1][par + 2 * i], 0, 0, 0); }
            }
        };
        block32(0u, false, true, true);
        block32(32u, false, true, true);
    }
#undef NA_TILE_HEAD
#undef NA_SOFTMAX
#pragma unroll
    for (int qt = 0; qt < 2; ++qt) {
        float lt = lrun[qt]; lt += __shfl_xor(lt, 16); lt += __shfl_xor(lt, 32);
        const float inv = 1.0f / lt;
        bf16_t* op = OB + (size_t)qrow[qt] * D + 128 * h + 4 * fq;
#pragma unroll
        for (int dt = 0; dt < 8; ++dt) { const f32x4 o = oacc[qt][dt] * inv; *(u32x2*)(op + 16 * dt) = (u32x2){cvt_pk_bf16(o[0], o[1]), cvt_pk_bf16(o[2], o[3])}; }
    }
}

__device__ __forceinline__ void route_phase(const Ctx& cx, int l, int T, int dummy = 0) {
    const ArgView a = cx.av;
    const int lane = cx.lane, w = cx.wave, tid = cx.tid, fq = lane >> 4, fr = lane & 15;
    const bf16_t* xs = (const bf16_t*)(a.ws_() + WS_XS); bf16_t* hx = (bf16_t*)(a.ws_() + WS_HX); const bf16_t* WR = (const bf16_t*)(a.ws_() + (size_t)l * WSET_BYTES + WS_WR);
    const float* modl = (const float*)(a.ws_() + WS_CTL + CTL_MOD) + (size_t)l * 3 * 12288; const float* nw = a.in_(7) + (size_t)l * D;
    unsigned* cnt = (unsigned*)(a.ws_() + WS_CTL) + CW_CNT + 64 * l + 2048 * (dummy ? 1 : 0);
    int* re = (int*)(a.ws_() + WS_ROUTE + RT_E); float* rw = (float*)(a.ws_() + WS_ROUTE + RT_W); int* rpz = (int*)(a.ws_() + WS_ROUTE + RT_P);
    LAS int* lcnt = (LAS int*)(cx.lds + LDS_LCNT); LAS int* lbase = lcnt + 32;
    LAS float* red = (LAS float*)cx.lds;
    LAS float* lgS = (LAS float*)(cx.lds + 61440);
    if (tid < 32) lcnt[tid] = 0;
    const int bt0 = (int)((long)cx.bid * T / cx.G), bt1 = (int)((long)(cx.bid + 1) * T / cx.G), nb = bt1 - bt0;
    const int t0 = bt0 + w * nb / 8, t1 = bt0 + (w + 1) * nb / 8;
    if (dummy != 3) {
        f32x4 vA[8], vB[8]; int curcls = -1;
        for (int tok = t0; tok < t1; ++tok) {
            const int cls = tok < SEQ ? 0 : (tok < MLAT ? 1 : 2);
            if (cls != curcls) { curcls = cls; const float* mp = modl + cls * 12288;
#pragma unroll
                for (int j = 0; j < 8; ++j) { const int e = ROW_E(j); vA[j] = *(const f32x4*)(nw + e) * (*(const f32x4*)(mp + 4 * D + e) + 1.0f); vB[j] = *(const f32x4*)(mp + 3 * D + e); } }
            f32x4 v[8]; float ss = 0.f;
#pragma unroll
            for (int j = 0; j < 4; ++j) { const u32x4 r = __builtin_nontemporal_load((const u32x4*)(xs + (size_t)tok * D + 8 * (lane + 64 * j))); pg8::unpack8(r, v[2 * j], v[2 * j + 1]); }
#pragma unroll
            for (int j = 0; j < 8; ++j) ss += (v[j][0] * v[j][0] + v[j][1] * v[j][1]) + (v[j][2] * v[j][2] + v[j][3] * v[j][3]);
            const float rstd = 1.0f / sqrtf(wave_sum(ss) * (1.0f / D) + RMS_EPS);
#pragma unroll
            for (int j = 0; j < 4; ++j) *(u32x4*)(hx + (size_t)tok * D + 8 * (lane + 64 * j)) = pg8::pack8(v[2 * j] * rstd * vA[2 * j] + vB[2 * j], v[2 * j + 1] * rstd * vA[2 * j + 1] + vB[2 * j + 1]);
            if (I8SEL(MK_I8E, l)) {
                float hmax = 0.f;
#pragma unroll
                for (int j = 0; j < 8; ++j) { v[j] = v[j] * rstd * vA[j] + vB[j]; hmax = fmaxf(hmax, fmaxf(fmaxf(fabsf(v[j][0]), fabsf(v[j][1])), fmaxf(fabsf(v[j][2]), fabsf(v[j][3])))); }
#pragma unroll
                for (int o = 1; o < 64; o <<= 1) hmax = fmaxf(hmax, __shfl_xor(hmax, o));
                hmax = fmaxf(hmax, 1e-20f); const float inv = 127.0f / hmax;
                unsigned char* h8 = a.ws_() + WS_HX8 + (size_t)tok * D;
#pragma unroll
                for (int j = 0; j < 4; ++j) *(u32x2*)(h8 + 8 * (lane + 64 * j)) = (u32x2){pk4_i8(v[2 * j][0] * inv, v[2 * j][1] * inv, v[2 * j][2] * inv, v[2 * j][3] * inv), pk4_i8(v[2 * j + 1][0] * inv, v[2 * j + 1][1] * inv, v[2 * j + 1][2] * inv, v[2 * j + 1][3] * inv)};
                if (lane == 0) ((float*)(a.ws_() + WS_SX))[tok] = hmax * (1.0f / 127.0f);
            }
        }
    }
    VM_WAIT();
    __syncthreads();
    if (dummy != 2) {
        const int kq = w & 3, th = w >> 2, tile0 = th ? 3 : 0, ntl = th ? 2 : 3;
        const bf16_t* hp[3];
#pragma unroll
        for (int i = 0; i < 3; ++i) { const int tk = min(bt0 + 16 * (tile0 + i) + fr, bt1 - 1); hp[i] = hx + (size_t)tk * D + 512 * kq + 8 * fq; }
        const bf16_t* wp = WR + ((size_t)(16 * kq) * 64 + lane) * 8;
        f32x4 acc[3][3];
#pragma unroll
        for (int i = 0; i < 3; ++i)
#pragma unroll
            for (int mt = 0; mt < 3; ++mt) acc[i][mt] = (f32x4){0.f, 0.f, 0.f, 0.f};
        const int ksrot = cx.bid & 15;
#pragma unroll 4
        for (int ks0 = 0; ks0 < 16; ++ks0) { const int ks = (ks0 + ksrot) & 15;
            bf16x8 af[3], bfv[3];
#pragma unroll
            for (int mt = 0; mt < 3; ++mt) { const u32x4 t_ = *(const u32x4*)(wp + ((size_t)mt * 64 + ks) * 512); af[mt] = __builtin_bit_cast(bf16x8, t_); }
#pragma unroll
            for (int i = 0; i < 3; ++i) if (i < ntl) { const u32x4 t_ = *(const u32x4*)(hp[i] + 32 * ks); bfv[i] = __builtin_bit_cast(bf16x8, t_); }
#pragma unroll
            for (int i = 0; i < 3; ++i) if (i < ntl)
#pragma unroll
                for (int mt = 0; mt < 3; ++mt) acc[i][mt] = __builtin_amdgcn_mfma_f32_16x16x32_bf16(af[mt], bfv[i], acc[i][mt], 0, 0, 0);
        }
#pragma unroll
        for (int i = 0; i < 3; ++i) if (i < ntl)
#pragma unroll
            for (int mt = 0; mt < 3; ++mt) *(LAS f32x4*)(red + (((kq * 5 + tile0 + i) * 3 + mt) * 64 + lane) * 4) = acc[i][mt];
    }
    __syncthreads();
    for (int idx = tid; idx < 80 * 48; idx += NTHR) { const int ts = idx / 48, o = idx % 48, tile = ts >> 4, f_r = ts & 15, mt = o >> 4, r = o & 15, ln = (r >> 2) * 16 + f_r, rg = r & 3;
        float sum = 0.f;
#pragma unroll
        for (int kq = 0; kq < 4; ++kq) sum += red[(((kq * 5 + tile) * 3 + mt) * 64 + ln) * 4 + rg];
        lgS[idx] = sum; }
    __syncthreads();
    int e0 = 0, e1 = 0; float w0 = 0.f, w1 = 0.f; int p0 = 0, p1 = 0;
    if (tid < nb) {
        const float* bre = a.in_(21) + (size_t)l * NEXP; const float* brg = a.in_(19) + (size_t)l * 4;
        const LAS float* lg = lgS + tid * 48;
        float g[4]; int gi = 0; float gm = -INFINITY;
#pragma unroll
        for (int j = 0; j < 4; ++j) { g[j] = lg[32 + j] + brg[j]; if (g[j] > gm) { gm = g[j]; gi = j; } }
        float gs = 0.f;
#pragma unroll
        for (int j = 0; j < 4; ++j) { float ev = __expf(g[j] - gm); asm volatile("" : "+v"(ev)); gs += ev; }
        const float gp = __builtin_amdgcn_rcpf(gs);
        float v0 = -INFINITY, v1 = -INFINITY; int i0 = 0, i1 = 0;
        for (int j = 0; j < 8; ++j) { const float x = lg[8 * gi + j] + bre[8 * gi + j];
            if (x > v0) { v1 = v0; i1 = i0; v0 = x; i0 = j; } else if (x > v1) { v1 = x; i1 = j; } }
        float ex = __expf(v1 - v0); asm volatile("" : "+v"(ex)); const float den = __builtin_amdgcn_rcpf(1.0f + ex);
        e0 = 8 * gi + i0; e1 = 8 * gi + i1; w0 = gp * den; w1 = gp * ex * den;
        p0 = atomicAdd((int*)&lcnt[e0], 1); p1 = atomicAdd((int*)&lcnt[e1], 1);
    }
    __syncthreads();
    if (tid < 32) { const int c = lcnt[tid]; lbase[tid] = c ? (int)__hip_atomic_fetch_add(cnt + tid, (unsigned)c, __ATOMIC_RELAXED, __HIP_MEMORY_SCOPE_AGENT) : 0; }
    __syncthreads();
    if (tid < nb) { const int tok = bt0 + tid;
        re[tok] = e0; re[MALL + tok] = e1; rw[tok] = w0; rw[MALL + tok] = w1; rpz[tok] = lbase[e0] + p0; rpz[MALL + tok] = lbase[e1] + p1; }
    __syncthreads();
}

__device__ __forceinline__ void load_tprefix(const Ctx& cx, int l) {
    const unsigned* cnt = (const unsigned*)(cx.av.ws_() + WS_CTL) + CW_CNT + 64 * l;
    LAS int* tp = (LAS int*)(cx.lds + LDS_TP);
    if (cx.tid < 64) {
        const int c = cx.tid < 32 ? ((int)__hip_atomic_load(cnt + (cx.tid & 31), __ATOMIC_RELAXED, __HIP_MEMORY_SCOPE_AGENT) + 255) >> 8 : 0;
        int v = c;
#pragma unroll
        for (int o = 1; o < 32; o <<= 1) { const int t = __shfl_up(v, o); if ((int)cx.lane >= o) v += t; }
        if (cx.tid < 32) tp[cx.tid] = v - c;
        if (cx.tid == 31) tp[32] = v;
    }
    __syncthreads();
}
__device__ __forceinline__ void dispatch_phase(const Ctx& cx, int l, int T) {
    const ArgView a = cx.av;
    const int lane = cx.lane;
    const unsigned* cnt = (const unsigned*)(a.ws_() + WS_CTL) + CW_CNT + 64 * l;
    const LAS int* tp = (const LAS int*)(cx.lds + LDS_TP);
    const int* re = (const int*)(a.ws_() + WS_ROUTE + RT_E); const float* rw = (const float*)(a.ws_() + WS_ROUTE + RT_W); const int* rpz = (const int*)(a.ws_() + WS_ROUTE + RT_P);
    int* tokslot = (int*)(a.ws_() + WS_ROUTE + RT_TS); float* wslot = (float*)(a.ws_() + WS_ROUTE + RT_WS);
    const int gw = cx.bid * NWAVES + cx.wave, NGW = cx.G * NWAVES;
    const int t0 = (int)((long)gw * T / NGW), t1 = (int)((long)(gw + 1) * T / NGW);
    for (int tok = t0 + lane; tok < t1; tok += 64) {
        const int ea = re[tok], eb = re[MALL + tok];
        const int sa = 256 * tp[ea] + rpz[tok], sb = 256 * tp[eb] + rpz[MALL + tok];
        tokslot[sa] = 2 * tok; tokslot[sb] = 2 * tok + 1; wslot[sa] = rw[tok]; wslot[sb] = rw[MALL + tok];
    }
    {
        const int e = gw & 31, sub = gw >> 5, nsub = NGW >> 5;
        const int c = (int)__hip_atomic_load(cnt + e, __ATOMIC_RELAXED, __HIP_MEMORY_SCOPE_AGENT), base = 256 * tp[e], padn = (256 - (c & 255)) & 255;
        for (int j = sub + nsub * lane; j < padn; j += 64 * nsub) { const int s = base + c + j; tokslot[s] = -1; wslot[s] = 0.f; }
    }
}
__device__ __forceinline__ void copy_x_phase(const Ctx& cx, int l, int T) {
    const ArgView a = cx.av; if (l != 0) return;
    bf16_t* xs = (bf16_t*)(a.ws_() + WS_XS);
    for (size_t i = (size_t)cx.bid * NTHR + cx.tid; i < (size_t)T * D / 4; i += (size_t)cx.G * NTHR) {
        const size_t e = i * 4; const float* src = e < (size_t)MLAT * D ? a.in_(0) + e : a.in_(2) + (e - (size_t)MLAT * D);
        const f32x4 v = *(const f32x4*)src; *(u32x2*)(xs + e) = (u32x2){cvt_pk_bf16(v[0], v[1]), cvt_pk_bf16(v[2], v[3])}; }
}

__global__ void __launch_bounds__(NTHR, 2) fwd_kernel(Args args) {
    extern __shared__ __attribute__((aligned(16))) unsigned char lds_raw[];
    Ctx cx; cx.lds = (LAS unsigned char*)lds_raw; cx.tid = threadIdx.x; cx.lane = cx.tid & 63; cx.wave = __builtin_amdgcn_readfirstlane(cx.tid >> 6); cx.G = gridDim.x; cx.bid = blockIdx.x;
    cx.av.kp = (const CAS unsigned char*)__builtin_amdgcn_kernarg_segment_ptr();
#define FRESH() do { int t_ = threadIdx.x; asm volatile("" : "+v"(t_)); cx.tid = t_; cx.lane = t_ & 63; cx.wave = __builtin_amdgcn_readfirstlane(t_ >> 6); \
        const CAS unsigned char* k_ = (const CAS unsigned char*)__builtin_amdgcn_kernarg_segment_ptr(); asm volatile("" : "+s"(k_)); cx.av.kp = k_; \
        int g_ = gridDim.x; asm volatile("" : "+s"(g_)); cx.G = g_; int b_ = blockIdx.x; asm volatile("" : "+s"(b_)); cx.bid = b_; } while (0)
    for (int u = cx.tid; u < (LDS_BYTES - LDSCTL_OFF) / 4; u += NTHR) ((LAS unsigned*)(cx.lds + LDSCTL_OFF))[u] = 0u;
    __syncthreads();
    XcdBarrier bar; bar.bar = (unsigned*)(args.ws + WS_CTL) + CW_BAR; bar.x = 0; bar.st = nullptr;
    if (!MK_PER_PHASE) bar = xcd_barrier_post((unsigned*)(args.ws + WS_CTL) + CW_BAR, (volatile LAS unsigned*)(cx.lds + LDS_MISC));
    const int lo = args.ph_lo, hi = args.ph_hi;
#define IN(k) (lo <= (k) && (k) < hi)
#define SEAM(k) do { if (IN(k) && IN((k) + 1)) xcd_barrier(bar); } while (0)

    if (IN(0)) for (int rep = 0; rep < DUPN(0); ++rep) { FRESH(); if (MK_BUILD & 1) p0_adaln(cx); if (MK_BUILD & 2) pw_convert0(cx); __syncthreads(); }
    SEAM(0);
    for (int l = 0; l < 2; ++l) {
        const int pb = 1 + 9 * l;
        const bool mix_on = (MK_MASK >> (2 * l)) & 1, moe_on = (MK_MASK >> (2 * l + 1)) & 1;
        const int Mact = l == 0 ? MALL : MLAT;
        if (IN(pb + 0)) { FRESH(); if (MK_BUILD & 4) { if (l == 0) { for (int rep = 0; rep < DUPN(1); ++rep) norm_phase<0>(cx, MALL); if ((MK_I8GATE != 0) && ((MK_BUILD & 2) != 0)) { __syncthreads(); conv_gate0(cx); } } else { norm_phase<1>(cx, MALL); __syncthreads(); if ((MK_BUILD & 2) && CQ_F0 < CV_EXP + CV_DENSE) conv_range(cx, CQ_F0, CV_EXP + CV_DENSE, cx.bid, cx.G); } } }
        SEAM(pb + 0);
        if ((MK_BUILD & 0x38) && IN(pb + 1) && mix_on) { FRESH();
            unsigned char* ws = cx.av.ws_();
            unsigned* pdone = (unsigned*)(ws + WS_CTL) + CW_PD8 + 128 * l; unsigned* qhead = (unsigned*)(ws + WS_CTL) + CW_QB + 64 * l;
            const int Gg = gemm_wgs((MALL / 256) * (NCOMB / 256), cx.G);
            if (cx.bid < Gg) {
            if (MK_I8GATE) {
                if (MK_I8IN) { pg8::Gemm g{(const bf16_t*)(ws + WS_HX8), D / 2, (const bf16_t*)(ws + (size_t)l * WSET_BYTES + WS_WC), 0, D / 2}; pg8::StaticOrder S; S.init(MALL, INW, Gg, cx.bid);
                  const float amax_in = __uint_as_float(__hip_atomic_load((const unsigned*)(ws + WS_CTL) + CW_GMAX + 2 + l, __ATOMIC_RELAXED, __HIP_MEMORY_SCOPE_AGENT));
                  pg8::EpiInProj E{(bf16_t*)(ws + WS_P), (bf16_t*)(ws + WS_G), cx.av.in_(14) + (size_t)l * GATEW, (const f32x2*)(ws + WS_ROPE), pdone, (const float*)(ws + WS_SX), amax_in * (1.0f / 127.0f)};
                  pg8::gemm_phase<pg8::EpiInProj, pg8::StaticOrder, false, true>(cx.lds, g, S, E); }
                else { pg8::Gemm g{(const bf16_t*)(ws + WS_HX), D, (const bf16_t*)(ws + (size_t)l * WSET_BYTES + WS_WC), 0, D}; pg8::StaticOrder S; S.init(MALL, INW, Gg, cx.bid);
                  pg8::EpiInProj E{(bf16_t*)(ws + WS_P), (bf16_t*)(ws + WS_G), cx.av.in_(14) + (size_t)l * GATEW, (const f32x2*)(ws + WS_ROPE), pdone, nullptr, 0.f};
                  pg8::gemm_phase(cx.lds, g, S, E); }
                { FRESH(); unsigned char* ws2 = cx.av.ws_();
                  pg8::Gemm g{(const bf16_t*)(ws2 + WS_HX8), D / 2, (const bf16_t*)(ws2 + (size_t)l * WSET_BYTES + WS_WC + (size_t)INW * D * 2), 0, D / 2}; pg8::StaticOrder S; S.init(MALL, GATEW, Gg, cx.bid);
                  const float amax = __uint_as_float(__hip_atomic_load((const unsigned*)(ws2 + WS_CTL) + CW_GMAX + l, __ATOMIC_RELAXED, __HIP_MEMORY_SCOPE_AGENT));
                  pg8::EpiGate8 E{(bf16_t*)(ws2 + WS_G), cx.av.in_(14) + (size_t)l * GATEW, (const float*)(ws2 + WS_SX), amax * (1.0f / 127.0f)};
                  pg8::gemm_phase<pg8::EpiGate8, pg8::StaticOrder, false, true>(cx.lds, g, S, E); }
            } else {
            pg8::Gemm g{(const bf16_t*)(ws + WS_HX), D, (const bf16_t*)(ws + (size_t)l * WSET_BYTES + WS_WC), 0, D}; pg8::SplitOrder S; S.init(MALL, INW, GATEW, Gg, cx.bid);
            pg8::EpiInProj E{(bf16_t*)(ws + WS_P), (bf16_t*)(ws + WS_G), cx.av.in_(14) + (size_t)l * GATEW, (const f32x2*)(ws + WS_ROPE), pdone, nullptr, 0.f};
            pg8::gemm_phase(cx.lds, g, S, E); } }
            if (MK_BUILD & 2) { FRESH(); if (l == 0) conv_side(cx, Gg, 0, CQ_A0); else conv_side(cx, Gg, CQ_F0 > CV_EXP + CV_DENSE ? CQ_F0 : CV_EXP + CV_DENSE, CQ_A1); __syncthreads(); }
            FRESH();
            if (cx.wave == 0) {
                const unsigned need = (unsigned)((MALL / 256) * (INW / 256)); unsigned sp = 0;
                for (;;) { const unsigned v_ = cx.lane < NWAVES ? __hip_atomic_load(pdone + 16 * (cx.lane & 7), __ATOMIC_RELAXED, __HIP_MEMORY_SCOPE_AGENT) : need;
                    if (__builtin_amdgcn_ballot_w64(v_ < need) == 0ull) break; __builtin_amdgcn_s_sleep(2); if (++sp > XB_SPIN_CAP) break; }
                __builtin_amdgcn_fence(__ATOMIC_ACQUIRE, "agent");
                asm volatile("s_waitcnt vmcnt(0)" ::: "memory");
            }
            __syncthreads();
            const int n_na = 512, n_sgu = 256, n_cna = (l == 0 ? 16 : 0), n_csg = (l == 0 ? 32 : 0), n_items = n_na + n_sgu + n_cna + n_csg;
            LAS int* qslot = (LAS int*)(cx.lds + LDS_MISC + 64);
            for (;;) {
                if (cx.tid == 0) qslot[0] = (int)__hip_atomic_fetch_add(qhead, 1u, __ATOMIC_RELAXED, __HIP_MEMORY_SCOPE_AGENT);
                __syncthreads();
                const int it = qslot[0];
                __syncthreads();
                if (it >= n_items) break;
                FRESH();
                const bool is_na = it < n_na || (it >= n_na + n_sgu && it < n_na + n_sgu + n_cna);
                const int id = it < n_na ? it : (it < n_na + n_sgu ? it - n_na : (it < n_na + n_sgu + n_cna ? 512 + (it - n_na - n_sgu) : 256 + (it - n_na - n_sgu - n_cna)));
                if (is_na) na_item2(cx, l, id); else sgu_item(cx, l, id);
                __syncthreads();
            }
        }
        SEAM(pb + 2);
        if ((MK_BUILD & 0x40) && IN(pb + 3) && mix_on) for (int rep = 0; rep < DUPN(4); ++rep) {
            FRESH(); unsigned char* ws = cx.av.ws_();
            const bool i8m = I8SEL(MK_I8M, l);
            if (i8m) {
                const unsigned* ctl = (const unsigned*)(ws + WS_CTL);
                const float swa = __uint_as_float(ctl[CW_GMAX + 6 + 2 * l]) * (1.0f / 127.0f), swb = __uint_as_float(ctl[CW_GMAX + 7 + 2 * l]) * (1.0f / 127.0f);
                quant_rows_ao(cx, (const bf16_t*)(ws + WS_A), ws + WS_HX8, (float*)(ws + WS_SX), (float*)(ws + WS_SX) + MALL, swa, swb, Mact);
                VM_WAIT(); xcd_barrier(bar); FRESH(); ws = cx.av.ws_(); }
            const int Gg = gemm_wgs((Mact / 256) * (D / 256), cx.G);
            if (cx.bid < Gg) {
            pg8::StaticOrder S; S.init(Mact, D, Gg, cx.bid);
            if (i8m) {
                pg8::Gemm g{(const bf16_t*)(ws + WS_HX8), D / 2, (const bf16_t*)(ws + (size_t)l * WSET_BYTES + WS_WA), 0, D / 2};
                pg8::EpiMergeI8 E{(bf16_t*)(ws + WS_T), (const bf16_t*)(ws + WS_G), (const float*)(ws + WS_SX), (const float*)(ws + WS_SX) + MALL};
                pg8::gemm_phase<pg8::EpiMergeI8, pg8::StaticOrder, false, true>(cx.lds, g, S, E);
            } else {
            pg8::Gemm g{(const bf16_t*)(ws + WS_A), D, (const bf16_t*)(ws + (size_t)l * WSET_BYTES + WS_WA), 0, D};
            pg8::EpiMergeF E{(bf16_t*)(ws + WS_T), (const bf16_t*)(ws + WS_G)}; pg8::gemm_phase(cx.lds, g, S, E); } }
            if (l == 0 && (MK_BUILD & 2)) { FRESH(); conv_side(cx, Gg, CQ_A0, CQ_C1B); __syncthreads(); }
        }
        SEAM(pb + 3);
        if (IN(pb + 4)) for (int rep = 0; rep < (l == 0 ? DUPN(5) : 1); ++rep) { FRESH();
            if ((MK_BUILD & 0x80) && mix_on) {
                unsigned char* ws = cx.av.ws_(); bf16_t* XS = (bf16_t*)(ws + WS_XS);
                const int Gg = gemm_wgs((Mact / 256) * (D / 256), cx.G);
                const bool i8o = I8SEL(MK_I8O, l);
                if (i8o) {
                    quant_rows2048(cx, (const bf16_t*)(ws + WS_T), ws + WS_HX8, (float*)(ws + WS_SX), Mact);
                    VM_WAIT(); xcd_barrier(bar); FRESH(); ws = cx.av.ws_(); XS = (bf16_t*)(ws + WS_XS); }
                if (cx.bid < Gg) {
                pg8::StaticOrder S; S.init(Mact, D, Gg, cx.bid);
                const float* modl_ = (const float*)(ws + WS_CTL + CTL_MOD) + (size_t)l * 3 * 12288;
                if (i8o) {
                    pg8::Gemm g{(const bf16_t*)(ws + WS_HX8), D / 2, (const bf16_t*)(ws + (size_t)l * WSET_BYTES + WS_WO), 0, D / 2};
                    const float sw = __uint_as_float(((const unsigned*)(ws + WS_CTL))[CW_GMAX + 4 + l]) * (1.0f / 127.0f); const float* sx = (const float*)(ws + WS_SX);
                    if (l == 0) { pg8::EpiOut<true> E{cx.av.in_(0), cx.av.in_(2), XS, modl_, sx, sw}; pg8::gemm_phase<pg8::EpiOut<true>, pg8::StaticOrder, false, true>(cx.lds, g, S, E); }
                    else { pg8::EpiOut<false> E{nullptr, nullptr, XS, modl_, sx, sw}; pg8::gemm_phase<pg8::EpiOut<false>, pg8::StaticOrder, false, true>(cx.lds, g, S, E); }
                } else {
                pg8::Gemm g{(const bf16_t*)(ws + WS_T), D, (const bf16_t*)(ws + (size_t)l * WSET_BYTES + WS_WO), 0, D};
                if (l == 0) { pg8::EpiOut<true> E{cx.av.in_(0), cx.av.in_(2), XS, modl_, nullptr, 0.f}; pg8::gemm_phase(cx.lds, g, S, E); }
                else { pg8::EpiOut<false> E{nullptr, nullptr, XS, modl_, nullptr, 0.f}; pg8::gemm_phase(cx.lds, g, S, E); } } }
                if (l == 0 && (MK_BUILD & 2)) { FRESH(); conv_side(cx, Gg, CQ_C1B, CQ_C2); __syncthreads(); }
            } else copy_x_phase(cx, l, Mact);
        }
        SEAM(pb + 4);
        if ((MK_BUILD & 0x100) && IN(pb + 5) && moe_on) { if (MK_DUP & 0x400) { FRESH(); route_phase(cx, l, Mact, 1 + ((MK_DUP >> 13) & 3)); __syncthreads(); } FRESH(); route_phase(cx, l, Mact); }
        SEAM(pb + 5);
        if ((MK_BUILD & 0x200) && IN(pb + 6) && moe_on) for (int rep = 0; rep < DUPN(6); ++rep) { FRESH(); load_tprefix(cx, l); dispatch_phase(cx, l, Mact); __syncthreads(); if (l == 1 && (MK_BUILD & 2)) conv_range(cx, CQ_A1, CQ_TOTAL, cx.bid, cx.G); }
        SEAM(pb + 6);
        if ((MK_BUILD & 0x400) && IN(pb + 7) && moe_on) for (int rep = 0; rep < DUPN(7); ++rep) { FRESH();
            load_tprefix(cx, l); unsigned char* ws = cx.av.ws_();
            const int Gg = gemm_wgs(((const LAS int*)(cx.lds + LDS_TP))[32] * (1024 / 256), cx.G);
            if (cx.bid < Gg) {
            pg8::GroupedOrder S; S.init((const LAS int*)(cx.lds + LDS_TP), 1024, Gg, cx.bid);
            if (I8SEL(MK_I8E, l)) {
                pg8::Gemm g{(const bf16_t*)(ws + WS_HX8), D / 2, (const bf16_t*)(ws + (size_t)l * WSET_BYTES + WS_WGU), (size_t)1024 * D / 2, D / 2};
                pg8::EpiGateUp8 E{(bf16_t*)(ws + WS_HID), (const int*)(ws + WS_ROUTE + RT_TS), (const float*)(ws + WS_SX), (const unsigned*)(ws + WS_CTL) + CW_EMAX + 64 * l};
                pg8::gemm_phase<pg8::EpiGateUp8, pg8::GroupedOrder, true, true>(cx.lds, g, S, E, (const int*)(ws + WS_ROUTE + RT_TS));
            } else {
            pg8::Gemm g{(const bf16_t*)(ws + WS_HX)  , D, (const bf16_t*)(ws + (size_t)l * WSET_BYTES + WS_WGU), (size_t)1024 * D, D};
            pg8::EpiGateUp E{(bf16_t*)(ws + WS_HID)};
            pg8::gemm_phase<pg8::EpiGateUp, pg8::GroupedOrder, true>(cx.lds, g, S, E, (const int*)(ws + WS_ROUTE + RT_TS)); } }
            if (l == 0 && (MK_BUILD & 2)) { FRESH(); conv_side(cx, Gg, CQ_C2, CQ_E0); __syncthreads(); }
        }
        SEAM(pb + 7);
        if ((MK_BUILD & 0x800) && IN(pb + 8) && moe_on) for (int rep = 0; rep < DUPN(8); ++rep) { FRESH();
            load_tprefix(cx, l); unsigned char* ws = cx.av.ws_();
            const bool i8d = I8SEL(MK_I8D, l);
            if (i8d) {
                quant_rows512(cx, (const bf16_t*)(ws + WS_HID), ws + WS_T, (float*)(ws + WS_T + ((size_t)32 << 20)), (const float*)(ws + WS_ROUTE + RT_WS), ((const LAS int*)(cx.lds + LDS_TP))[32] * 256);
                VM_WAIT(); xcd_barrier(bar); FRESH(); ws = cx.av.ws_(); }
            const int Gg = gemm_wgs(((const LAS int*)(cx.lds + LDS_TP))[32] * (D / 256), cx.G);
            if (cx.bid < Gg) {
            pg8::GroupedOrder S; S.init((const LAS int*)(cx.lds + LDS_TP), D, Gg, cx.bid);
            if (i8d) {
                int kk = DEXP / 2; asm volatile("" : "+s"(kk));
                pg8::Gemm g{(const bf16_t*)(ws + WS_T), kk, (const bf16_t*)(ws + (size_t)l * WSET_BYTES + WS_WD), (size_t)D * DEXP / 2, kk};
                pg8::EpiDown<true> E{(bf16_t*)(ws + WS_G)  , (const int*)(ws + WS_ROUTE + RT_TS), (const float*)(ws + WS_T + ((size_t)32 << 20)), (const unsigned*)(ws + WS_CTL) + CW_DMAX + 32 * l};
                pg8::gemm_phase<pg8::EpiDown<true>, pg8::GroupedOrder, false, true>(cx.lds, g, S, E);
            } else {
            pg8::Gemm g{(const bf16_t*)(ws + WS_HID), DEXP, (const bf16_t*)(ws + (size_t)l * WSET_BYTES + WS_WD), (size_t)D * DEXP, DEXP};
            pg8::EpiDown<false> E{(bf16_t*)(ws + WS_G)  , (const int*)(ws + WS_ROUTE + RT_TS), (const float*)(ws + WS_ROUTE + RT_WS), nullptr};
            pg8::gemm_phase(cx.lds, g, S, E); } }
            if (l == 0 && (MK_BUILD & 2)) { FRESH(); conv_side(cx, Gg, CQ_E0, CQ_F0); __syncthreads(); }
        }
        SEAM(pb + 8);
    }
    if ((MK_BUILD & 0x1000) && IN(19)) for (int rep = 0; rep < DUPN(9); ++rep) { FRESH(); norm_phase<2>(cx, MLAT); }
#undef IN
#undef SEAM
#undef FRESH
}

extern "C" void kernel_launch(void* const* d_in, const int* in_sizes, int n_in, void* d_out, int out_size, void* d_ws, size_t ws_size, hipStream_t stream) {
    static int grid = 0;
    if (grid == 0) {
        if (n_in != 26 || out_size != MLAT * D || ws_size < WS_END) { fprintf(stderr, "kernel_launch: unexpected problem (n_in %d, out %d, ws %zu < %zu)\n", n_in, out_size, ws_size, (size_t)WS_END); grid = -1; return; }
        int dev = 0, cus = 0, per_cu = 0;
        if (hipGetDevice(&dev) != hipSuccess || hipDeviceGetAttribute(&cus, hipDeviceAttributeMultiprocessorCount, dev) != hipSuccess) { grid = -1; return; }
        if (hipFuncSetAttribute((const void*)fwd_kernel, hipFuncAttributeMaxDynamicSharedMemorySize, LDS_BYTES) != hipSuccess) { fprintf(stderr, "kernel_launch: hipFuncSetAttribute failed\n"); grid = -1; return; }
        if (hipOccupancyMaxActiveBlocksPerMultiprocessor(&per_cu, (const void*)fwd_kernel, NTHR, LDS_BYTES) != hipSuccess || per_cu < 1) { fprintf(stderr, "kernel_launch: occupancy query says %d\n", per_cu); }
        (void)hipGetLastError();
        grid = cus;
    }
    if (grid < 0) return;
    (void)hipMemsetAsync((char*)d_ws + WS_CTL, 0, 65536, stream);
    Args a{};
    for (int i = 0; i < 26; ++i) a.in[i] = (const float*)d_in[i];
    a.out = (float*)d_out; a.ws = (unsigned char*)d_ws;
#if MK_PER_PHASE
    for (int p = 0; p < NPHASE; ++p) { a.ph_lo = p; a.ph_hi = p + 1; hipLaunchKernelGGL(fwd_kernel, dim3(grid), dim3(NTHR), LDS_BYTES, stream, a); }
#else
    a.ph_lo = 0; a.ph_hi = NPHASE; hipLaunchKernelGGL(fwd_kernel, dim3(grid), dim3(NTHR), LDS_BYTES, stream, a);
#endif
}
```

```cpp
#include <hip/hip_runtime.h>
#include <cstdio>
#include <cstdint>

#ifndef MK_PER_PHASE
#define MK_PER_PHASE 0
#endif
#ifndef MK_I8GATE
#define MK_I8GATE 1
#endif
#ifndef MK_I8IN
#define MK_I8E 3
#define MK_I8O 3
#define I8SEL(mask, l) ((mask) == 3 ? true : ((mask) == 0 ? false : ((((mask) >> (l)) & 1) != 0)))
#define MK_I8M 3
#define MK_I8D 3
#define MK_I8IN 1
#endif
#ifndef MK_DUP
#define MK_DUP 0
#endif
#define DUPN(k) (1 + ((MK_DUP >> (k)) & 1))
#ifndef MK_BUILD
#define MK_BUILD 0xFFFF
#endif
#ifndef MK_MASK
#define MK_MASK 15
#endif

#define LAS __attribute__((address_space(3)))
typedef unsigned short bf16_t;
typedef short bf16x8 __attribute__((ext_vector_type(8)));
typedef short s16x4 __attribute__((ext_vector_type(4)));
typedef float f32x4 __attribute__((ext_vector_type(4)));
typedef float f32x2 __attribute__((ext_vector_type(2)));
typedef unsigned u32x4 __attribute__((ext_vector_type(4)));
typedef unsigned u32x2 __attribute__((ext_vector_type(2)));

constexpr int D = 2048, SEQ = 8192, GRID_W = 64, GROWS = 128, CTXL = 256;
constexpr int MLAT = 16384, MCTX = 512, MALL = 16896;
constexpr int SGUW = 1024, NH = 8, HDIM = 128, INW = 5120, GATEW = 4096, NCOMB = 9216;
constexpr int NEXP = 32, DEXP = 512, SLOTS = 41984;
constexpr float RMS_EPS = 1e-6f;
constexpr int NWAVES = 8, NTHR = 512;
#ifndef CQ_SET
#define CQ_SET 0
#endif
#if CQ_SET == 0
constexpr int CQ_A0 = 7500, CQ_C1A = 0, CQ_C1B = 22500, CQ_C2 = 38500, CQ_E0 = 43500, CQ_F0 = 45500, CQ_A1 = 55808;
#elif CQ_SET == 1
constexpr int CQ_A0 = 7000, CQ_C1A = 10000, CQ_C1B = 13000, CQ_C2 = 24576, CQ_E0 = 30000, CQ_F0 = 32000, CQ_A1 = 42000;
#else
constexpr int CQ_A0 = 13000, CQ_C1A = 19000, CQ_C1B = 25000, CQ_C2 = 39000, CQ_E0 = 49000, CQ_F0 = 53000, CQ_A1 = 55808;
#endif

constexpr size_t MiB = 1u << 20;
constexpr size_t WS_CTL = 0, CTL_BYTES = 1 * MiB;
constexpr size_t WS_WC = 1 * MiB;
constexpr size_t WS_WA = WS_WC + 36 * MiB;
constexpr size_t WS_WB = WS_WA + 4 * MiB;
constexpr size_t WS_WO = WS_WB + 4 * MiB;
constexpr size_t WS_WGU = WS_WO + 8 * MiB;
constexpr size_t WS_WD = WS_WGU + 128 * MiB;
constexpr size_t WS_WR = WS_WD + 64 * MiB;
constexpr size_t WSET_BYTES = 245 * MiB;
constexpr size_t WS_XS = WS_WR + 1 * MiB + WSET_BYTES;
constexpr size_t WS_HX = WS_XS + 132 * MiB;
constexpr size_t WS_P = WS_HX + 66 * MiB;
constexpr size_t WS_G = WS_P + 165 * MiB;
constexpr size_t WS_A = WS_G + 132 * MiB;
constexpr size_t WS_O = WS_A + 33 * MiB;
constexpr size_t WS_T = WS_O + 33 * MiB;
constexpr size_t WS_HID = WS_T + 66 * MiB;
constexpr size_t WS_ROUTE = WS_HID + 41 * MiB;
constexpr size_t WS_ROPE = WS_ROUTE + 2 * MiB;
constexpr size_t WS_HX8 = WS_ROPE + 1 * MiB;
constexpr size_t WS_SX = WS_HX8 + 33 * MiB;
constexpr size_t WS_END = WS_SX + 1 * MiB;
constexpr int CW_BAR = 4096;
constexpr int CW_CNT = 8192;
constexpr int CW_PDONE = 12288;
constexpr int CW_EMAX = 12288 + 512;
constexpr float GMAX_MARGIN = 1.1f;
constexpr float EMAX_MARGIN = 1.2f;
constexpr int CW_DMAX = 12288 + 640;
constexpr int CW_PD8 = 12288 + 1280;
constexpr int CW_GMAX = 12288 + 256;
constexpr int CW_QB = 12288 + 128;
constexpr size_t CTL_MOD = 65536;
constexpr size_t RT_E = 0, RT_W = RT_E + 2 * MALL * 4, RT_P = RT_W + 2 * MALL * 4, RT_TS = RT_P + 2 * MALL * 4, RT_WS = RT_TS + SLOTS * 4;
static_assert(RT_WS + SLOTS * 4 <= 2 * MiB, "route map");

constexpr int RING_BYTES = 131072;
constexpr int LDSCTL_OFF = 139264;
constexpr int LDS_TP = LDSCTL_OFF + 0;
constexpr int LDS_MISC = LDSCTL_OFF + 256;
constexpr int LDS_LCNT = LDSCTL_OFF + 512;
constexpr int LDS_BYTES = 147456;

#define LDS_WAIT() asm volatile("s_waitcnt lgkmcnt(0)" ::: "memory")
#define VM_WAIT() asm volatile("s_waitcnt vmcnt(0)" ::: "memory")
__device__ __forceinline__ unsigned cvt_pk_bf16(float lo, float hi) { unsigned r; asm volatile("v_cvt_pk_bf16_f32 %0, %1, %2" : "=v"(r) : "v"(lo), "v"(hi)); return r; }
__device__ __forceinline__ float bflo(unsigned w) { return __uint_as_float(w << 16); }
__device__ __forceinline__ float bfhi(unsigned w) { return __uint_as_float(w & 0xffff0000u); }
__device__ __forceinline__ float wave_sum(float v) {
#pragma unroll
    for (int o = 1; o < 64; o <<= 1) v += __shfl_xor(v, o);
    return v;
}
__device__ __forceinline__ float fast_sigmoid(float x) { return __builtin_amdgcn_rcpf(1.0f + __builtin_amdgcn_exp2f(-1.44269504f * x)); }
__device__ __forceinline__ float gelu_tanh(float x) { const float u = 0.7978845608f * (x + 0.044715f * x * x * x); return x * fast_sigmoid(2.0f * u); }
__device__ __forceinline__ float silu_f(float x) { return x * fast_sigmoid(x); }
__device__ __forceinline__ unsigned offb(unsigned row, unsigned ch) { return 256u * row + 16u * (ch ^ (((row & 3u) << 2) | ((row >> 2) & 3u))); }
__device__ __forceinline__ bf16x8 tr_frag(unsigned tile_base, unsigned rowbase, unsigned c, unsigned lane) {
    const unsigned g = lane >> 4, q = (lane & 15u) >> 2, p = lane & 3u;
    const unsigned a0 = tile_base + offb(rowbase + 8u * g + q, 2u * c + (p >> 1)) + 8u * (p & 1u);
    const unsigned a1 = tile_base + offb(rowbase + 8u * g + 4u + q, 2u * c + (p >> 1)) + 8u * (p & 1u);
    s16x4 r0, r1;
    asm volatile("ds_read_b64_tr_b16 %0, %2\n\tds_read_b64_tr_b16 %1, %3\n\ts_waitcnt lgkmcnt(0)" : "=&v"(r0), "=&v"(r1) : "v"(a0), "v"(a1) : "memory");
    bf16x8 f; f[0] = r0[0]; f[1] = r0[1]; f[2] = r0[2]; f[3] = r0[3]; f[4] = r1[0]; f[5] = r1[1]; f[6] = r1[2]; f[7] = r1[3];
    return f;
}

#define XB_TMO      128
#define XB_XCNT(j)  (256  + 64 * (j))
#define XB_XSUB(j)  (1280 + 64 * (j))
#define XB_XGEN(j)  (2304 + 64 * (j))
#define XB_TOP      3328
#define XB_TOPGEN   3392
#define XCD_BAR_WORDS 3456
#define XB_SPIN_CAP (1u << 24)

__device__ __forceinline__ unsigned xb_ld(unsigned* p)              { return __hip_atomic_load(p, __ATOMIC_RELAXED, __HIP_MEMORY_SCOPE_AGENT); }
__device__ __forceinline__ unsigned xb_add(unsigned* p, unsigned v) { return __hip_atomic_fetch_add(p, v, __ATOMIC_RELAXED, __HIP_MEMORY_SCOPE_AGENT); }
__device__ __forceinline__ unsigned xb_xcc_id() { return (unsigned)__builtin_amdgcn_s_getreg((3 << 11) | 20) & 0xFu; }
#define XB_SPIN(cond, bar) do { unsigned _sp = 0; while (cond) { __builtin_amdgcn_s_sleep(1); \
    if ((++_sp & 255u) == 0u) { if (xb_ld(&(bar)[XB_TMO])) break; if (_sp > XB_SPIN_CAP) { atomicAdd(&(bar)[XB_TMO], 1u); break; } } } } while (0)

struct XcdBarrier {
    unsigned* bar; unsigned x;
    volatile LAS unsigned* st;
};

__device__ __forceinline__ XcdBarrier xcd_barrier_post(unsigned* bar, volatile LAS unsigned* st) {
    XcdBarrier b; b.bar = bar; b.x = xb_xcc_id(); b.st = st;
    if (threadIdx.x == 0) (void)xb_add(&bar[XB_XCNT(b.x)], 1u);
    return b;
}
__device__ __forceinline__ void xcd_barrier_complete(unsigned* bar, unsigned x, unsigned& nloc, unsigned& nx) {
    const unsigned G = gridDim.x * gridDim.y * gridDim.z;
    unsigned sum, cnt, mine, sp = 0u;
    for (;;) {
        sum = 0u; cnt = 0u; mine = 0u;
#pragma unroll
        for (unsigned j = 0; j < 16; ++j) { const unsigned c = xb_ld(&bar[XB_XCNT(j)]); sum += c; cnt += (c > 0u) ? 1u : 0u; mine = (j == x) ? c : mine; }
        if (sum == G) break;
        __builtin_amdgcn_s_sleep(1);
        if ((++sp & 255u) == 0u) { if (xb_ld(&bar[XB_TMO])) break; if (sp > XB_SPIN_CAP) { atomicAdd(&bar[XB_TMO], 1u); break; } }
    }
    nloc = mine > 0u ? mine : 1u; nx = cnt > 0u ? cnt : 1u;
}

__device__ __forceinline__ void xcd_barrier(const XcdBarrier& b) {
    asm volatile("s_waitcnt vmcnt(0)" ::: "memory");
    __syncthreads();
    if (threadIdx.x == 0) {
        unsigned* bar = b.bar;
        __builtin_amdgcn_s_waitcnt(0);
        unsigned nloc = b.st[0], nx = b.st[1];
        if (nloc == 0u) { xcd_barrier_complete(bar, b.x, nloc, nx); b.st[0] = nloc; b.st[1] = nx; }
        const unsigned old = xb_add(&bar[XB_XSUB(b.x)], 1u);
        const unsigned gen = old / nloc;
        if (old + 1u == (gen + 1u) * nloc) {
            __builtin_amdgcn_fence(__ATOMIC_RELEASE, "agent");
            asm volatile("s_waitcnt vmcnt(0)" ::: "memory");
            const unsigned og = xb_add(&bar[XB_TOP], 1u);
            const unsigned tg = og / nx;
            if (og + 1u == (tg + 1u) * nx) xb_add(&bar[XB_TOPGEN], 1u);
            else XB_SPIN(xb_ld(&bar[XB_TOPGEN]) == tg, bar);
            __builtin_amdgcn_fence(__ATOMIC_ACQUIRE, "agent");
            xb_add(&bar[XB_XGEN(b.x)], 1u);
            asm volatile("s_waitcnt vmcnt(0)" ::: "memory");
        } else {
            XB_SPIN(xb_ld(&bar[XB_XGEN(b.x)]) == gen, bar);
            __builtin_amdgcn_fence(__ATOMIC_ACQUIRE, "agent");
            asm volatile("s_waitcnt vmcnt(0)" ::: "memory");
        }
    }
    __syncthreads();
}

namespace pg8 {
constexpr int BM = 256, BK = 64, HALF = 128, HTB = HALF * BK * 2, STAGE_BYTES = 8 * HTB, NXCD = 8, WGM = 4;
__host__ __device__ __forceinline__ int lds_byte(int r, int c) { const int st = (r >> 4) * 2 + (c >> 5), rr = r & 15, cc = c & 31, ob = rr * 64 + cc * 2; return st * 1024 + (ob ^ (((ob >> 9) & 1) << 5)); }
__host__ __device__ __forceinline__ void stage_rc(int b, int& R, int& C) { const int st = b / 1024, sb = b % 1024, swz = sb ^ (((sb >> 9) & 1) << 5); R = (st >> 1) * 16 + swz / 64; C = (st & 1) * 32 + (swz % 64) / 2; }
__host__ __device__ __forceinline__ int perm32(int rho) { const int n = rho >> 4, i = rho & 15; return 8 * (i >> 2) + 4 * n + (i & 3); }

struct Unit { int pm, pn, e; };
struct Gemm { const bf16_t* A; int lda; const bf16_t* Bt; size_t bstride; int K; };

__device__ __forceinline__ int xcd_remap(int wgid, int nwg) { const int q = nwg / NXCD, r = nwg % NXCD, xcd = wgid % NXCD, off = wgid / NXCD; return (xcd < r ? xcd * (q + 1) : r * (q + 1) + (xcd - r) * q) + off; }
struct StaticOrder {
    int nM, nN, nwg, G, c;
    __device__ __forceinline__ void init(int M, int N, int G_, int c_) { nM = M / BM; nN = N / BM; nwg = nM * nN; G = G_; c = c_; }
    __device__ __forceinline__ bool next(int i, Unit& u) const {
        const long L = (long)i * G + c; if (L >= nwg) return false;
        const int wgid = xcd_remap((int)L, nwg);
        const int nig = WGM * nN, gid = wgid / nig, fm = gid * WGM, gsz = (nM - fm) < WGM ? (nM - fm) : WGM;
        u.pm = fm + ((wgid % nig) % gsz); u.pn = (wgid % nig) / gsz; u.e = 0; return true;
    }
};
struct SplitOrder {
    int nM, nN1, nN2, nwg1, nwg2, G, c;
    __device__ __forceinline__ void init(int M, int N1, int N2, int G_, int c_) { nM = M / BM; nN1 = N1 / BM; nN2 = N2 / BM; nwg1 = nM * nN1; nwg2 = nM * nN2; G = G_; c = c_; }
    __device__ __forceinline__ void map(int L, int nwg, int nN, Unit& u) const {
        const int wgid = xcd_remap(L, nwg);
        const int nig = WGM * nN, gid = wgid / nig, fm = gid * WGM, gsz = (nM - fm) < WGM ? (nM - fm) : WGM;
        u.pm = fm + ((wgid % nig) % gsz); u.pn = (wgid % nig) / gsz; u.e = 0; }
    __device__ __forceinline__ bool next(int i, Unit& u) const {
        const long L = (long)i * G + c; if (L >= nwg1 + nwg2) return false;
        if (L < nwg1) map((int)L, nwg1, nN1, u); else { map((int)L - nwg1, nwg2, nN2, u); u.pn += nN1; }
        return true;
    }
};
struct GroupedOrder {
    const LAS int* tp; int nN, nwg, G, c;
    __device__ __forceinline__ void init(const LAS int* tp_, int N, int G_, int c_) { tp = tp_; nN = N / BM; nwg = tp_[32] * nN; G = G_; c = c_; }
    __device__ __forceinline__ bool next(int i, Unit& u) const {
        const long L = (long)i * G + c; if (L >= nwg) return false;
        const int wgid = xcd_remap((int)L, nwg);
        const int mt = wgid / nN; u.pm = mt; u.pn = wgid % nN;
        int e = 0;
        for (int j = 1; j < 32; ++j) e += (tp[j] <= mt) ? 1 : 0;
        u.e = e; return true;
    }
};

typedef int i32x4v __attribute__((ext_vector_type(4)));
template <class Epi, class Sched, bool GATHER = false, bool INT8 = false>
__device__ __forceinline__ void gemm_phase(LAS unsigned char* lds, const Gemm g, const Sched& S, const Epi& E, const int* rowmap = nullptr) {
    int tid_ = threadIdx.x; asm volatile("" : "+v"(tid_));
    const int tid = tid_, wid = __builtin_amdgcn_readfirstlane(tid >> 6), lane = tid & 63, wr = wid >> 2, wc = wid & 3, fr = lane & 15, fq = lane >> 4;
    const int K = g.K, nt = K / BK, lda = g.lda;
    unsigned voffA[2], voffB[2];
#pragma unroll
    for (int i = 0; i < 2; ++i) { int R, C; stage_rc(tid * 16 + i * 8192, R, C); const int Rb = Epi::PERM ? ((R & ~31) + perm32(R & 31)) : R;
        voffA[i] = (unsigned)(R * lda + C) * 2u; voffB[i] = (unsigned)(Rb * K + C) * 2u; }
    const size_t kstep = (size_t)(BK * 2);
    const size_t hstepA = GATHER ? (size_t)0 : (size_t)HALF * lda * 2, tstepA = 2 * hstepA;
    unsigned gcur[2][2], gnxt[2][2];
    auto gather_offs = [&](int pm, unsigned (&o)[2][2]) {
#pragma unroll
        for (int h = 0; h < 2; ++h)
#pragma unroll
            for (int i = 0; i < 2; ++i) { int R, C; stage_rc(tid * 16 + i * 8192, R, C); const int ts = rowmap[256 * pm + 128 * h + R]; const int row = ts < 0 ? 0 : (ts >> 1);
                o[h][i] = (unsigned)(row * lda + C) * 2u; }
    };
    const size_t hstepB = (size_t)HALF * K * 2, tstepB = 2 * hstepB;
    const unsigned ldsw = (unsigned)wid * 1024u;
    const int aoff = lds_byte(wr * 64 + fr, fq * 8), boff = lds_byte(wc * 32 + fr, fq * 8);
#define PG8_SA(b, h) (((b) * 2 + (h)) * HTB)
#define PG8_SB(b, h) ((4 + (b) * 2 + (h)) * HTB)
#define PG8_STAGE(bufoff, gbase, voff) do { _Pragma("unroll") for (int _i = 0; _i < 2; ++_i) \
        __builtin_amdgcn_global_load_lds((const unsigned*)((const char*)(gbase) + (voff)[_i]), (LAS unsigned*)(lds + (bufoff) + ldsw + _i * 8192), 16, 0, 0); } while (0)
#define PG8_LDA(dst, b, h) do { _Pragma("unroll") for (int m = 0; m < 4; ++m) _Pragma("unroll") for (int k = 0; k < 2; ++k) dst[m][k] = *(const LAS bf16x8*)(lds + PG8_SA(b, h) + aoff + m * 2048 + k * 1024); } while (0)
#define PG8_LDB(dst, b, h) do { _Pragma("unroll") for (int n = 0; n < 2; ++n) _Pragma("unroll") for (int k = 0; k < 2; ++k) dst[n][k] = *(const LAS bf16x8*)(lds + PG8_SB(b, h) + boff + n * 2048 + k * 1024); } while (0)
#define PG8_MMA(ai, bj, At, Bt) do { __builtin_amdgcn_s_setprio(1); _Pragma("unroll") for (int m = 0; m < 4; ++m) _Pragma("unroll") for (int n = 0; n < 2; ++n) _Pragma("unroll") for (int k = 0; k < 2; ++k) { \
        if constexpr (INT8) acc[ai][bj][m][n] = __builtin_bit_cast(f32x4, __builtin_amdgcn_mfma_i32_16x16x64_i8(__builtin_bit_cast(i32x4v, Bt[n][k]), __builtin_bit_cast(i32x4v, At[m][k]), __builtin_bit_cast(i32x4v, acc[ai][bj][m][n]), 0, 0, 0)); \
        else acc[ai][bj][m][n] = __builtin_amdgcn_mfma_f32_16x16x32_bf16(Bt[n][k], At[m][k], acc[ai][bj][m][n], 0, 0, 0); } __builtin_amdgcn_s_setprio(0); } while (0)
#define PG8_WAIT_V(n) asm volatile("s_waitcnt vmcnt(" #n ")" ::: "memory")
#define PG8_WAIT_L(n) asm volatile("s_waitcnt lgkmcnt(" #n ")" ::: "memory")
#define PG8_BAR __builtin_amdgcn_s_barrier()
#define PG8_SCHED __builtin_amdgcn_sched_barrier(0)
    Unit cur, nxt; int ui = 0; bool pend = false;
    if (!S.next(0, cur)) return;
    f32x4 acc[2][2][4][2];
#pragma unroll
    for (int a = 0; a < 2; ++a)
#pragma unroll
        for (int b = 0; b < 2; ++b)
#pragma unroll
            for (int m = 0; m < 4; ++m)
#pragma unroll
                for (int n = 0; n < 2; ++n) acc[a][b][m][n] = (f32x4){0.f, 0.f, 0.f, 0.f};
    bf16x8 At[4][2], B0[2][2], B1[2][2];
    const char* cA = (const char*)g.A + (size_t)cur.pm * tstepA; const char* cB = (const char*)g.Bt + (size_t)cur.e * g.bstride * 2 + (size_t)cur.pn * tstepB;
    if constexpr (GATHER) gather_offs(cur.pm, gcur);
#define PG8_OC(h) (GATHER ? gcur[h] : voffA)
    PG8_STAGE(PG8_SB(0, 0), cB, voffB); PG8_STAGE(PG8_SB(0, 1), cB + hstepB, voffB); PG8_STAGE(PG8_SA(0, 0), cA, PG8_OC(0)); PG8_STAGE(PG8_SA(0, 1), cA + hstepA, PG8_OC(1));
    if (wr == 1) PG8_BAR;
    PG8_WAIT_V(2); PG8_BAR;
    PG8_STAGE(PG8_SB(1, 0), cB + kstep, voffB); PG8_STAGE(PG8_SA(1, 0), cA + kstep, PG8_OC(0)); PG8_STAGE(PG8_SB(1, 1), cB + hstepB + kstep, voffB);
    PG8_WAIT_V(6); PG8_BAR;
    for (;;) {
        const bool has_next = S.next(ui + 1, nxt);
        const char* nA = has_next ? (const char*)g.A + (size_t)nxt.pm * tstepA : cA;
        const char* nB = has_next ? (const char*)g.Bt + (size_t)nxt.e * g.bstride * 2 + (size_t)nxt.pn * tstepB : cB;
        if constexpr (GATHER) { if (has_next) gather_offs(nxt.pm, gnxt); else {
#pragma unroll
            for (int h = 0; h < 2; ++h)
#pragma unroll
                for (int i = 0; i < 2; ++i) gnxt[h][i] = gcur[h][i]; } }
        for (int t = 0; t < nt; t += 2) {
            if constexpr (Epi::MID) { if (t == nt / 2) E.mid(acc, cur, wr, wc, fr, fq); }
            const bool last = (t == nt - 2);
            const char* a1 = cA + (size_t)(t + 1) * kstep;
            const char* a2 = last ? nA : cA + (size_t)(t + 2) * kstep; const char* b2 = last ? nB : cB + (size_t)(t + 2) * kstep;
            const char* a3 = a2 + kstep; const char* b3 = b2 + kstep;
            unsigned osel[2][2];
#pragma unroll
            for (int h = 0; h < 2; ++h)
#pragma unroll
                for (int i = 0; i < 2; ++i) osel[h][i] = GATHER ? (last ? gnxt[h][i] : gcur[h][i]) : voffA[i];
            PG8_LDB(B0, 0, 0); PG8_LDB(B1, 0, 1); PG8_SCHED; PG8_LDA(At, 0, 0); PG8_STAGE(PG8_SA(1, 1), a1 + hstepA, PG8_OC(1));
            PG8_WAIT_V(8); PG8_WAIT_L(0); PG8_BAR; PG8_MMA(0, 0, At, B0); PG8_MMA(0, 1, At, B1); PG8_BAR; PG8_SCHED;
            PG8_LDA(At, 0, 1); PG8_STAGE(PG8_SB(0, 0), b2, voffB); PG8_STAGE(PG8_SB(0, 1), b2 + hstepB, voffB); PG8_STAGE(PG8_SA(0, 0), a2, osel[0]);
            PG8_WAIT_V(8); PG8_WAIT_L(0); PG8_BAR; PG8_MMA(1, 0, At, B0); PG8_MMA(1, 1, At, B1); PG8_BAR; PG8_SCHED;
            PG8_LDB(B0, 1, 0); PG8_LDB(B1, 1, 1); PG8_SCHED; PG8_LDA(At, 1, 0); PG8_STAGE(PG8_SA(0, 1), a2 + hstepA, osel[1]);
            PG8_WAIT_V(8); PG8_WAIT_L(0); PG8_BAR; PG8_MMA(0, 0, At, B0); PG8_MMA(0, 1, At, B1); PG8_BAR; PG8_SCHED;
            PG8_LDA(At, 1, 1); PG8_STAGE(PG8_SB(1, 0), b3, voffB); PG8_STAGE(PG8_SB(1, 1), b3 + hstepB, voffB); PG8_STAGE(PG8_SA(1, 0), a3, osel[0]);
            PG8_WAIT_V(8); PG8_WAIT_L(0); PG8_BAR; PG8_MMA(1, 0, At, B0); PG8_MMA(1, 1, At, B1); PG8_BAR; PG8_SCHED;
        }
        if (wr == 0) PG8_BAR;
        if constexpr (Epi::SIGNAL) { if (pend) E.signal(lane); }
        E(acc, cur, wr, wc, fr, fq);
        if constexpr (Epi::SIGNAL) pend = E.wants(cur);
        if (!has_next) break;
#pragma unroll
        for (int a = 0; a < 2; ++a)
#pragma unroll
            for (int b = 0; b < 2; ++b)
#pragma unroll
                for (int m = 0; m < 4; ++m)
#pragma unroll
                    for (int n = 0; n < 2; ++n) acc[a][b][m][n] = (f32x4){0.f, 0.f, 0.f, 0.f};
        cur = nxt; cA = nA; cB = nB; ++ui;
        if constexpr (GATHER) {
#pragma unroll
            for (int h = 0; h < 2; ++h)
#pragma unroll
                for (int i = 0; i < 2; ++i) gcur[h][i] = gnxt[h][i]; }
        if (wr == 1) PG8_BAR;
    }
    PG8_WAIT_V(0);
    if constexpr (Epi::SIGNAL) { if (pend) E.signal(lane); }
    PG8_BAR;
#undef PG8_OC
#undef PG8_SA
#undef PG8_SB
#undef PG8_STAGE
#undef PG8_LDA
#undef PG8_LDB
#undef PG8_MMA
#undef PG8_WAIT_V
#undef PG8_WAIT_L
#undef PG8_BAR
#undef PG8_SCHED
}

__device__ __forceinline__ u32x4 pack8(const f32x4 v0, const f32x4 v1) { u32x4 w; w.x = cvt_pk_bf16(v0[0], v0[1]); w.y = cvt_pk_bf16(v0[2], v0[3]); w.z = cvt_pk_bf16(v1[0], v1[1]); w.w = cvt_pk_bf16(v1[2], v1[3]); return w; }
__device__ __forceinline__ void unpack8(const u32x4 w, f32x4& v0, f32x4& v1) { v0 = (f32x4){bflo(w.x), bfhi(w.x), bflo(w.y), bfhi(w.y)}; v1 = (f32x4){bflo(w.z), bfhi(w.z), bflo(w.w), bfhi(w.w)}; }

struct EpiInProj {
    static constexpr bool PERM = true, MID = false, SIGNAL = true;
    bf16_t* P; bf16_t* G; const float* bgate; const f32x2* rope; unsigned* pdone; const float* sx; float sw;
    __device__ __forceinline__ void stP(const __amdgpu_buffer_rsrc_t rs, size_t elem, const u32x4 v) const { __builtin_amdgcn_raw_buffer_store_b128(v, rs, (unsigned)(elem * 2), 0, 16); }
    __device__ __forceinline__ bool wants(const Unit& u) const { return u.pn < 20; }
    __device__ __forceinline__ void signal(int lane) const { if (lane == 0) { const int w_ = __builtin_amdgcn_readfirstlane((int)(threadIdx.x >> 6)); __hip_atomic_fetch_add(pdone + 16 * w_, 1u, __ATOMIC_RELAXED, __HIP_MEMORY_SCOPE_AGENT); } }
    __device__ __forceinline__ void operator()(const f32x4 (&acc)[2][2][4][2], const Unit& u, int wr, int wc, int fr, int fq) const {
        const int row0 = u.pm * BM + wr * 64 + fr, colt = u.pn * BM + wc * 32 + 8 * fq;
        const int mode = (u.pn < 8) ? 0 : (u.pn < 12 ? 1 : (u.pn < 16 ? 3 : (u.pn < 20 ? 1 : 2)));
        const __amdgpu_buffer_rsrc_t prs = __builtin_amdgcn_make_buffer_rsrc(P, 0, (unsigned)((size_t)MALL * INW * 2), 0x00020000);
        float scv[2][4];
#pragma unroll
        for (int ai = 0; ai < 2; ++ai)
#pragma unroll
            for (int m = 0; m < 4; ++m) scv[ai][m] = sx ? sx[row0 + ai * HALF + m * 16] * sw : 0.f;
        asm volatile("" ::: "memory");
        if (mode == 3) {
            const int hh = wc >> 1, ax = wc & 1, c1 = u.pn * BM + 128 * hh + 64 * ax + 8 * fq;
#pragma unroll
            for (int ai = 0; ai < 2; ++ai)
#pragma unroll
                for (int m = 0; m < 4; ++m) {
                    const int row = row0 + ai * HALF + m * 16;
                    f32x4 x1a = acc[ai][0][m][0], x1b = acc[ai][0][m][1], x2a = acc[ai][1][m][0], x2b = acc[ai][1][m][1];
                    if (sx) { const float sc = scv[ai][m];
#pragma unroll
                        for (int j = 0; j < 4; ++j) { x1a[j] = (float)__float_as_int(x1a[j]) * sc; x1b[j] = (float)__float_as_int(x1b[j]) * sc; x2a[j] = (float)__float_as_int(x2a[j]) * sc; x2b[j] = (float)__float_as_int(x2b[j]) * sc; } }
                    if (row < MLAT) {
                        const int t = row & (SEQ - 1), pos = ax ? (t & 63) : (t >> 6);
                        const f32x4* tp = (const f32x4*)(rope + pos * 32 + 8 * fq);
                        const f32x4 t0 = tp[0], t1 = tp[1], t2 = tp[2], t3 = tp[3];
                        const f32x4 ca = (f32x4){t0[0], t0[2], t1[0], t1[2]}, sa = (f32x4){t0[1], t0[3], t1[1], t1[3]};
                        const f32x4 cb = (f32x4){t2[0], t2[2], t3[0], t3[2]}, sb = (f32x4){t2[1], t2[3], t3[1], t3[3]};
                        const f32x4 y1a = x1a * ca - x2a * sa, y2a = x2a * ca + x1a * sa, y1b = x1b * cb - x2b * sb, y2b = x2b * cb + x1b * sb;
                        x1a = y1a; x2a = y2a; x1b = y1b; x2b = y2b;
                    }
                    stP(prs, (size_t)row * INW + c1, pack8(x1a, x1b)); stP(prs, (size_t)row * INW + c1 + 32, pack8(x2a, x2b));
                }
            return;
        }
        if (mode == 2) {
            const int cc = 128 * (u.pn - 20) + wc * 32 + 8 * fq;
            f32x4 ba[2], bb[2];
#pragma unroll
            for (int n = 0; n < 2; ++n) { ba[n] = *(const f32x4*)(bgate + cc + 4 * n); bb[n] = *(const f32x4*)(bgate + D + cc + 4 * n); }
#pragma unroll
            for (int ai = 0; ai < 2; ++ai)
#pragma unroll
                for (int m = 0; m < 4; ++m) {
                    const size_t row = (size_t)(row0 + ai * HALF + m * 16);
                    f32x4 rr[2], gb[2];
#pragma unroll
                    for (int n = 0; n < 2; ++n)
#pragma unroll
                        for (int j = 0; j < 4; ++j) { const float ga = fast_sigmoid(acc[ai][0][m][n][j] + ba[n][j]); const float g2 = fmaxf(fast_sigmoid(acc[ai][1][m][n][j] + bb[n][j]), 5.9604645e-8f);
                            gb[n][j] = g2; rr[n][j] = ga * __builtin_amdgcn_rcpf(g2); }
                    *(u32x4*)(G + row * GATEW + cc) = pack8(rr[0], rr[1]); *(u32x4*)(G + row * GATEW + D + cc) = pack8(gb[0], gb[1]);
                }
            return;
        }
        f32x4 bv[2][2];
#pragma unroll
        for (int bj = 0; bj < 2; ++bj)
#pragma unroll
            for (int n = 0; n < 2; ++n) bv[bj][n] = (f32x4){0.f, 0.f, 0.f, 0.f};
#pragma unroll
        for (int ai = 0; ai < 2; ++ai)
#pragma unroll
            for (int m = 0; m < 4; ++m) {
                const size_t row = (size_t)(row0 + ai * HALF + m * 16); const float sc = scv[ai][m];
#pragma unroll
                for (int bj = 0; bj < 2; ++bj) { f32x4 v0 = acc[ai][bj][m][0] + bv[bj][0], v1 = acc[ai][bj][m][1] + bv[bj][1];
                    if (sx) {
#pragma unroll
                        for (int j = 0; j < 4; ++j) { v0[j] = (float)__float_as_int(acc[ai][bj][m][0][j]) * sc; v1[j] = (float)__float_as_int(acc[ai][bj][m][1][j]) * sc; } }
                    if (mode == 0) {
#pragma unroll
                        for (int j = 0; j < 4; ++j) { v0[j] = gelu_tanh(v0[j]); v1[j] = gelu_tanh(v1[j]); } }
                    stP(prs, row * INW + colt + bj * HALF, pack8(v0, v1)); } }
    }
};
struct EpiGate8 {
    static constexpr bool PERM = true, MID = false, SIGNAL = false;
    bf16_t* G; const float* bgate; const float* sx; float sw;
    __device__ __forceinline__ void operator()(const f32x4 (&acc)[2][2][4][2], const Unit& u, int wr, int wc, int fr, int fq) const {
        const int row0 = u.pm * BM + wr * 64 + fr, cc = 128 * u.pn + wc * 32 + 8 * fq;
        f32x4 ba[2], bb[2];
#pragma unroll
        for (int n = 0; n < 2; ++n) { ba[n] = *(const f32x4*)(bgate + cc + 4 * n); bb[n] = *(const f32x4*)(bgate + D + cc + 4 * n); }
        float scv[2][4];
#pragma unroll
        for (int ai = 0; ai < 2; ++ai)
#pragma unroll
            for (int m = 0; m < 4; ++m) scv[ai][m] = sx[row0 + ai * HALF + m * 16] * sw;
        asm volatile("" ::: "memory");
#pragma unroll
        for (int ai = 0; ai < 2; ++ai)
#pragma unroll
            for (int m = 0; m < 4; ++m) {
                const size_t row = (size_t)(row0 + ai * HALF + m * 16); const float sc = scv[ai][m];
                f32x4 rr[2], gb[2];
#pragma unroll
                for (int n = 0; n < 2; ++n)
#pragma unroll
                    for (int j = 0; j < 4; ++j) { const float za = (float)__float_as_int(acc[ai][0][m][n][j]) * sc + ba[n][j], zb = (float)__float_as_int(acc[ai][1][m][n][j]) * sc + bb[n][j];
                        const float ta = 1.0f + __builtin_amdgcn_exp2f(-1.44269504f * za), tb = fminf(1.0f + __builtin_amdgcn_exp2f(-1.44269504f * zb), 16777216.0f);
                        gb[n][j] = __builtin_amdgcn_rcpf(tb); rr[n][j] = tb * __builtin_amdgcn_rcpf(ta); }
                *(u32x4*)(G + row * GATEW + cc) = pack8(rr[0], rr[1]); *(u32x4*)(G + row * GATEW + D + cc) = pack8(gb[0], gb[1]);
            }
    }
};
struct EpiMergeF {
    static constexpr bool PERM = true, MID = true, SIGNAL = false;
    bf16_t* T; const bf16_t* G;
    __device__ __forceinline__ void mid(f32x4 (&acc)[2][2][4][2], const Unit& u, int wr, int wc, int fr_, int fq_) const {
        int fr = fr_, fq = fq_; asm volatile("" : "+v"(fr), "+v"(fq));
        const int row0 = u.pm * BM + wr * 64 + fr, colt = u.pn * BM + wc * 32 + 8 * fq;
#pragma unroll
        for (int ai = 0; ai < 2; ++ai)
#pragma unroll
            for (int mh = 0; mh < 2; ++mh) {
                u32x4 raw[2][2];
#pragma unroll
                for (int mm = 0; mm < 2; ++mm)
#pragma unroll
                    for (int bj = 0; bj < 2; ++bj) raw[mm][bj] = __builtin_nontemporal_load((const u32x4*)(G + (size_t)(row0 + ai * HALF + (2 * mh + mm) * 16) * GATEW + colt + bj * HALF));
#pragma unroll
                for (int mm = 0; mm < 2; ++mm)
#pragma unroll
                    for (int bj = 0; bj < 2; ++bj) { f32x4 r0, r1; unpack8(raw[mm][bj], r0, r1); acc[ai][bj][2 * mh + mm][0] *= r0; acc[ai][bj][2 * mh + mm][1] *= r1; }
                asm volatile("" ::: "memory");
            }
    }
    __device__ __forceinline__ void operator()(const f32x4 (&acc)[2][2][4][2], const Unit& u, int wr, int wc, int fr, int fq) const {
        const int row0 = u.pm * BM + wr * 64 + fr, colt = u.pn * BM + wc * 32 + 8 * fq;
#pragma unroll
        for (int ai = 0; ai < 2; ++ai) {
            u32x4 gb[4][2];
#pragma unroll
            for (int m = 0; m < 4; ++m)
#pragma unroll
                for (int bj = 0; bj < 2; ++bj) gb[m][bj] = __builtin_nontemporal_load((const u32x4*)(G + (size_t)(row0 + ai * HALF + m * 16) * GATEW + D + colt + bj * HALF));
            asm volatile("" ::: "memory");
#pragma unroll
            for (int m = 0; m < 4; ++m) {
                bf16_t* tp = T + (size_t)(row0 + ai * HALF + m * 16) * D + colt;
#pragma unroll
                for (int bj = 0; bj < 2; ++bj) { f32x4 g0, g1; unpack8(gb[m][bj], g0, g1);
                    *(u32x4*)(tp + bj * HALF) = pack8(acc[ai][bj][m][0] * g0, acc[ai][bj][m][1] * g1); } }
            asm volatile("" ::: "memory");
        }
    }
};
struct EpiMergeI8 {
    static constexpr bool PERM = true, MID = true, SIGNAL = false;
    bf16_t* T; const bf16_t* G; const float* cab; const float* sob;
    __device__ __forceinline__ void mid(f32x4 (&acc)[2][2][4][2], const Unit& u, int wr, int wc, int fr_, int fq_) const {
        int fr = fr_, fq = fq_; asm volatile("" : "+v"(fr), "+v"(fq));
        const int row0 = u.pm * BM + wr * 64 + fr, colt = u.pn * BM + wc * 32 + 8 * fq;
#pragma unroll
        for (int ai = 0; ai < 2; ++ai)
#pragma unroll
            for (int mh = 0; mh < 2; ++mh) {
                u32x4 raw[2][2]; float c[2];
#pragma unroll
                for (int mm = 0; mm < 2; ++mm) { c[mm] = cab[row0 + ai * HALF + (2 * mh + mm) * 16];
#pragma unroll
                    for (int bj = 0; bj < 2; ++bj) raw[mm][bj] = __builtin_nontemporal_load((const u32x4*)(G + (size_t)(row0 + ai * HALF + (2 * mh + mm) * 16) * GATEW + colt + bj * HALF)); }
#pragma unroll
                for (int mm = 0; mm < 2; ++mm)
#pragma unroll
                    for (int bj = 0; bj < 2; ++bj) { f32x4 r0, r1; unpack8(raw[mm][bj], r0, r1);
#pragma unroll
                        for (int j = 0; j < 4; ++j) {
                            acc[ai][bj][2 * mh + mm][0][j] = __int_as_float((int)__builtin_amdgcn_fmed3f((float)__float_as_int(acc[ai][bj][2 * mh + mm][0][j]) * c[mm] * r0[j], -1.0e9f, 1.0e9f));
                            acc[ai][bj][2 * mh + mm][1][j] = __int_as_float((int)__builtin_amdgcn_fmed3f((float)__float_as_int(acc[ai][bj][2 * mh + mm][1][j]) * c[mm] * r1[j], -1.0e9f, 1.0e9f)); } }
                asm volatile("" ::: "memory");
            }
    }
    __device__ __forceinline__ void operator()(const f32x4 (&acc)[2][2][4][2], const Unit& u, int wr, int wc, int fr, int fq) const {
        const int row0 = u.pm * BM + wr * 64 + fr, colt = u.pn * BM + wc * 32 + 8 * fq;
#pragma unroll
        for (int ai = 0; ai < 2; ++ai) {
            u32x4 gb[4][2]; float sc[4];
#pragma unroll
            for (int m = 0; m < 4; ++m) { sc[m] = sob[row0 + ai * HALF + m * 16];
#pragma unroll
                for (int bj = 0; bj < 2; ++bj) gb[m][bj] = __builtin_nontemporal_load((const u32x4*)(G + (size_t)(row0 + ai * HALF + m * 16) * GATEW + D + colt + bj * HALF)); }
            asm volatile("" ::: "memory");
#pragma unroll
            for (int m = 0; m < 4; ++m) {
                bf16_t* tp = T + (size_t)(row0 + ai * HALF + m * 16) * D + colt;
#pragma unroll
                for (int bj = 0; bj < 2; ++bj) { f32x4 g0, g1; unpack8(gb[m][bj], g0, g1); f32x4 a0, a1;
#pragma unroll
                    for (int j = 0; j < 4; ++j) { a0[j] = (float)__float_as_int(acc[ai][bj][m][0][j]) * sc[m] * g0[j]; a1[j] = (float)__float_as_int(acc[ai][bj][m][1][j]) * sc[m] * g1[j]; }
                    *(u32x4*)(tp + bj * HALF) = pack8(a0, a1); } }
            asm volatile("" ::: "memory");
        }
    }
};
template <bool FIRST> struct EpiOut {
    static constexpr bool PERM = true, MID = false, SIGNAL = false;
    const float* xlat; const float* xctx; bf16_t* xs; const float* mod;
    const float* sx; float sw;
    __device__ __forceinline__ void operator()(const f32x4 (&acc)[2][2][4][2], const Unit& u, int wr, int wc, int fr, int fq) const {
        const int row0 = u.pm * BM + wr * 64 + fr, colt = u.pn * BM + wc * 32 + 8 * fq;
        const int cls = (u.pm < 32) ? 0 : (u.pm < 64 ? 1 : 2);
        const float* gate = mod + cls * 12288 + 2 * D;
        f32x4 gv[2][2];
#pragma unroll
        for (int bj = 0; bj < 2; ++bj)
#pragma unroll
            for (int n = 0; n < 2; ++n) gv[bj][n] = *(const f32x4*)(gate + colt + bj * HALF + 4 * n);
        constexpr int MB = FIRST ? 2 : 4;
#pragma unroll
        for (int ai = 0; ai < 2; ++ai)
#pragma unroll
        for (int mb = 0; mb < 4; mb += MB) {
            f32x4 xf[MB][2][2]; u32x4 xb[MB][2]; float sc[MB];
#pragma unroll
            for (int mm = 0; mm < MB; ++mm) {
                const int row = row0 + ai * HALF + (mb + mm) * 16;
                if (sx) sc[mm] = sx[row];
#pragma unroll
                for (int bj = 0; bj < 2; ++bj) {
                    if (FIRST) { const float* xr = ((row < MLAT) ? (xlat + (size_t)row * D) : (xctx + (size_t)(row - MLAT) * D)) + colt + bj * HALF; xf[mm][bj][0] = __builtin_nontemporal_load((const f32x4*)xr); xf[mm][bj][1] = __builtin_nontemporal_load((const f32x4*)(xr + 4)); }
                    else xb[mm][bj] = *(const u32x4*)(xs + (size_t)row * D + colt + bj * HALF); } }
            asm volatile("" ::: "memory");
#pragma unroll
            for (int mm = 0; mm < MB; ++mm) {
                const int m = mb + mm, row = row0 + ai * HALF + m * 16;
                bf16_t* op = xs + (size_t)row * D + colt;
#pragma unroll
                for (int bj = 0; bj < 2; ++bj) { f32x4 x0, x1;
                    if (FIRST) { x0 = xf[mm][bj][0]; x1 = xf[mm][bj][1]; } else unpack8(xb[mm][bj], x0, x1);
                    if (sx) { const float s_ = sc[mm] * sw; f32x4 a0, a1;
#pragma unroll
                        for (int j = 0; j < 4; ++j) { a0[j] = (float)__float_as_int(acc[ai][bj][m][0][j]) * s_; a1[j] = (float)__float_as_int(acc[ai][bj][m][1][j]) * s_; }
                        *(u32x4*)(op + bj * HALF) = pack8(x0 + gv[bj][0] * a0, x1 + gv[bj][1] * a1);
                    } else
                    *(u32x4*)(op + bj * HALF) = pack8(x0 + gv[bj][0] * acc[ai][bj][m][0], x1 + gv[bj][1] * acc[ai][bj][m][1]); } }
            asm volatile("" ::: "memory");
        }
    }
};
struct EpiGateUp {
    static constexpr bool PERM = true, MID = false, SIGNAL = false;
    bf16_t* HID;
    __device__ __forceinline__ void operator()(const f32x4 (&acc)[2][2][4][2], const Unit& u, int wr, int wc, int fr, int fq) const {
        const int row0 = u.pm * BM + wr * 64 + fr, col0 = u.pn * 128 + wc * 32 + 8 * fq;
#pragma unroll
        for (int ai = 0; ai < 2; ++ai)
#pragma unroll
            for (int m = 0; m < 4; ++m) {
                const size_t row = (size_t)(row0 + ai * HALF + m * 16);
                f32x4 v0, v1;
#pragma unroll
                for (int j = 0; j < 4; ++j) { v0[j] = silu_f(acc[ai][0][m][0][j]) * acc[ai][1][m][0][j]; v1[j] = silu_f(acc[ai][0][m][1][j]) * acc[ai][1][m][1][j]; }
                *(u32x4*)(HID + row * DEXP + col0) = pack8(v0, v1); }
    }
};
struct EpiGateUp8 {
    static constexpr bool PERM = true, MID = false, SIGNAL = false;
    bf16_t* HID; const int* ts; const float* sx; const unsigned* emax;
    __device__ __forceinline__ void operator()(const f32x4 (&acc)[2][2][4][2], const Unit& u, int wr, int wc, int fr, int fq) const {
        const int row0 = u.pm * BM + wr * 64 + fr, col0 = u.pn * 128 + wc * 32 + 8 * fq;
        const float sg = __uint_as_float(emax[2 * u.e]) * (1.0f / 127.0f), su = __uint_as_float(emax[2 * u.e + 1]) * (1.0f / 127.0f);
        int tv[2][4]; float scv[2][4];
#pragma unroll
        for (int ai = 0; ai < 2; ++ai)
#pragma unroll
            for (int m = 0; m < 4; ++m) tv[ai][m] = ts[row0 + ai * HALF + m * 16];
#pragma unroll
        for (int ai = 0; ai < 2; ++ai)
#pragma unroll
            for (int m = 0; m < 4; ++m) scv[ai][m] = sx[max(tv[ai][m], 0) >> 1];
        asm volatile("" ::: "memory");
#pragma unroll
        for (int ai = 0; ai < 2; ++ai)
#pragma unroll
            for (int m = 0; m < 4; ++m) {
                const size_t row = (size_t)(row0 + ai * HALF + m * 16);
                const float sc = tv[ai][m] >= 0 ? scv[ai][m] : 0.f; const float cg = sc * sg, cu = sc * su;
                f32x4 v0, v1;
#pragma unroll
                for (int j = 0; j < 4; ++j) { v0[j] = silu_f((float)__float_as_int(acc[ai][0][m][0][j]) * cg) * ((float)__float_as_int(acc[ai][1][m][0][j]) * cu);
                                              v1[j] = silu_f((float)__float_as_int(acc[ai][0][m][1][j]) * cg) * ((float)__float_as_int(acc[ai][1][m][1][j]) * cu); }
                *(u32x4*)(HID + row * DEXP + col0) = pack8(v0, v1); }
    }
};
template <bool I8> struct EpiDown {
    static constexpr bool PERM = true, MID = false, SIGNAL = false;
    bf16_t* Y; const int* tokslot; const float* wslot;
    const unsigned* dmax;
    __device__ __forceinline__ void operator()(const f32x4 (&acc)[2][2][4][2], const Unit& u, int wr, int wc, int fr, int fq) const {
        const int row0 = u.pm * BM + wr * 64 + fr, colt = u.pn * BM + wc * 32 + 8 * fq;
        float swd = 1.0f; if (I8) swd = __uint_as_float(dmax[u.e]) * (1.0f / 127.0f);
        int tv[2][4]; float wv[2][4];
#pragma unroll
        for (int ai = 0; ai < 2; ++ai)
#pragma unroll
            for (int m = 0; m < 4; ++m) { tv[ai][m] = tokslot[row0 + ai * HALF + m * 16]; wv[ai][m] = wslot[row0 + ai * HALF + m * 16]; }
        asm volatile("" ::: "memory");
#pragma unroll
        for (int ai = 0; ai < 2; ++ai)
#pragma unroll
            for (int m = 0; m < 4; ++m) {
                const int ts = tv[ai][m]; const float w = I8 ? wv[ai][m] * swd : wv[ai][m];
                if (ts >= 0) {
                    bf16_t* yp = Y + (size_t)ts * D + colt;
#pragma unroll
                    for (int bj = 0; bj < 2; ++bj) {
                        if (I8) { f32x4 a0, a1;
#pragma unroll
                            for (int j = 0; j < 4; ++j) { a0[j] = (float)__float_as_int(acc[ai][bj][m][0][j]) * w; a1[j] = (float)__float_as_int(acc[ai][bj][m][1][j]) * w; }
                            *(u32x4*)(yp + bj * HALF) = pack8(a0, a1);
                        } else *(u32x4*)(yp + bj * HALF) = pack8(acc[ai][bj][m][0] * w, acc[ai][bj][m][1] * w); } } }
    }
};
}

struct Args {
    const float* in[26];
    float* out; unsigned char* ws;
    int ph_lo, ph_hi;
};
constexpr int NPHASE = 20;

#define CAS __attribute__((address_space(4)))
struct ArgView {
    const CAS unsigned char* kp;
    __device__ __forceinline__ const float* in_(int i) const { return *(const float* const CAS*)(kp + 8 * i); }
    __device__ __forceinline__ float* out_() const { return *(float* const CAS*)(kp + 208); }
    __device__ __forceinline__ unsigned char* ws_() const { return *(unsigned char* const CAS*)(kp + 216); }
};
struct Ctx {
    LAS unsigned char* lds; int tid, lane, wave, G, bid;
    ArgView av;
};
static_assert(sizeof(Args) == 232, "Args layout vs ArgView offsets");

__device__ __forceinline__ void p0_adaln(const Ctx& cx) {
    const ArgView a = cx.av;
    const float* w_ada = a.in_(4); const float* b_ada = a.in_(5); const float* cvec = a.in_(1); const float* cctx = a.in_(3);
    float* mod = (float*)(a.ws_() + WS_CTL + CTL_MOD);
    const int lane = cx.lane, w = cx.wave;
    LAS float* red = (LAS float*)cx.lds;
    for (int task = cx.bid; task < 2 * 96; task += cx.G) {
        const int l = task / 96, cg = task % 96;
        const int k0 = w * 256, n0 = cg * 128 + lane * 2;
        const float* W = w_ada + ((size_t)l * D + k0) * 12288 + n0;
        f32x2 acc[3] = {(f32x2){0.f, 0.f}, (f32x2){0.f, 0.f}, (f32x2){0.f, 0.f}};
        for (int h = 0; h < 4; ++h) {
            const float s0 = silu_f(cvec[k0 + 64 * h + lane]), s1 = silu_f(cvec[D + k0 + 64 * h + lane]), s2 = silu_f(cctx[k0 + 64 * h + lane]);
#pragma unroll
            for (int jb = 0; jb < 2; ++jb) {
                f32x2 wv[32];
#pragma unroll
                for (int j = 0; j < 32; ++j) wv[j] = __builtin_nontemporal_load((const f32x2*)(W + (size_t)(64 * h + 32 * jb + j) * 12288));
                asm volatile("" ::: "memory");
#pragma unroll
                for (int j = 0; j < 32; ++j) {
                    acc[0] += wv[j] * __int_as_float(__builtin_amdgcn_readlane(__float_as_int(s0), 32 * jb + j));
                    acc[1] += wv[j] * __int_as_float(__builtin_amdgcn_readlane(__float_as_int(s1), 32 * jb + j));
                    acc[2] += wv[j] * __int_as_float(__builtin_amdgcn_readlane(__float_as_int(s2), 32 * jb + j));
                }
            }
        }
#pragma unroll
        for (int r = 0; r < 3; ++r) *(LAS f32x2*)(red + (w * 3 + r) * 128 + 2 * lane) = acc[r];
        __syncthreads();
        for (int idx = cx.tid; idx < 384; idx += NTHR) { const int r = idx >> 7, c = idx & 127;
            float sum = b_ada[(size_t)l * 12288 + cg * 128 + c];
#pragma unroll
            for (int ww = 0; ww < 8; ++ww) sum += red[(ww * 3 + r) * 128 + c];
            mod[((size_t)l * 3 + r) * 12288 + cg * 128 + c] = sum; }
        __syncthreads();
    }
    f32x2* tab = (f32x2*)(a.ws_() + WS_ROPE);
    for (int idx = cx.bid * NTHR + cx.tid; idx < 128 * 32; idx += cx.G * NTHR) {
        const int pos = idx >> 5, i = idx & 31;
        const float invf = powf(10000.0f, -(float)i / 32.0f); const float ang = (float)pos * invf;
        tab[idx] = (f32x2){cosf(ang), sinf(ang)};
    }
}

__device__ __forceinline__ void tr_item(const float* src, int N, int k0, int n0, bf16_t* dst, int ldd, int drow0, LAS float* scr, int lane, int shift32 = 0) {
    f32x4 v[16];
    const float* p = src + (size_t)(k0 + (lane >> 4)) * N + n0 + 4 * (lane & 15);
#pragma unroll
    for (int i = 0; i < 16; ++i) v[i] = __builtin_nontemporal_load((const f32x4*)(p + (size_t)(4 * i) * N));
#pragma unroll
    for (int i = 0; i < 16; ++i) { LAS float* s = scr + (4 * i + (lane >> 4)) * 65 + 4 * (lane & 15); s[0] = v[i][0]; s[1] = v[i][1]; s[2] = v[i][2]; s[3] = v[i][3]; }
    LDS_WAIT();
    const int c = lane & 7;
#pragma unroll
    for (int jj = 0; jj < 8; ++jj) { const int n = (lane >> 3) + 8 * jj; const LAS float* s = scr + (8 * c) * 65 + n;
        u32x4 o; o.x = cvt_pk_bf16(s[0], s[65]); o.y = cvt_pk_bf16(s[2 * 65], s[3 * 65]); o.z = cvt_pk_bf16(s[4 * 65], s[5 * 65]); o.w = cvt_pk_bf16(s[6 * 65], s[7 * 65]);
        *(u32x4*)(dst + (size_t)(drow0 + n + (n >= 32 ? shift32 : 0)) * ldd + k0 + 8 * c) = o; }
    LDS_WAIT();
}
__device__ __forceinline__ unsigned pk4_i8(float a, float b, float c, float d) {
    const int q0 = (int)fminf(fmaxf(__builtin_rintf(a), -127.f), 127.f), q1 = (int)fminf(fmaxf(__builtin_rintf(b), -127.f), 127.f);
    const int q2 = (int)fminf(fmaxf(__builtin_rintf(c), -127.f), 127.f), q3 = (int)fminf(fmaxf(__builtin_rintf(d), -127.f), 127.f);
    return (unsigned)(q0 & 255) | ((unsigned)(q1 & 255) << 8) | ((unsigned)(q2 & 255) << 16) | ((unsigned)(q3 & 255) << 24); }
__device__ __forceinline__ void tr_item_i8(const float* src, int N, int k0, int n0, unsigned char* dst, int ldd, int drow0, const unsigned* amaxp, LAS float* scr, int lane, int shift32 = 0) {
    const unsigned ab = __hip_atomic_load(amaxp, __ATOMIC_RELAXED, __HIP_MEMORY_SCOPE_AGENT);
    f32x4 v[16];
    const float* p = src + (size_t)(k0 + (lane >> 4)) * N + n0 + 4 * (lane & 15);
#pragma unroll
    for (int i = 0; i < 16; ++i) v[i] = __builtin_nontemporal_load((const f32x4*)(p + (size_t)(4 * i) * N));
#pragma unroll
    for (int i = 0; i < 16; ++i) { LAS float* s_ = scr + (4 * i + (lane >> 4)) * 65 + 4 * (lane & 15); s_[0] = v[i][0]; s_[1] = v[i][1]; s_[2] = v[i][2]; s_[3] = v[i][3]; }
    LDS_WAIT();
    const float inv = 127.0f / fmaxf(__uint_as_float(ab), 1e-20f);
    const int c = lane & 7;
#pragma unroll
    for (int jj = 0; jj < 8; ++jj) { const int n = (lane >> 3) + 8 * jj; const LAS float* s_ = scr + (8 * c) * 65 + n;
        const u32x2 o = (u32x2){pk4_i8(s_[0] * inv, s_[65] * inv, s_[2 * 65] * inv, s_[3 * 65] * inv), pk4_i8(s_[4 * 65] * inv, s_[5 * 65] * inv, s_[6 * 65] * inv, s_[7 * 65] * inv)};
        *(u32x2*)(dst + (size_t)(drow0 + n + (n >= 32 ? shift32 : 0)) * ldd + k0 + 8 * c) = o; }
    LDS_WAIT();
}
constexpr int CV_IN = 32 * 80, CV_GT = 32 * 64, CV_A = 16 * 32, CV_O = 32 * 32, CV_EG = 32 * 32 * 8, CV_ED = 32 * 8 * 32;
constexpr int CV_DENSE = CV_IN + CV_GT + 2 * CV_A + CV_O, CV_EXP = 2 * CV_EG + CV_ED, CV_LAYER = CV_DENSE + CV_EXP;
static_assert(CV_DENSE == 6656 && CV_LAYER == 31232, "conversion item counts");
constexpr int CQ_TOTAL = CV_EXP + CV_LAYER;
__device__ __forceinline__ void conv_item(const ArgView a, int l, int r, LAS float* scr, int lane) {
    unsigned char* wset = a.ws_() + (size_t)l * WSET_BYTES;
    bf16_t* WC = (bf16_t*)(wset + WS_WC);
    if (r < CV_IN) { const int kb = r / 80, nb = r % 80, n0 = 64 * nb;
        int drow0 = n0, sh = 0;
        if (n0 >= 3072 && n0 < 4096) { const int lo = n0 - 3072; drow0 = 3072 + (lo & ~255) + 64 * ((lo >> 7) & 1) + 32 * ((lo >> 6) & 1); sh = 96; }
        if (MK_I8IN) {
            tr_item_i8(a.in_(8) + (size_t)l * D * INW, INW, 64 * kb, n0, (unsigned char*)(wset + WS_WC), D, drow0, (const unsigned*)(a.ws_() + WS_CTL) + CW_GMAX + 2 + l, scr, lane, sh);
        } else
        tr_item(a.in_(8) + (size_t)l * D * INW, INW, 64 * kb, n0, WC, D, drow0, scr, lane, sh); return; } r -= CV_IN;
    if (r < CV_GT) { const int kb = r / 64, nb = r % 64, n0 = 64 * nb, c = n0 & (D - 1);
        if (MK_I8GATE) {
            tr_item_i8(a.in_(13) + (size_t)l * D * GATEW, GATEW, 64 * kb, n0, (unsigned char*)(wset + WS_WC) + (size_t)INW * D * 2, D, 256 * (c >> 7) + (c & 127) + 128 * (n0 >> 11), (const unsigned*)(a.ws_() + WS_CTL) + CW_GMAX + l, scr, lane);
        } else
        tr_item(a.in_(13) + (size_t)l * D * GATEW, GATEW, 64 * kb, n0, WC, D, INW + 256 * (c >> 7) + (c & 127) + 128 * (n0 >> 11), scr, lane); return; } r -= CV_GT;
    if (r < 2 * CV_A) { const int b = r / CV_A; r %= CV_A; const int kb = r / 32, nb = r % 32;
        if (I8SEL(MK_I8M, l))
            tr_item_i8(a.in_(15 + b) + (size_t)l * SGUW * D, D, 64 * kb, 64 * nb, wset + WS_WA + (size_t)b * SGUW, D, 64 * nb, (const unsigned*)(a.ws_() + WS_CTL) + CW_GMAX + 6 + 2 * l + b, scr, lane);
        else
        tr_item(a.in_(15 + b) + (size_t)l * SGUW * D, D, 64 * kb, 64 * nb, (bf16_t*)(wset + WS_WA) + (size_t)b * SGUW, D, 64 * nb, scr, lane); return; } r -= 2 * CV_A;
    if (r < CV_O) { const int kb = r / 32, nb = r % 32;
        if (I8SEL(MK_I8O, l)) {
            tr_item_i8(a.in_(17) + (size_t)l * D * D, D, 64 * kb, 64 * nb, wset + WS_WO, D, 64 * nb, (const unsigned*)(a.ws_() + WS_CTL) + CW_GMAX + 4 + l, scr, lane);
        } else
        tr_item(a.in_(17) + (size_t)l * D * D, D, 64 * kb, 64 * nb, (bf16_t*)(wset + WS_WO), D, 64 * nb, scr, lane); return; } r -= CV_O;
    if (r < 2 * CV_EG) { const int up = r / CV_EG; r %= CV_EG; const int e = r / 256, q = r % 256, kb = q / 8, nb = q % 8, n0 = 64 * nb;
        const float* src = a.in_(22 + up) + ((size_t)l * NEXP + e) * D * DEXP;
        if (I8SEL(MK_I8E, l)) {
            tr_item_i8(src, DEXP, 64 * kb, n0, wset + WS_WGU + (size_t)e * 1024 * D, D, 256 * (n0 >> 7) + (n0 & 127) + 128 * up, (const unsigned*)(a.ws_() + WS_CTL) + CW_EMAX + 64 * l + 2 * e + up, scr, lane);
        } else
        tr_item(src, DEXP, 64 * kb, n0, (bf16_t*)(wset + WS_WGU) + (size_t)e * 1024 * D, D, 256 * (n0 >> 7) + (n0 & 127) + 128 * up, scr, lane); return; } r -= 2 * CV_EG;
    { const int e = r / 256, q = r % 256, kb = q / 32, nb = q % 32;
      if (I8SEL(MK_I8D, l)) {
          tr_item_i8(a.in_(24) + ((size_t)l * NEXP + e) * DEXP * D, D, 64 * kb, 64 * nb, wset + WS_WD + (size_t)e * D * DEXP, DEXP, 64 * nb, (const unsigned*)(a.ws_() + WS_CTL) + CW_DMAX + 32 * l + e, scr, lane);
      } else
      tr_item(a.in_(24) + ((size_t)l * NEXP + e) * DEXP * D, D, 64 * kb, 64 * nb, (bf16_t*)(wset + WS_WD) + (size_t)e * D * DEXP, DEXP, 64 * nb, scr, lane); }
}
__device__ __forceinline__ void conv_range(const Ctx& cx, int qlo, int qhi, int rank, int nblk) {
    LAS float* scr = (LAS float*)(cx.lds + cx.wave * 16640);
    for (int q = qlo + rank * NWAVES + cx.wave; q < qhi; q += nblk * NWAVES) {
        if (q < CV_EXP) conv_item(cx.av, 0, CV_DENSE + q, scr, cx.lane); else conv_item(cx.av, 1, q - CV_EXP, scr, cx.lane); }
}
__device__ __forceinline__ void conv_tail(const Ctx& cx, int nwg, int qlo, int qhi) {
    const int rem = nwg % cx.G;
    if (rem == 0) conv_range(cx, qlo, qhi, cx.bid, cx.G);
    else if (cx.bid >= rem) conv_range(cx, qlo, qhi, cx.bid - rem, cx.G - rem);
}
__device__ __forceinline__ void conv_gate0(const Ctx& cx) {
    LAS float* scr = (LAS float*)(cx.lds + cx.wave * 16640);
    for (int r = (MK_I8IN ? 0 : CV_IN) + cx.bid * NWAVES + cx.wave; r < CV_IN + CV_GT; r += cx.G * NWAVES) conv_item(cx.av, 0, r, scr, cx.lane);
    if (MK_I8O & 1) for (int r = CV_DENSE - CV_O + cx.bid * NWAVES + cx.wave; r < CV_DENSE; r += cx.G * NWAVES) conv_item(cx.av, 0, r, scr, cx.lane);
    if (MK_I8M & 1) for (int r = CV_IN + CV_GT + cx.bid * NWAVES + cx.wave; r < CV_DENSE - CV_O; r += cx.G * NWAVES) conv_item(cx.av, 0, r, scr, cx.lane);
}
__device__ __forceinline__ int gemm_wgs(int nwg, int G) { const int rounds = (nwg + G - 1) / G; int g = rounds > 0 ? (nwg + rounds - 1) / rounds : G; g = (g + 7) & ~7; return g < G ? g : G; }
__device__ __forceinline__ void conv_side(const Ctx& cx, int Gg, int qlo, int qhi) {
    if (qhi <= qlo) return;
    if (Gg >= cx.G) conv_range(cx, qlo, qhi, cx.bid, cx.G);
    else if (cx.bid >= Gg) conv_range(cx, qlo, qhi, cx.bid - Gg, cx.G - Gg);
}
__device__ __forceinline__ void pw_convert0(const Ctx& cx) {
    const ArgView a = cx.av;
    LAS float* scr = (LAS float*)(cx.lds + cx.wave * 16640);
#define CV_SKIP_GATE(r) ((MK_I8GATE && (r) >= CV_IN && (r) < CV_IN + CV_GT) || (MK_I8IN && (r) < CV_IN) || ((MK_I8O & 1) && (r) >= CV_DENSE - CV_O) || ((MK_I8M & 1) && (r) >= CV_IN + CV_GT && (r) < CV_DENSE - CV_O))
    if (cx.G >= 224) { if (cx.bid >= 192) for (int r = (cx.bid - 192) * NWAVES + cx.wave; r < CV_DENSE; r += (cx.G - 192) * NWAVES) { if (!CV_SKIP_GATE(r)) conv_item(a, 0, r, scr, cx.lane); } }
    else for (int r = cx.bid * NWAVES + cx.wave; r < CV_DENSE; r += cx.G * NWAVES) { if (!CV_SKIP_GATE(r)) conv_item(a, 0, r, scr, cx.lane); }
#undef CV_SKIP_GATE
#define WG_PUSH_MAX(val, word) do { LAS float* r_ = (LAS float*)(cx.lds + LDS_MISC + 128); if (cx.lane == 0) r_[cx.wave] = (val); __syncthreads(); \
        if (cx.tid == 0) { float mm_ = r_[0]; for (int i_ = 1; i_ < NWAVES; ++i_) mm_ = fmaxf(mm_, r_[i_]); \
            __hip_atomic_fetch_max((unsigned*)(a.ws_() + WS_CTL) + (word), __float_as_uint(mm_), __ATOMIC_RELAXED, __HIP_MEMORY_SCOPE_AGENT); } __syncthreads(); } while (0)
    if (MK_I8GATE) {
        for (int l = 0; l < 2; ++l) { const f32x4* w = (const f32x4*)(a.in_(13) + (size_t)l * D * GATEW); float m = 0.f;
            for (int i = cx.bid * NTHR + cx.tid; i < (D / 8) * (GATEW / 4); i += cx.G * NTHR) { const f32x4 v = w[(size_t)(i / (GATEW / 4)) * 8 * (GATEW / 4) + i % (GATEW / 4)]; m = fmaxf(m, fmaxf(fmaxf(fabsf(v[0]), fabsf(v[1])), fmaxf(fabsf(v[2]), fabsf(v[3])))); }
#pragma unroll
            for (int o = 1; o < 64; o <<= 1) m = fmaxf(m, __shfl_xor(m, o));
            WG_PUSH_MAX(m * GMAX_MARGIN, CW_GMAX + l); }
    }
    if (MK_I8IN) {
        for (int l = 0; l < 2; ++l) { const f32x4* w = (const f32x4*)(a.in_(8) + (size_t)l * D * INW); float m = 0.f;
            for (int i = cx.bid * NTHR + cx.tid; i < (D / 8) * (INW / 4); i += cx.G * NTHR) { const f32x4 v = w[(size_t)(i / (INW / 4)) * 8 * (INW / 4) + i % (INW / 4)]; m = fmaxf(m, fmaxf(fmaxf(fabsf(v[0]), fabsf(v[1])), fmaxf(fabsf(v[2]), fabsf(v[3])))); }
#pragma unroll
            for (int o = 1; o < 64; o <<= 1) m = fmaxf(m, __shfl_xor(m, o));
            WG_PUSH_MAX(m * GMAX_MARGIN, CW_GMAX + 2 + l); }
    }
    if (MK_I8M) {
        for (int mb = 0; mb < 4; ++mb) { const int l = mb >> 1, b = mb & 1; const f32x4* w = (const f32x4*)(a.in_(15 + b) + (size_t)l * SGUW * D); float m = 0.f;
            for (int i = cx.bid * NTHR + cx.tid; i < (SGUW / 8) * (D / 4); i += cx.G * NTHR) { const f32x4 v = w[(size_t)(i / (D / 4)) * 8 * (D / 4) + i % (D / 4)]; m = fmaxf(m, fmaxf(fmaxf(fabsf(v[0]), fabsf(v[1])), fmaxf(fabsf(v[2]), fabsf(v[3])))); }
#pragma unroll
            for (int o = 1; o < 64; o <<= 1) m = fmaxf(m, __shfl_xor(m, o));
            WG_PUSH_MAX(m * GMAX_MARGIN, CW_GMAX + 6 + 2 * l + b); }
    }
    if (MK_I8O) {
        for (int l = 0; l < 2; ++l) { const f32x4* w = (const f32x4*)(a.in_(17) + (size_t)l * D * D); float m = 0.f;
            for (int i = cx.bid * NTHR + cx.tid; i < (D / 8) * (D / 4); i += cx.G * NTHR) { const f32x4 v = w[(size_t)(i / (D / 4)) * 8 * (D / 4) + i % (D / 4)]; m = fmaxf(m, fmaxf(fmaxf(fabsf(v[0]), fabsf(v[1])), fmaxf(fabsf(v[2]), fabsf(v[3])))); }
#pragma unroll
            for (int o = 1; o < 64; o <<= 1) m = fmaxf(m, __shfl_xor(m, o));
            WG_PUSH_MAX(m * GMAX_MARGIN, CW_GMAX + 4 + l); }
    }
    if (MK_I8D) {
        for (int uu = cx.bid * NWAVES + cx.wave; uu < 1024; uu += cx.G * NWAVES) {
            const int mat = uu >> 4, part = uu & 15, l = mat >> 5, e = mat & 31;
            if (!(I8SEL(MK_I8D, l))) continue;
            const float* src = a.in_(24) + ((size_t)l * NEXP + e) * DEXP * D + (size_t)(part * 32) * D;
            f32x4 v[8];
#pragma unroll
            for (int j = 0; j < 8; ++j) v[j] = *(const f32x4*)(src + 4 * (j * 64 + cx.lane));
            float m = 0.f;
#pragma unroll
            for (int j = 0; j < 8; ++j) m = fmaxf(m, fmaxf(fmaxf(fabsf(v[j][0]), fabsf(v[j][1])), fmaxf(fabsf(v[j][2]), fabsf(v[j][3]))));
#pragma unroll
            for (int o = 1; o < 64; o <<= 1) m = fmaxf(m, __shfl_xor(m, o));
            if (cx.lane == 0) __hip_atomic_fetch_max((unsigned*)(a.ws_() + WS_CTL) + CW_DMAX + 32 * l + e, __float_as_uint(m * EMAX_MARGIN), __ATOMIC_RELAXED, __HIP_MEMORY_SCOPE_AGENT);
        }
    }
    if (MK_I8E) {
        for (int uu = cx.bid * NWAVES + cx.wave; uu < 2048; uu += cx.G * NWAVES) {
            const int mat = uu >> 4, part = uu & 15, l = mat >> 6, up = (mat >> 5) & 1, e = mat & 31;
            if (!(I8SEL(MK_I8E, l))) continue;
            const float* src = a.in_(22 + up) + ((size_t)l * NEXP + e) * D * DEXP;
            f32x4 v[8];
#pragma unroll
            for (int j = 0; j < 8; ++j) { const int idx = j * 64 + cx.lane; v[j] = *(const f32x4*)(src + (size_t)((part * 4 + (idx >> 7)) * 32) * DEXP + 4 * (idx & 127)); }
            float m = 0.f;
#pragma unroll
            for (int j = 0; j < 8; ++j) m = fmaxf(m, fmaxf(fmaxf(fabsf(v[j][0]), fabsf(v[j][1])), fmaxf(fabsf(v[j][2]), fabsf(v[j][3]))));
#pragma unroll
            for (int o = 1; o < 64; o <<= 1) m = fmaxf(m, __shfl_xor(m, o));
            if (cx.lane == 0) __hip_atomic_fetch_max((unsigned*)(a.ws_() + WS_CTL) + CW_EMAX + 64 * l + 2 * e + up, __float_as_uint(m * EMAX_MARGIN), __ATOMIC_RELAXED, __HIP_MEMORY_SCOPE_AGENT);
        }
    }
    for (int idx = cx.bid * NTHR + cx.tid; idx < 2 * 48 * D; idx += cx.G * NTHR) {
        const int l = idx / (48 * D), id = idx % (48 * D), row = id / D, k = id % D;
        const float* wre = a.in_(20) + (size_t)l * D * NEXP; const float* wrg = a.in_(18) + (size_t)l * D * 4;
        bf16_t* WR = (bf16_t*)(a.ws_() + (size_t)l * WSET_BYTES + WS_WR);
        const float v = row < 32 ? wre[(size_t)k * NEXP + row] : (row < 36 ? wrg[(size_t)k * 4 + (row - 32)] : 0.f);
        const int mt = row >> 4, fr = row & 15, ki = k >> 5, fq = (k >> 3) & 3, j = k & 7;
        WR[(((size_t)mt * 64 + ki) * 64 + fq * 16 + fr) * 8 + j] = (bf16_t)(cvt_pk_bf16(v, 0.f) & 0xffffu);
    }
}

#define ROW_E(jj) (8 * (lane + 64 * ((jj) >> 1)) + 4 * ((jj) & 1))
template <int MODE>
__device__ __forceinline__ void norm_phase(const Ctx& cx, int T) {
    const ArgView a = cx.av;
    const int gw = cx.bid * NWAVES + cx.wave, NGW = cx.G * NWAVES, lane = cx.lane;
    const int t0 = (int)((long)gw * T / NGW), t1 = (int)((long)(gw + 1) * T / NGW);
    bf16_t* xs = (bf16_t*)(a.ws_() + WS_XS); bf16_t* hx = (bf16_t*)(a.ws_() + WS_HX); const bf16_t* yb = (const bf16_t*)(a.ws_() + WS_G);
    const float* modbase = (const float*)(a.ws_() + WS_CTL + CTL_MOD);
    const int lcur = (MODE == 0) ? 0 : 1;
    const float* nw = (MODE == 2) ? a.in_(25) : (a.in_(6) + (size_t)lcur * D);
    const bool do_comb = (MODE == 1) ? ((MK_MASK & 2) != 0) : ((MODE == 2) ? ((MK_MASK & 8) != 0) : false);
    const int lprev = (MODE == 2) ? 1 : 0;
    f32x4 vA[8], vB[8], vG[8]; int curcls = -1;
    f32x4 nxf[8]; u32x4 nxs[4], ny0[4], ny1[4];
    auto fetch = [&](int tk) {
        if (MODE == 0) {
            const float* xr = tk < MLAT ? a.in_(0) + (size_t)tk * D : a.in_(2) + (size_t)(tk - MLAT) * D;
#pragma unroll
            for (int j = 0; j < 8; ++j) nxf[j] = __builtin_nontemporal_load((const f32x4*)(xr + ROW_E(j)));
        } else {
#pragma unroll
            for (int j = 0; j < 4; ++j) nxs[j] = __builtin_nontemporal_load((const u32x4*)(xs + (size_t)tk * D + 8 * (lane + 64 * j)));
            if (do_comb) { const bf16_t* y0 = yb + (size_t)tk * 2 * D;
#pragma unroll
                for (int j = 0; j < 4; ++j) { ny0[j] = __builtin_nontemporal_load((const u32x4*)(y0 + 8 * (lane + 64 * j))); ny1[j] = __builtin_nontemporal_load((const u32x4*)(y0 + D + 8 * (lane + 64 * j))); } }
        }
    };
    if (gw < T) fetch(gw);
    for (int tok = gw; tok < T; tok += NGW) {
        const int cls = tok < SEQ ? 0 : (tok < MLAT ? 1 : 2);
        if (cls != curcls) { curcls = cls;
#define NP_TAB(R) _Pragma("unroll") for (int jj = 0; jj < 8; ++jj) { const int j = (jj + (R)) & 7; const int e = ROW_E(j); const f32x4 w = *(const f32x4*)(nw + e); \
                if (MODE == 2) { vA[j] = w; vB[j] = (f32x4){0.f, 0.f, 0.f, 0.f}; } \
                else { const float* mp = modbase + ((size_t)lcur * 3 + cls) * 12288; vA[j] = w * (*(const f32x4*)(mp + D + e) + 1.0f); vB[j] = *(const f32x4*)(mp + e); } \
                if (MODE != 0) vG[j] = *(const f32x4*)(modbase + ((size_t)lprev * 3 + cls) * 12288 + 5 * D + e); }
            switch (cx.bid & 3) { case 0: NP_TAB(0) break; case 1: NP_TAB(2) break; case 2: NP_TAB(4) break; default: NP_TAB(6) break; }
#undef NP_TAB
        }
        f32x4 v[8]; float ss = 0.f;
        if (MODE == 0) {
#pragma unroll
            for (int j = 0; j < 8; ++j) v[j] = nxf[j];
        } else {
#pragma unroll
            for (int j = 0; j < 4; ++j) pg8::unpack8(nxs[j], v[2 * j], v[2 * j + 1]);
        }
        u32x4 cy0[4], cy1[4];
        if (MODE != 0 && do_comb) {
#pragma unroll
            for (int j = 0; j < 4; ++j) { cy0[j] = ny0[j]; cy1[j] = ny1[j]; }
        }
        if (tok + NGW < T) fetch(tok + NGW);
        asm volatile("" ::: "memory");
        if (MODE != 0 && do_comb) {
#pragma unroll
            for (int j = 0; j < 4; ++j) { const u32x4 p0 = cy0[j], p1 = cy1[j];
                f32x4 a0, a1, b0, b1; pg8::unpack8(p0, a0, a1); pg8::unpack8(p1, b0, b1);
                v[2 * j] += vG[2 * j] * (a0 + b0); v[2 * j + 1] += vG[2 * j + 1] * (a1 + b1); }
            if (MODE == 1) {
#pragma unroll
                for (int j = 0; j < 4; ++j) { const u32x4 pk = pg8::pack8(v[2 * j], v[2 * j + 1]); *(u32x4*)(xs + (size_t)tok * D + 8 * (lane + 64 * j)) = pk;
                    pg8::unpack8(pk, v[2 * j], v[2 * j + 1]); }
            }
        }
#pragma unroll
        for (int j = 0; j < 8; ++j) ss += (v[j][0] * v[j][0] + v[j][1] * v[j][1]) + (v[j][2] * v[j][2] + v[j][3] * v[j][3]);
        const float rstd = 1.0f / sqrtf(wave_sum(ss) * (1.0f / D) + RMS_EPS);
        if (MODE == 2) {
#pragma unroll
            for (int j = 0; j < 8; ++j) *(f32x4*)(a.out_() + (size_t)tok * D + ROW_E(j)) = v[j] * rstd * vA[j];
        } else {
            float hmax = 0.f;
#pragma unroll
            for (int j = 0; j < 8; ++j) { v[j] = v[j] * rstd * vA[j] + vB[j]; hmax = fmaxf(hmax, fmaxf(fmaxf(fabsf(v[j][0]), fabsf(v[j][1])), fmaxf(fabsf(v[j][2]), fabsf(v[j][3])))); }
            if (!(MK_I8GATE && MK_I8IN)) {
#pragma unroll
            for (int j = 0; j < 4; ++j) *(u32x4*)(hx + (size_t)tok * D + 8 * (lane + 64 * j)) = pg8::pack8(v[2 * j], v[2 * j + 1]); }
            if (MK_I8GATE) {
#pragma unroll
                for (int o = 1; o < 64; o <<= 1) hmax = fmaxf(hmax, __shfl_xor(hmax, o));
                hmax = fmaxf(hmax, 1e-20f); const float inv = 127.0f / hmax;
                unsigned char* h8 = a.ws_() + WS_HX8 + (size_t)tok * D;
#pragma unroll
                for (int j = 0; j < 4; ++j) *(u32x2*)(h8 + 8 * (lane + 64 * j)) = (u32x2){pk4_i8(v[2 * j][0] * inv, v[2 * j][1] * inv, v[2 * j][2] * inv, v[2 * j][3] * inv), pk4_i8(v[2 * j + 1][0] * inv, v[2 * j + 1][1] * inv, v[2 * j + 1][2] * inv, v[2 * j + 1][3] * inv)};
                if (lane == 0) ((float*)(a.ws_() + WS_SX))[tok] = hmax * (1.0f / 127.0f);
            }
        }
    }
}

__device__ __forceinline__ void quant_rows2048(const Ctx& cx, const bf16_t* src, unsigned char* dst, float* scale, int nrows) {
    const int gw = cx.bid * NWAVES + cx.wave, NGW = cx.G * NWAVES, lane = cx.lane;
    u32x4 nx[4];
    if (gw < nrows) {
#pragma unroll
        for (int j = 0; j < 4; ++j) nx[j] = *(const u32x4*)(src + (size_t)gw * D + 8 * (lane + 64 * j)); }
    for (int row = gw; row < nrows; row += NGW) {
        f32x4 v[8];
#pragma unroll
        for (int j = 0; j < 4; ++j) pg8::unpack8(nx[j], v[2 * j], v[2 * j + 1]);
        if (row + NGW < nrows) {
#pragma unroll
            for (int j = 0; j < 4; ++j) nx[j] = *(const u32x4*)(src + (size_t)(row + NGW) * D + 8 * (lane + 64 * j)); }
        float hmax = 0.f;
#pragma unroll
        for (int j = 0; j < 8; ++j) hmax = fmaxf(hmax, fmaxf(fmaxf(fabsf(v[j][0]), fabsf(v[j][1])), fmaxf(fabsf(v[j][2]), fabsf(v[j][3]))));
#pragma unroll
        for (int o = 1; o < 64; o <<= 1) hmax = fmaxf(hmax, __shfl_xor(hmax, o));
        hmax = fmaxf(hmax, 1e-20f); const float inv = 127.0f / hmax;
        unsigned char* h8 = dst + (size_t)row * D;
#pragma unroll
        for (int j = 0; j < 4; ++j) *(u32x2*)(h8 + 8 * (lane + 64 * j)) = (u32x2){pk4_i8(v[2 * j][0] * inv, v[2 * j][1] * inv, v[2 * j][2] * inv, v[2 * j][3] * inv), pk4_i8(v[2 * j + 1][0] * inv, v[2 * j + 1][1] * inv, v[2 * j + 1][2] * inv, v[2 * j + 1][3] * inv)};
        if (lane == 0) scale[row] = hmax * (1.0f / 127.0f);
    }
}

__device__ __forceinline__ void quant_rows_ao(const Ctx& cx, const bf16_t* src, unsigned char* dst, float* cab, float* sob, float swa, float swb, int nrows) {
    const int gw = cx.bid * NWAVES + cx.wave, NGW = cx.G * NWAVES, lane = cx.lane;
    u32x4 nx[4];
    if (gw < nrows) {
#pragma unroll
        for (int j = 0; j < 4; ++j) nx[j] = *(const u32x4*)(src + (size_t)gw * D + 8 * (lane + 64 * j)); }
    for (int row = gw; row < nrows; row += NGW) {
        f32x4 v[8];
#pragma unroll
        for (int j = 0; j < 4; ++j) pg8::unpack8(nx[j], v[2 * j], v[2 * j + 1]);
        if (row + NGW < nrows) {
#pragma unroll
            for (int j = 0; j < 4; ++j) nx[j] = *(const u32x4*)(src + (size_t)(row + NGW) * D + 8 * (lane + 64 * j)); }
        float ma = 0.f, mo = 0.f;
#pragma unroll
        for (int j = 0; j < 4; ++j) { ma = fmaxf(ma, fmaxf(fmaxf(fabsf(v[j][0]), fabsf(v[j][1])), fmaxf(fabsf(v[j][2]), fabsf(v[j][3])))); mo = fmaxf(mo, fmaxf(fmaxf(fabsf(v[4 + j][0]), fabsf(v[4 + j][1])), fmaxf(fabsf(v[4 + j][2]), fabsf(v[4 + j][3])))); }
#pragma unroll
        for (int o = 1; o < 64; o <<= 1) { ma = fmaxf(ma, __shfl_xor(ma, o)); mo = fmaxf(mo, __shfl_xor(mo, o)); }
        ma = fmaxf(ma, 1e-20f); mo = fmaxf(mo, 1e-20f); const float ia = 127.0f / ma, io = 127.0f / mo;
        unsigned char* h8 = dst + (size_t)row * D;
#pragma unroll
        for (int j = 0; j < 4; ++j) { const float inv = j < 2 ? ia : io;
            *(u32x2*)(h8 + 8 * (lane + 64 * j)) = (u32x2){pk4_i8(v[2 * j][0] * inv, v[2 * j][1] * inv, v[2 * j][2] * inv, v[2 * j][3] * inv), pk4_i8(v[2 * j + 1][0] * inv, v[2 * j + 1][1] * inv, v[2 * j + 1][2] * inv, v[2 * j + 1][3] * inv)}; }
        if (lane == 0) { const float sa = ma * (1.0f / 127.0f) * swa, so_ = mo * (1.0f / 127.0f) * swb; cab[row] = sa / so_; sob[row] = so_; }
    }
}
__device__ __forceinline__ void quant_rows512(const Ctx& cx, const bf16_t* src, unsigned char* dst, float* scale, const float* wslot, int nrows) {
    const int gw = cx.bid * NWAVES + cx.wave, NGW = cx.G * NWAVES, lane = cx.lane;
    for (int r0 = gw * 4; r0 < nrows; r0 += NGW * 4) {
        u32x4 raw[4];
#pragma unroll
        for (int i = 0; i < 4; ++i) raw[i] = __builtin_nontemporal_load((const u32x4*)(src + (size_t)(r0 + i) * DEXP + 8 * lane));
#pragma unroll
        for (int i = 0; i < 4; ++i) {
            f32x4 a0, a1; pg8::unpack8(raw[i], a0, a1);
            float hmax = fmaxf(fmaxf(fmaxf(fabsf(a0[0]), fabsf(a0[1])), fmaxf(fabsf(a0[2]), fabsf(a0[3]))), fmaxf(fmaxf(fabsf(a1[0]), fabsf(a1[1])), fmaxf(fabsf(a1[2]), fabsf(a1[3]))));
#pragma unroll
            for (int o = 1; o < 64; o <<= 1) hmax = fmaxf(hmax, __shfl_xor(hmax, o));
            hmax = fmaxf(hmax, 1e-20f); const float inv = 127.0f / hmax;
            *(u32x2*)(dst + (size_t)(r0 + i) * DEXP + 8 * lane) = (u32x2){pk4_i8(a0[0] * inv, a0[1] * inv, a0[2] * inv, a0[3] * inv), pk4_i8(a1[0] * inv, a1[1] * inv, a1[2] * inv, a1[3] * inv)};
            if (lane == 0) scale[r0 + i] = hmax * (1.0f / 127.0f) * wslot[r0 + i];
        }
    }
}

__device__ __forceinline__ unsigned offa(unsigned row, unsigned ch);
template <int OFF> __device__ __forceinline__ void tr4(unsigned a0, unsigned a1, bf16x8 (&f)[4]);
__device__ __forceinline__ void sgu_item(const Ctx& cx, int l, int item) {
    const ArgView a = cx.av;
    const int lane = cx.lane, w = cx.wave, fq = lane >> 4, fr = lane & 15;
    int ck, g0, ng;
    if (item < 256) { ck = item >> 1; g0 = 4 * (item & 1); ng = 4; } else { const int ci = item - 256; ck = 128 + (ci >> 3); g0 = ci & 7; ng = 1; }
    const int row0 = ck < 128 ? ck * 128 : MLAT + (ck - 128) * 128;
    const bf16_t* P = (const bf16_t*)(a.ws_() + WS_P); bf16_t* AB = (bf16_t*)(a.ws_() + WS_A);
    const float* nw = a.in_(9) + (size_t)l * SGUW; const float* Ws = a.in_(10) + (size_t)l * 8 * 128 * 128; const float* bs = a.in_(11) + (size_t)l * 8 * 128;
    LAS float* rstdS = (LAS float*)cx.lds; LAS unsigned char* Vt = cx.lds + 1024; const unsigned vt_base = (unsigned)(size_t)Vt;
    auto stage = [&](int g, int buf) {
#pragma unroll
        for (int i = 0; i < 4; ++i) { const unsigned o = 1024u * (4 * w + i) + 16u * lane, srow = 8u * (o >> 11) + ((o >> 6) & 7u), sch = 4u * ((o >> 9) & 3u) + (((o >> 4) & 3u) ^ ((srow >> 2) & 3u));
            __builtin_amdgcn_global_load_lds((const unsigned*)(P + (size_t)(row0 + srow) * INW + SGUW + 128 * g + 8 * sch), (LAS unsigned*)(Vt + buf * 32768 + 1024 * (4 * w + i)), 16, 0, 0); }
    };
    stage(g0, 0);
#pragma unroll 8
    for (int i = 0; i < 16; ++i) { const int m = 16 * w + i; const bf16_t* vp = P + (size_t)(row0 + m) * INW + SGUW + 16 * lane;
        const u32x4 x0 = *(const u32x4*)vp, x1 = *(const u32x4*)(vp + 8); float ss = 0.f;
#pragma unroll
        for (int j = 0; j < 4; ++j) { const float p0 = bflo(x0[j]), p1 = bfhi(x0[j]), p2 = bflo(x1[j]), p3 = bfhi(x1[j]); ss += (p0 * p0 + p1 * p1) + (p2 * p2 + p3 * p3); }
        ss = wave_sum(ss);
        if (lane == 0) rstdS[m] = 1.0f / sqrtf(ss * (1.0f / SGUW) + RMS_EPS); }
    __syncthreads();
    for (int gi = 0; gi < ng; ++gi) {
        const int g = g0 + gi, buf = gi & 1;
        bf16x8 Wf[4];
#pragma unroll
        for (int ks = 0; ks < 4; ++ks) { const float* wp = Ws + ((size_t)g * 128 + 16 * w + fr) * 128 + 32 * ks + 8 * fq;
            const f32x4 r0 = *(const LAS f32x4*)(rstdS + 32 * ks + 8 * fq), r1 = *(const LAS f32x4*)(rstdS + 32 * ks + 8 * fq + 4);
            const f32x4 w0 = *(const f32x4*)wp * r0, w1 = *(const f32x4*)(wp + 4) * r1; const u32x4 pk = pg8::pack8(w0, w1);
            Wf[ks] = __builtin_bit_cast(bf16x8, pk); }
        __syncthreads();
        if (gi + 1 < ng) stage(g + 1, buf ^ 1);
        const int tok = row0 + 16 * w + fr; const float bias = bs[g * 128 + 16 * w + fr];
        u32x2 uuv[8]; f32x4 nvv[8];
#pragma unroll
        for (int ct = 0; ct < 8; ++ct) { const int c = 128 * g + 16 * ct + 4 * fq; uuv[ct] = *(const u32x2*)(P + (size_t)tok * INW + c); nvv[ct] = *(const f32x4*)(nw + c); }
        asm volatile("" ::: "memory");
        f32x4 acc[8];
#pragma unroll
        for (int ct = 0; ct < 8; ++ct) acc[ct] = (f32x4){0.f, 0.f, 0.f, 0.f};
        { unsigned ln = cx.lane; asm volatile("" : "+v"(ln));
          const unsigned fq_o = ln >> 4, q_o = (ln & 15u) >> 2, p_o = ln & 3u;
#pragma unroll
          for (int ks = 0; ks < 4; ++ks)
#pragma unroll
            for (int par = 0; par < 2; ++par) {
                const unsigned vrow0 = 32u * ks + 8u * fq_o + q_o;
                const unsigned a0 = vt_base + buf * 32768 + offa(vrow0, 2u * par + (p_o >> 1)) + 8u * (p_o & 1u);
                const unsigned a1 = vt_base + buf * 32768 + offa(vrow0 + 4u, 2u * par + (p_o >> 1)) + 8u * (p_o & 1u);
                bf16x8 vf[4]; tr4<0>(a0, a1, vf);
#pragma unroll
                for (int i = 0; i < 4; ++i) acc[par + 2 * i] = __builtin_amdgcn_mfma_f32_16x16x32_bf16(vf[i], Wf[ks], acc[par + 2 * i], 0, 0, 0); } }
#pragma unroll
        for (int ct = 0; ct < 8; ++ct) { const int c = 128 * g + 16 * ct + 4 * fq;
            const u32x2 uu = uuv[ct]; const f32x4 nv = nvv[ct];
            const float o0 = bflo(uu.x) * (acc[ct][0] * nv[0] + bias), o1 = bfhi(uu.x) * (acc[ct][1] * nv[1] + bias), o2 = bflo(uu.y) * (acc[ct][2] * nv[2] + bias), o3 = bfhi(uu.y) * (acc[ct][3] * nv[3] + bias);
            *(u32x2*)(AB + (size_t)tok * D + c) = (u32x2){cvt_pk_bf16(o0, o1), cvt_pk_bf16(o2, o3)}; }
    }
}

__device__ __forceinline__ unsigned offa(unsigned row, unsigned ch) { return 2048u * (row >> 3) + 512u * (ch >> 2) + 64u * (row & 7u) + 16u * ((ch & 3u) ^ ((row >> 2) & 3u)); }
template <int OFF>
__device__ __forceinline__ void tr4(unsigned a0, unsigned a1, bf16x8 (&f)[4]) {
    s16x4 r0, r1, r2, r3, r4, r5, r6, r7;
    asm volatile("ds_read_b64_tr_b16 %0, %8 offset:%10\n\tds_read_b64_tr_b16 %1, %9 offset:%10\n\t"
                 "ds_read_b64_tr_b16 %2, %8 offset:%11\n\tds_read_b64_tr_b16 %3, %9 offset:%11\n\t"
                 "ds_read_b64_tr_b16 %4, %8 offset:%12\n\tds_read_b64_tr_b16 %5, %9 offset:%12\n\t"
                 "ds_read_b64_tr_b16 %6, %8 offset:%13\n\tds_read_b64_tr_b16 %7, %9 offset:%13\n\t"
                 "s_waitcnt lgkmcnt(0)"
                 : "=&v"(r0), "=&v"(r1), "=&v"(r2), "=&v"(r3), "=&v"(r4), "=&v"(r5), "=&v"(r6), "=&v"(r7)
                 : "v"(a0), "v"(a1), "i"(OFF), "i"(OFF + 512), "i"(OFF + 1024), "i"(OFF + 1536) : "memory");
    f[0] = (bf16x8){r0[0], r0[1], r0[2], r0[3], r1[0], r1[1], r1[2], r1[3]}; f[1] = (bf16x8){r2[0], r2[1], r2[2], r2[3], r3[0], r3[1], r3[2], r3[3]};
    f[2] = (bf16x8){r4[0], r4[1], r4[2], r4[3], r5[0], r5[1], r5[2], r5[3]}; f[3] = (bf16x8){r6[0], r6[1], r6[2], r6[3], r7[0], r7[1], r7[2], r7[3]};
}
__device__ __forceinline__ void na_item2(const Ctx& cx, int l, int item) {
    const ArgView a = cx.av;
    const int tid = cx.tid, lane = cx.lane, w = cx.wave, fq = lane >> 4, fr = lane & 15;
    const bf16_t* P = (const bf16_t*)(a.ws_() + WS_P); bf16_t* OB = (bf16_t*)(a.ws_() + WS_A) + SGUW;
    const f32x2* rope = (const f32x2*)(a.ws_() + WS_ROPE);
    const bool isctx = item >= 512;
    int b, h, rq = 0;
    if (!isctx) { b = item >> 8; h = (item >> 5) & 7; rq = item & 31; } else { const int it = item - 512; b = it >> 3; h = it & 7; }
    LAS unsigned char* Kt = cx.lds; LAS unsigned char* Vt = cx.lds + 16384; LAS float* biasS = (LAS float*)(cx.lds + 131072);
    const unsigned vt_base = (unsigned)(size_t)Vt;
    const int R0 = 4 * rq, cseg = w & 3, qc = 16 * cseg + fr;
    const int r0a = min(max(R0 - 4, 0), GROWS - 8), r0e = min(max(R0 + 3 - 4, 0), GROWS - 8) + 7;
    const int nloc = isctx ? 0 : (r0e - r0a + 1), ntile = nloc + 4;
    int rA[2], r0w[2], qrow[2];
#pragma unroll
    for (int qt = 0; qt < 2; ++qt) { rA[qt] = R0 + 2 * (w >> 2) + qt; r0w[qt] = min(max(rA[qt] - 4, 0), GROWS - 8);
        qrow[qt] = isctx ? (MLAT + b * CTXL + 32 * w + 16 * qt + fr) : (b * SEQ + rA[qt] * GRID_W + qc); }
    const int cs = (cseg == 0) ? 0 : (cseg == 1 ? 8 : (cseg == 2 ? 24 : 32));
    const int cstart = min(max(qc - 8, 0), GRID_W - 16);
    if (!isctx) { const float* rpb = a.in_(12) + ((size_t)l * NH + h) * 15 * 31; for (int i = tid; i < 465; i += NTHR) biasS[i] = rpb[i] * 1.44269504f; }
    bf16x8 q[2][4];
    if (!isctx) {
#pragma unroll
        for (int qt = 0; qt < 2; ++qt) {
            const bf16_t* qsrc = P + (size_t)qrow[qt] * INW + 2048 + 128 * h + 8 * fq;
            u32x4 raw[4];
#pragma unroll
            for (int ks = 0; ks < 4; ++ks) raw[ks] = *(const u32x4*)(qsrc + 32 * ks);
#pragma unroll
            for (int ax = 0; ax < 2; ++ax) {
                const int pos = ax ? qc : rA[qt]; const f32x2* tp = rope + pos * 32 + 8 * fq;
                f32x4 x1a, x1b, x2a, x2b; pg8::unpack8(raw[2 * ax], x1a, x1b); pg8::unpack8(raw[2 * ax + 1], x2a, x2b);
                f32x4 o1a, o1b, o2a, o2b;
#pragma unroll
                for (int j = 0; j < 4; ++j) { const f32x2 csA = tp[j], csB = tp[4 + j];
                    o1a[j] = x1a[j] * csA.x - x2a[j] * csA.y; o2a[j] = x2a[j] * csA.x + x1a[j] * csA.y;
                    o1b[j] = x1b[j] * csB.x - x2b[j] * csB.y; o2b[j] = x2b[j] * csB.x + x1b[j] * csB.y; }
                const u32x4 p1 = pg8::pack8(o1a, o1b), p2 = pg8::pack8(o2a, o2b);
                q[qt][2 * ax] = __builtin_bit_cast(bf16x8, p1); q[qt][2 * ax + 1] = __builtin_bit_cast(bf16x8, p2);
            }
        }
    }
    auto stage = [&](int ti) {
        const bool loc = ti < nloc; const int buf = ti & 3;
        const size_t row0 = loc ? (size_t)(b * SEQ + (r0a + ti) * GRID_W) : (size_t)(MLAT + b * CTXL + 64 * (ti - nloc));
        unsigned ln = cx.lane; asm volatile("" : "+v"(ln));
#pragma unroll
        for (int i = 0; i < 2; ++i) {
            const unsigned o = 1024u * (2 * w + i) + 16u * ln, srow = 8u * (o >> 11) + ((o >> 6) & 7u), sch = 4u * ((o >> 9) & 3u) + (((o >> 4) & 3u) ^ ((srow >> 2) & 3u));
            const bf16_t* src = P + (row0 + srow) * INW + 3072 + 128 * h + 8 * sch;
            __builtin_amdgcn_global_load_lds((const unsigned*)src, (LAS unsigned*)(Kt + buf * 32768 + 1024 * (2 * w + i)), 16, 0, 0);
            __builtin_amdgcn_global_load_lds((const unsigned*)(src + 1024), (LAS unsigned*)(Vt + buf * 32768 + 1024 * (2 * w + i)), 16, 0, 0);
        }
    };
    float mrun[2] = {-1e30f, -1e30f}, lrun[2] = {0.f, 0.f};
    f32x4 oacc[2][8];
#pragma unroll
    for (int qt = 0; qt < 2; ++qt)
#pragma unroll
        for (int dt = 0; dt < 8; ++dt) oacc[qt][dt] = (f32x4){0.f, 0.f, 0.f, 0.f};
    const float sc_l2 = 0.08838834764831845f * 1.44269504f;

#define NA_SOFTMAX(QT, NT, SARR, PF) do { \
        float lm_ = -INFINITY; \
        _Pragma("unroll") for (int t_ = 0; t_ < NT; ++t_) _Pragma("unroll") for (int j_ = 0; j_ < 4; ++j_) lm_ = fmaxf(lm_, SARR[t_][j_]); \
        if (__any(lm_ > mrun[QT] + 8.0f)) { \
            float tm_ = fmaxf(lm_, __shfl_xor(lm_, 16)); tm_ = fmaxf(tm_, __shfl_xor(tm_, 32)); \
            const float mn_ = fmaxf(mrun[QT], tm_), al_ = __builtin_amdgcn_exp2f(mrun[QT] - mn_); mrun[QT] = mn_; lrun[QT] *= al_; \
            _Pragma("unroll") for (int dt_ = 0; dt_ < 8; ++dt_) oacc[QT][dt_] *= al_; } \
        float ps_ = 0.f; \
        _Pragma("unroll") for (int kb_ = 0; kb_ < NT / 2; ++kb_) { f32x4 p0_, p1_; \
            _Pragma("unroll") for (int j_ = 0; j_ < 4; ++j_) { p0_[j_] = __builtin_amdgcn_exp2f(SARR[2 * kb_][j_] - mrun[QT]); p1_[j_] = __builtin_amdgcn_exp2f(SARR[2 * kb_ + 1][j_] - mrun[QT]); ps_ += p0_[j_] + p1_[j_]; } \
            const u32x4 pk_ = pg8::pack8(p0_, p1_); PF[kb_] = __builtin_bit_cast(bf16x8, pk_); } \
        lrun[QT] += ps_; } while (0)

    stage(0); stage(1); stage(2);
#define NA_TILE_HEAD() \
        const int buf = ti & 3; \
        { const int rem = ntile - 1 - ti; \
          if (rem >= 2) asm volatile("s_waitcnt vmcnt(8) lgkmcnt(0)" ::: "memory"); else if (rem == 1) asm volatile("s_waitcnt vmcnt(4) lgkmcnt(0)" ::: "memory"); else asm volatile("s_waitcnt vmcnt(0) lgkmcnt(0)" ::: "memory"); } \
        __builtin_amdgcn_s_barrier(); asm volatile("" ::: "memory"); \
        if (ti + 3 < ntile) stage(ti + 3);
    for (int ti = 0; ti < nloc; ++ti) {
        NA_TILE_HEAD()
        unsigned lane_o = cx.lane; asm volatile("" : "+v"(lane_o));
        const unsigned fq_o = lane_o >> 4, fr_o = lane_o & 15u, krow_sel = 8u * (fr_o >> 2) + (fr_o & 3u), q_o = fr_o >> 2, p_o = lane_o & 3u;
        const LAS unsigned char* Kb = Kt + buf * 32768;
        const int kr = r0a + ti;
        auto block32 = [&](const unsigned keybase, const bool masked, const bool act0, const bool act1) {
            f32x4 s[2][2];
#pragma unroll
            for (int qt = 0; qt < 2; ++qt)
#pragma unroll
                for (int t = 0; t < 2; ++t) s[qt][t] = (f32x4){0.f, 0.f, 0.f, 0.f};
#pragma unroll
            for (int t = 0; t < 2; ++t) { const LAS unsigned char* kp_ = Kb + offa(keybase + krow_sel + 4 * t, fq_o);
#pragma unroll
                for (int ks = 0; ks < 4; ++ks) { const bf16x8 kf = *(const LAS bf16x8*)(kp_ + 512 * ks);
                    s[0][t] = __builtin_amdgcn_mfma_f32_16x16x32_bf16(kf, q[0][ks], s[0][t], 0, 0, 0);
                    s[1][t] = __builtin_amdgcn_mfma_f32_16x16x32_bf16(kf, q[1][ks], s[1][t], 0, 0, 0); }
                __builtin_amdgcn_sched_barrier(0); }
            bf16x8 pf[2][1];
#pragma unroll
            for (int qt = 0; qt < 2; ++qt) {
                if (masked) {
                    const bool act = qt ? act1 : act0;
                    const LAS float* brow = biasS + (kr - rA[qt] + 7) * 31 + 15 - qc;
#pragma unroll
                    for (int t = 0; t < 2; ++t)
#pragma unroll
                        for (int j = 0; j < 4; ++j) { const int kc = (int)keybase + 8 * (int)fq_o + 4 * t + j; const bool ok = act && (kc >= cstart) && (kc < cstart + 16);
                            const float bv = ok ? brow[kc] : 0.f; s[qt][t][j] = ok ? (s[qt][t][j] * sc_l2 + bv) : -INFINITY; }
                } else {
#pragma unroll
                    for (int t = 0; t < 2; ++t) s[qt][t] *= sc_l2;
                }
                if (qt == 0) NA_SOFTMAX(0, 2, s[0], pf[0]); else NA_SOFTMAX(1, 2, s[1], pf[1]);
            }
            const unsigned vrow0 = keybase + 8u * fq_o + q_o;
#pragma unroll
            for (int par = 0; par < 2; ++par) {
                const unsigned a0 = vt_base + buf * 32768 + offa(vrow0, 2u * par + (p_o >> 1)) + 8u * (p_o & 1u);
                const unsigned a1 = vt_base + buf * 32768 + offa(vrow0 + 4u, 2u * par + (p_o >> 1)) + 8u * (p_o & 1u);
                bf16x8 vf[4]; tr4<0>(a0, a1, vf);
#pragma unroll
                for (int i = 0; i < 4; ++i) { oacc[0][par + 2 * i] = __builtin_amdgcn_mfma_f32_16x16x32_bf16(vf[i], pf[0][0], oacc[0][par + 2 * i], 0, 0, 0);
                                              oacc[1][par + 2 * i] = __builtin_amdgcn_mfma_f32_16x16x32_bf16(vf[i], pf[1][0], oacc[1][par + 2 * i], 0, 0, 0); }
            }
        };
        const bool act0 = (kr >= r0w[0] && kr < r0w[0] + 8), act1 = (kr >= r0w[1] && kr < r0w[1] + 8);
        if (act0 || act1) block32((unsigned)cs, true, act0, act1);
    }
#pragma unroll
    for (int qt = 0; qt < 2; ++qt) { const bf16_t* qsrc = P + (size_t)qrow[qt] * INW + 2048 + 128 * h + 8 * fq;
#pragma unroll
        for (int ks = 0; ks < 4; ++ks) { const u32x4 raw = *(const u32x4*)(qsrc + 32 * ks); q[qt][ks] = __builtin_bit_cast(bf16x8, raw); } }
    for (int ti = nloc; ti < ntile; ++ti) {
        NA_TILE_HEAD()
        unsigned lane_o = cx.lane; asm volatile("" : "+v"(lane_o));
        const unsigned fq_o = lane_o >> 4, fr_o = lane_o & 15u, krow_sel = 8u * (fr_o >> 2) + (fr_o & 3u), q_o = fr_o >> 2, p_o = lane_o & 3u;
        const LAS unsigned char* Kb = Kt + buf * 32768;
        const int kr = r0a + ti;
        auto block32 = [&](const unsigned keybase, const bool masked, const bool act0, const bool act1) {
            f32x4 s[2][2];
#pragma unroll
            for (int qt = 0; qt < 2; ++qt)
#pragma unroll
                for (int t = 0; t < 2; ++t) s[qt][t] = (f32x4){0.f, 0.f, 0.f, 0.f};
#pragma unroll
            for (int t = 0; t < 2; ++t) { const LAS unsigned char* kp_ = Kb + offa(keybase + krow_sel + 4 * t, fq_o);
#pragma unroll
                for (int ks = 0; ks < 4; ++ks) { const bf16x8 kf = *(const LAS bf16x8*)(kp_ + 512 * ks);
                    s[0][t] = __builtin_amdgcn_mfma_f32_16x16x32_bf16(kf, q[0][ks], s[0][t], 0, 0, 0);
                    s[1][t] = __builtin_amdgcn_mfma_f32_16x16x32_bf16(kf, q[1][ks], s[1][t], 0, 0, 0); }
                __builtin_amdgcn_sched_barrier(0); }
            bf16x8 pf[2][1];
#pragma unroll
            for (int qt = 0; qt < 2; ++qt) {
                if (masked) {
                    const bool act = qt ? act1 : act0;
                    const LAS float* brow = biasS + (kr - rA[qt] + 7) * 31 + 15 - qc;
#pragma unroll
                    for (int t = 0; t < 2; ++t)
#pragma unroll
                        for (int j = 0; j < 4; ++j) { const int kc = (int)keybase + 8 * (int)fq_o + 4 * t + j; const bool ok = act && (kc >= cstart) && (kc < cstart + 16);
                            const float bv = ok ? brow[kc] : 0.f; s[qt][t][j] = ok ? (s[qt][t][j] * sc_l2 + bv) : -INFINITY; }
                } else {
#pragma unroll
                    for (int t = 0; t < 2; ++t) s[qt][t] *= sc_l2;
                }
                if (qt == 0) NA_SOFTMAX(0, 2, s[0], pf[0]); else NA_SOFTMAX(1, 2, s[1], pf[1]);
            }
            const unsigned vrow0 = keybase + 8u * fq_o + q_o;
#pragma unroll
            for (int par = 0; par < 2; ++par) {
                const unsigned a0 = vt_base + buf * 32768 + offa(vrow0, 2u * par + (p_o >> 1)) + 8u * (p_o & 1u);
                const unsigned a1 = vt_base + buf * 32768 + offa(vrow0 + 4u, 2u * par + (p_o >> 1)) + 8u * (p_o & 1u);
                bf16x8 vf[4]; tr4<0>(a0, a1, vf);
#pragma unroll
                for (int i = 0; i < 4; ++i) { oacc[0][par + 2 * i] = __builtin_amdgcn_mfma_f32_16x16x32_bf16(vf[i], pf[0][0], oacc[0][par + 2 * i], 0, 0, 0);
                                              oacc[1][par + 2 * i] = __builtin_amdgcn_mfma_f32_16x16x32_bf16(vf[i], pf[1][0], oacc[1][par + 2 * i], 0, 0, 0); }
            }
        };
        block32(0u, false, true, true);
        block32(32u, false, true, true);
    }
#undef NA_TILE_HEAD
#undef NA_SOFTMAX
#pragma unroll
    for (int qt = 0; qt < 2; ++qt) {
        float lt = lrun[qt]; lt += __shfl_xor(lt, 16); lt += __shfl_xor(lt, 32);
        const float inv = 1.0f / lt;
        bf16_t* op = OB + (size_t)qrow[qt] * D + 128 * h + 4 * fq;
#pragma unroll
        for (int dt = 0; dt < 8; ++dt) { const f32x4 o = oacc[qt][dt] * inv; *(u32x2*)(op + 16 * dt) = (u32x2){cvt_pk_bf16(o[0], o[1]), cvt_pk_bf16(o[2], o[3])}; }
    }
}

__device__ __forceinline__ void route_phase(const Ctx& cx, int l, int T, int dummy = 0) {
    const ArgView a = cx.av;
    const int lane = cx.lane, w = cx.wave, tid = cx.tid, fq = lane >> 4, fr = lane & 15;
    const bf16_t* xs = (const bf16_t*)(a.ws_() + WS_XS); bf16_t* hx = (bf16_t*)(a.ws_() + WS_HX); const bf16_t* WR = (const bf16_t*)(a.ws_() + (size_t)l * WSET_BYTES + WS_WR);
    const float* modl = (const float*)(a.ws_() + WS_CTL + CTL_MOD) + (size_t)l * 3 * 12288; const float* nw = a.in_(7) + (size_t)l * D;
    unsigned* cnt = (unsigned*)(a.ws_() + WS_CTL) + CW_CNT + 64 * l + 2048 * (dummy ? 1 : 0);
    int* re = (int*)(a.ws_() + WS_ROUTE + RT_E); float* rw = (float*)(a.ws_() + WS_ROUTE + RT_W); int* rpz = (int*)(a.ws_() + WS_ROUTE + RT_P);
    LAS int* lcnt = (LAS int*)(cx.lds + LDS_LCNT); LAS int* lbase = lcnt + 32;
    LAS float* red = (LAS float*)cx.lds;
    LAS float* lgS = (LAS float*)(cx.lds + 61440);
    if (tid < 32) lcnt[tid] = 0;
    const int bt0 = (int)((long)cx.bid * T / cx.G), bt1 = (int)((long)(cx.bid + 1) * T / cx.G), nb = bt1 - bt0;
    const int t0 = bt0 + w * nb / 8, t1 = bt0 + (w + 1) * nb / 8;
    if (dummy != 3) {
        f32x4 vA[8], vB[8]; int curcls = -1;
        for (int tok = t0; tok < t1; ++tok) {
            const int cls = tok < SEQ ? 0 : (tok < MLAT ? 1 : 2);
            if (cls != curcls) { curcls = cls; const float* mp = modl + cls * 12288;
#pragma unroll
                for (int j = 0; j < 8; ++j) { const int e = ROW_E(j); vA[j] = *(const f32x4*)(nw + e) * (*(const f32x4*)(mp + 4 * D + e) + 1.0f); vB[j] = *(const f32x4*)(mp + 3 * D + e); } }
            f32x4 v[8]; float ss = 0.f;
#pragma unroll
            for (int j = 0; j < 4; ++j) { const u32x4 r = __builtin_nontemporal_load((const u32x4*)(xs + (size_t)tok * D + 8 * (lane + 64 * j))); pg8::unpack8(r, v[2 * j], v[2 * j + 1]); }
#pragma unroll
            for (int j = 0; j < 8; ++j) ss += (v[j][0] * v[j][0] + v[j][1] * v[j][1]) + (v[j][2] * v[j][2] + v[j][3] * v[j][3]);
            const float rstd = 1.0f / sqrtf(wave_sum(ss) * (1.0f / D) + RMS_EPS);
#pragma unroll
            for (int j = 0; j < 4; ++j) *(u32x4*)(hx + (size_t)tok * D + 8 * (lane + 64 * j)) = pg8::pack8(v[2 * j] * rstd * vA[2 * j] + vB[2 * j], v[2 * j + 1] * rstd * vA[2 * j + 1] + vB[2 * j + 1]);
            if (I8SEL(MK_I8E, l)) {
                float hmax = 0.f;
#pragma unroll
                for (int j = 0; j < 8; ++j) { v[j] = v[j] * rstd * vA[j] + vB[j]; hmax = fmaxf(hmax, fmaxf(fmaxf(fabsf(v[j][0]), fabsf(v[j][1])), fmaxf(fabsf(v[j][2]), fabsf(v[j][3])))); }
#pragma unroll
                for (int o = 1; o < 64; o <<= 1) hmax = fmaxf(hmax, __shfl_xor(hmax, o));
                hmax = fmaxf(hmax, 1e-20f); const float inv = 127.0f / hmax;
                unsigned char* h8 = a.ws_() + WS_HX8 + (size_t)tok * D;
#pragma unroll
                for (int j = 0; j < 4; ++j) *(u32x2*)(h8 + 8 * (lane + 64 * j)) = (u32x2){pk4_i8(v[2 * j][0] * inv, v[2 * j][1] * inv, v[2 * j][2] * inv, v[2 * j][3] * inv), pk4_i8(v[2 * j + 1][0] * inv, v[2 * j + 1][1] * inv, v[2 * j + 1][2] * inv, v[2 * j + 1][3] * inv)};
                if (lane == 0) ((float*)(a.ws_() + WS_SX))[tok] = hmax * (1.0f / 127.0f);
            }
        }
    }
    VM_WAIT();
    __syncthreads();
    if (dummy != 2) {
        const int kq = w & 3, th = w >> 2, tile0 = th ? 3 : 0, ntl = th ? 2 : 3;
        const bf16_t* hp[3];
#pragma unroll
        for (int i = 0; i < 3; ++i) { const int tk = min(bt0 + 16 * (tile0 + i) + fr, bt1 - 1); hp[i] = hx + (size_t)tk * D + 512 * kq + 8 * fq; }
        const bf16_t* wp = WR + ((size_t)(16 * kq) * 64 + lane) * 8;
        f32x4 acc[3][3];
#pragma unroll
        for (int i = 0; i < 3; ++i)
#pragma unroll
            for (int mt = 0; mt < 3; ++mt) acc[i][mt] = (f32x4){0.f, 0.f, 0.f, 0.f};
        const int ksrot = cx.bid & 15;
#pragma unroll 4
        for (int ks0 = 0; ks0 < 16; ++ks0) { const int ks = (ks0 + ksrot) & 15;
            bf16x8 af[3], bfv[3];
#pragma unroll
            for (int mt = 0; mt < 3; ++mt) { const u32x4 t_ = *(const u32x4*)(wp + ((size_t)mt * 64 + ks) * 512); af[mt] = __builtin_bit_cast(bf16x8, t_); }
#pragma unroll
            for (int i = 0; i < 3; ++i) if (i < ntl) { const u32x4 t_ = *(const u32x4*)(hp[i] + 32 * ks); bfv[i] = __builtin_bit_cast(bf16x8, t_); }
#pragma unroll
            for (int i = 0; i < 3; ++i) if (i < ntl)
#pragma unroll
                for (int mt = 0; mt < 3; ++mt) acc[i][mt] = __builtin_amdgcn_mfma_f32_16x16x32_bf16(af[mt], bfv[i], acc[i][mt], 0, 0, 0);
        }
#pragma unroll
        for (int i = 0; i < 3; ++i) if (i < ntl)
#pragma unroll
            for (int mt = 0; mt < 3; ++mt) *(LAS f32x4*)(red + (((kq * 5 + tile0 + i) * 3 + mt) * 64 + lane) * 4) = acc[i][mt];
    }
    __syncthreads();
    for (int idx = tid; idx < 80 * 48; idx += NTHR) { const int ts = idx / 48, o = idx % 48, tile = ts >> 4, f_r = ts & 15, mt = o >> 4, r = o & 15, ln = (r >> 2) * 16 + f_r, rg = r & 3;
        float sum = 0.f;
#pragma unroll
        for (int kq = 0; kq < 4; ++kq) sum += red[(((kq * 5 + tile) * 3 + mt) * 64 + ln) * 4 + rg];
        lgS[idx] = sum; }
    __syncthreads();
    int e0 = 0, e1 = 0; float w0 = 0.f, w1 = 0.f; int p0 = 0, p1 = 0;
    if (tid < nb) {
        const float* bre = a.in_(21) + (size_t)l * NEXP; const float* brg = a.in_(19) + (size_t)l * 4;
        const LAS float* lg = lgS + tid * 48;
        float g[4]; int gi = 0; float gm = -INFINITY;
#pragma unroll
        for (int j = 0; j < 4; ++j) { g[j] = lg[32 + j] + brg[j]; if (g[j] > gm) { gm = g[j]; gi = j; } }
        float gs = 0.f;
#pragma unroll
        for (int j = 0; j < 4; ++j) { float ev = __expf(g[j] - gm); asm volatile("" : "+v"(ev)); gs += ev; }
        const float gp = __builtin_amdgcn_rcpf(gs);
        float v0 = -INFINITY, v1 = -INFINITY; int i0 = 0, i1 = 0;
        for (int j = 0; j < 8; ++j) { const float x = lg[8 * gi + j] + bre[8 * gi + j];
            if (x > v0) { v1 = v0; i1 = i0; v0 = x; i0 = j; } else if (x > v1) { v1 = x; i1 = j; } }
        float ex = __expf(v1 - v0); asm volatile("" : "+v"(ex)); const float den = __builtin_amdgcn_rcpf(1.0f + ex);
        e0 = 8 * gi + i0; e1 = 8 * gi + i1; w0 = gp * den; w1 = gp * ex * den;
        p0 = atomicAdd((int*)&lcnt[e0], 1); p1 = atomicAdd((int*)&lcnt[e1], 1);
    }
    __syncthreads();
    if (tid < 32) { const int c = lcnt[tid]; lbase[tid] = c ? (int)__hip_atomic_fetch_add(cnt + tid, (unsigned)c, __ATOMIC_RELAXED, __HIP_MEMORY_SCOPE_AGENT) : 0; }
    __syncthreads();
    if (tid < nb) { const int tok = bt0 + tid;
        re[tok] = e0; re[MALL + tok] = e1; rw[tok] = w0; rw[MALL + tok] = w1; rpz[tok] = lbase[e0] + p0; rpz[MALL + tok] = lbase[e1] + p1; }
    __syncthreads();
}

__device__ __forceinline__ void load_tprefix(const Ctx& cx, int l) {
    const unsigned* cnt = (const unsigned*)(cx.av.ws_() + WS_CTL) + CW_CNT + 64 * l;
    LAS int* tp = (LAS int*)(cx.lds + LDS_TP);
    if (cx.tid < 64) {
        const int c = cx.tid < 32 ? ((int)__hip_atomic_load(cnt + (cx.tid & 31), __ATOMIC_RELAXED, __HIP_MEMORY_SCOPE_AGENT) + 255) >> 8 : 0;
        int v = c;
#pragma unroll
        for (int o = 1; o < 32; o <<= 1) { const int t = __shfl_up(v, o); if ((int)cx.lane >= o) v += t; }
        if (cx.tid < 32) tp[cx.tid] = v - c;
        if (cx.tid == 31) tp[32] = v;
    }
    __syncthreads();
}
__device__ __forceinline__ void dispatch_phase(const Ctx& cx, int l, int T) {
    const ArgView a = cx.av;
    const int lane = cx.lane;
    const unsigned* cnt = (const unsigned*)(a.ws_() + WS_CTL) + CW_CNT + 64 * l;
    const LAS int* tp = (const LAS int*)(cx.lds + LDS_TP);
    const int* re = (const int*)(a.ws_() + WS_ROUTE + RT_E); const float* rw = (const float*)(a.ws_() + WS_ROUTE + RT_W); const int* rpz = (const int*)(a.ws_() + WS_ROUTE + RT_P);
    int* tokslot = (int*)(a.ws_() + WS_ROUTE + RT_TS); float* wslot = (float*)(a.ws_() + WS_ROUTE + RT_WS);
    const int gw = cx.bid * NWAVES + cx.wave, NGW = cx.G * NWAVES;
    const int t0 = (int)((long)gw * T / NGW), t1 = (int)((long)(gw + 1) * T / NGW);
    for (int tok = t0 + lane; tok < t1; tok += 64) {
        const int ea = re[tok], eb = re[MALL + tok];
        const int sa = 256 * tp[ea] + rpz[tok], sb = 256 * tp[eb] + rpz[MALL + tok];
        tokslot[sa] = 2 * tok; tokslot[sb] = 2 * tok + 1; wslot[sa] = rw[tok]; wslot[sb] = rw[MALL + tok];
    }
    {
        const int e = gw & 31, sub = gw >> 5, nsub = NGW >> 5;
        const int c = (int)__hip_atomic_load(cnt + e, __ATOMIC_RELAXED, __HIP_MEMORY_SCOPE_AGENT), base = 256 * tp[e], padn = (256 - (c & 255)) & 255;
        for (int j = sub + nsub * lane; j < padn; j += 64 * nsub) { const int s = base + c + j; tokslot[s] = -1; wslot[s] = 0.f; }
    }
}
__device__ __forceinline__ void copy_x_phase(const Ctx& cx, int l, int T) {
    const ArgView a = cx.av; if (l != 0) return;
    bf16_t* xs = (bf16_t*)(a.ws_() + WS_XS);
    for (size_t i = (size_t)cx.bid * NTHR + cx.tid; i < (size_t)T * D / 4; i += (size_t)cx.G * NTHR) {
        const size_t e = i * 4; const float* src = e < (size_t)MLAT * D ? a.in_(0) + e : a.in_(2) + (e - (size_t)MLAT * D);
        const f32x4 v = *(const f32x4*)src; *(u32x2*)(xs + e) = (u32x2){cvt_pk_bf16(v[0], v[1]), cvt_pk_bf16(v[2], v[3])}; }
}

__global__ void __launch_bounds__(NTHR, 2) fwd_kernel(Args args) {
    extern __shared__ __attribute__((aligned(16))) unsigned char lds_raw[];
    Ctx cx; cx.lds = (LAS unsigned char*)lds_raw; cx.tid = threadIdx.x; cx.lane = cx.tid & 63; cx.wave = __builtin_amdgcn_readfirstlane(cx.tid >> 6); cx.G = gridDim.x; cx.bid = blockIdx.x;
    cx.av.kp = (const CAS unsigned char*)__builtin_amdgcn_kernarg_segment_ptr();
#define FRESH() do { int t_ = threadIdx.x; asm volatile("" : "+v"(t_)); cx.tid = t_; cx.lane = t_ & 63; cx.wave = __builtin_amdgcn_readfirstlane(t_ >> 6); \
        const CAS unsigned char* k_ = (const CAS unsigned char*)__builtin_amdgcn_kernarg_segment_ptr(); asm volatile("" : "+s"(k_)); cx.av.kp = k_; \
        int g_ = gridDim.x; asm volatile("" : "+s"(g_)); cx.G = g_; int b_ = blockIdx.x; asm volatile("" : "+s"(b_)); cx.bid = b_; } while (0)
    for (int u = cx.tid; u < (LDS_BYTES - LDSCTL_OFF) / 4; u += NTHR) ((LAS unsigned*)(cx.lds + LDSCTL_OFF))[u] = 0u;
    __syncthreads();
    XcdBarrier bar; bar.bar = (unsigned*)(args.ws + WS_CTL) + CW_BAR; bar.x = 0; bar.st = nullptr;
    if (!MK_PER_PHASE) bar = xcd_barrier_post((unsigned*)(args.ws + WS_CTL) + CW_BAR, (volatile LAS unsigned*)(cx.lds + LDS_MISC));
    const int lo = args.ph_lo, hi = args.ph_hi;
#define IN(k) (lo <= (k) && (k) < hi)
#define SEAM(k) do { if (IN(k) && IN((k) + 1)) xcd_barrier(bar); } while (0)

    if (IN(0)) for (int rep = 0; rep < DUPN(0); ++rep) { FRESH(); if (MK_BUILD & 1) p0_adaln(cx); if (MK_BUILD & 2) pw_convert0(cx); __syncthreads(); }
    SEAM(0);
    for (int l = 0; l < 2; ++l) {
        const int pb = 1 + 9 * l;
        const bool mix_on = (MK_MASK >> (2 * l)) & 1, moe_on = (MK_MASK >> (2 * l + 1)) & 1;
        const int Mact = l == 0 ? MALL : MLAT;
        if (IN(pb + 0)) { FRESH(); if (MK_BUILD & 4) { if (l == 0) { for (int rep = 0; rep < DUPN(1); ++rep) norm_phase<0>(cx, MALL); if ((MK_I8GATE != 0) && ((MK_BUILD & 2) != 0)) { __syncthreads(); conv_gate0(cx); } } else { norm_phase<1>(cx, MALL); __syncthreads(); if ((MK_BUILD & 2) && CQ_F0 < CV_EXP + CV_DENSE) conv_range(cx, CQ_F0, CV_EXP + CV_DENSE, cx.bid, cx.G); } } }
        SEAM(pb + 0);
        if ((MK_BUILD & 0x38) && IN(pb + 1) && mix_on) { FRESH();
            unsigned char* ws = cx.av.ws_();
            unsigned* pdone = (unsigned*)(ws + WS_CTL) + CW_PD8 + 128 * l; unsigned* qhead = (unsigned*)(ws + WS_CTL) + CW_QB + 64 * l;
            const int Gg = gemm_wgs((MALL / 256) * (NCOMB / 256), cx.G);
            if (cx.bid < Gg) {
            if (MK_I8GATE) {
                if (MK_I8IN) { pg8::Gemm g{(const bf16_t*)(ws + WS_HX8), D / 2, (const bf16_t*)(ws + (size_t)l * WSET_BYTES + WS_WC), 0, D / 2}; pg8::StaticOrder S; S.init(MALL, INW, Gg, cx.bid);
                  const float amax_in = __uint_as_float(__hip_atomic_load((const unsigned*)(ws + WS_CTL) + CW_GMAX + 2 + l, __ATOMIC_RELAXED, __HIP_MEMORY_SCOPE_AGENT));
                  pg8::EpiInProj E{(bf16_t*)(ws + WS_P), (bf16_t*)(ws + WS_G), cx.av.in_(14) + (size_t)l * GATEW, (const f32x2*)(ws + WS_ROPE), pdone, (const float*)(ws + WS_SX), amax_in * (1.0f / 127.0f)};
                  pg8::gemm_phase<pg8::EpiInProj, pg8::StaticOrder, false, true>(cx.lds, g, S, E); }
                else { pg8::Gemm g{(const bf16_t*)(ws + WS_HX), D, (const bf16_t*)(ws + (size_t)l * WSET_BYTES + WS_WC), 0, D}; pg8::StaticOrder S; S.init(MALL, INW, Gg, cx.bid);
                  pg8::EpiInProj E{(bf16_t*)(ws + WS_P), (bf16_t*)(ws + WS_G), cx.av.in_(14) + (size_t)l * GATEW, (const f32x2*)(ws + WS_ROPE), pdone, nullptr, 0.f};
                  pg8::gemm_phase(cx.lds, g, S, E); }
                { FRESH(); unsigned char* ws2 = cx.av.ws_();
                  pg8::Gemm g{(const bf16_t*)(ws2 + WS_HX8), D / 2, (const bf16_t*)(ws2 + (size_t)l * WSET_BYTES + WS_WC + (size_t)INW * D * 2), 0, D / 2}; pg8::StaticOrder S; S.init(MALL, GATEW, Gg, cx.bid);
                  const float amax = __uint_as_float(__hip_atomic_load((const unsigned*)(ws2 + WS_CTL) + CW_GMAX + l, __ATOMIC_RELAXED, __HIP_MEMORY_SCOPE_AGENT));
                  pg8::EpiGate8 E{(bf16_t*)(ws2 + WS_G), cx.av.in_(14) + (size_t)l * GATEW, (const float*)(ws2 + WS_SX), amax * (1.0f / 127.0f)};
                  pg8::gemm_phase<pg8::EpiGate8, pg8::StaticOrder, false, true>(cx.lds, g, S, E); }
            } else {
            pg8::Gemm g{(const bf16_t*)(ws + WS_HX), D, (const bf16_t*)(ws + (size_t)l * WSET_BYTES + WS_WC), 0, D}; pg8::SplitOrder S; S.init(MALL, INW, GATEW, Gg, cx.bid);
            pg8::EpiInProj E{(bf16_t*)(ws + WS_P), (bf16_t*)(ws + WS_G), cx.av.in_(14) + (size_t)l * GATEW, (const f32x2*)(ws + WS_ROPE), pdone, nullptr, 0.f};
            pg8::gemm_phase(cx.lds, g, S, E); } }
            if (MK_BUILD & 2) { FRESH(); if (l == 0) conv_side(cx, Gg, 0, CQ_A0); else conv_side(cx, Gg, CQ_F0 > CV_EXP + CV_DENSE ? CQ_F0 : CV_EXP + CV_DENSE, CQ_A1); __syncthreads(); }
            FRESH();
            if (cx.wave == 0) {
                const unsigned need = (unsigned)((MALL / 256) * (INW / 256)); unsigned sp = 0;
                for (;;) { const unsigned v_ = cx.lane < NWAVES ? __hip_atomic_load(pdone + 16 * (cx.lane & 7), __ATOMIC_RELAXED, __HIP_MEMORY_SCOPE_AGENT) : need;
                    if (__builtin_amdgcn_ballot_w64(v_ < need) == 0ull) break; __builtin_amdgcn_s_sleep(2); if (++sp > XB_SPIN_CAP) break; }
                __builtin_amdgcn_fence(__ATOMIC_ACQUIRE, "agent");
                asm volatile("s_waitcnt vmcnt(0)" ::: "memory");
            }
            __syncthreads();
            const int n_na = 512, n_sgu = 256, n_cna = (l == 0 ? 16 : 0), n_csg = (l == 0 ? 32 : 0), n_items = n_na + n_sgu + n_cna + n_csg;
            LAS int* qslot = (LAS int*)(cx.lds + LDS_MISC + 64);
            for (;;) {
                if (cx.tid == 0) qslot[0] = (int)__hip_atomic_fetch_add(qhead, 1u, __ATOMIC_RELAXED, __HIP_MEMORY_SCOPE_AGENT);
                __syncthreads();
                const int it = qslot[0];
                __syncthreads();
                if (it >= n_items) break;
                FRESH();
                const bool is_na = it < n_na || (it >= n_na + n_sgu && it < n_na + n_sgu + n_cna);
                const int id = it < n_na ? it : (it < n_na + n_sgu ? it - n_na : (it < n_na + n_sgu + n_cna ? 512 + (it - n_na - n_sgu) : 256 + (it - n_na - n_sgu - n_cna)));
                if (is_na) na_item2(cx, l, id); else sgu_item(cx, l, id);
                __syncthreads();
            }
        }
        SEAM(pb + 2);
        if ((MK_BUILD & 0x40) && IN(pb + 3) && mix_on) for (int rep = 0; rep < DUPN(4); ++rep) {
            FRESH(); unsigned char* ws = cx.av.ws_();
            const bool i8m = I8SEL(MK_I8M, l);
            if (i8m) {
                const unsigned* ctl = (const unsigned*)(ws + WS_CTL);
                const float swa = __uint_as_float(ctl[CW_GMAX + 6 + 2 * l]) * (1.0f / 127.0f), swb = __uint_as_float(ctl[CW_GMAX + 7 + 2 * l]) * (1.0f / 127.0f);
                quant_rows_ao(cx, (const bf16_t*)(ws + WS_A), ws + WS_HX8, (float*)(ws + WS_SX), (float*)(ws + WS_SX) + MALL, swa, swb, Mact);
                VM_WAIT(); xcd_barrier(bar); FRESH(); ws = cx.av.ws_(); }
            const int Gg = gemm_wgs((Mact / 256) * (D / 256), cx.G);
            if (cx.bid < Gg) {
            pg8::StaticOrder S; S.init(Mact, D, Gg, cx.bid);
            if (i8m) {
                pg8::Gemm g{(const bf16_t*)(ws + WS_HX8), D / 2, (const bf16_t*)(ws + (size_t)l * WSET_BYTES + WS_WA), 0, D / 2};
                pg8::EpiMergeI8 E{(bf16_t*)(ws + WS_T), (const bf16_t*)(ws + WS_G), (const float*)(ws + WS_SX), (const float*)(ws + WS_SX) + MALL};
                pg8::gemm_phase<pg8::EpiMergeI8, pg8::StaticOrder, false, true>(cx.lds, g, S, E);
            } else {
            pg8::Gemm g{(const bf16_t*)(ws + WS_A), D, (const bf16_t*)(ws + (size_t)l * WSET_BYTES + WS_WA), 0, D};
            pg8::EpiMergeF E{(bf16_t*)(ws + WS_T), (const bf16_t*)(ws + WS_G)}; pg8::gemm_phase(cx.lds, g, S, E); } }
            if (l == 0 && (MK_BUILD & 2)) { FRESH(); conv_side(cx, Gg, CQ_A0, CQ_C1B); __syncthreads(); }
        }
        SEAM(pb + 3);
        if (IN(pb + 4)) for (int rep = 0; rep < (l == 0 ? DUPN(5) : 1); ++rep) { FRESH();
            if ((MK_BUILD & 0x80) && mix_on) {
                unsigned char* ws = cx.av.ws_(); bf16_t* XS = (bf16_t*)(ws + WS_XS);
                const int Gg = gemm_wgs((Mact / 256) * (D / 256), cx.G);
                const bool i8o = I8SEL(MK_I8O, l);
                if (i8o) {
                    quant_rows2048(cx, (const bf16_t*)(ws + WS_T), ws + WS_HX8, (float*)(ws + WS_SX), Mact);
                    VM_WAIT(); xcd_barrier(bar); FRESH(); ws = cx.av.ws_(); XS = (bf16_t*)(ws + WS_XS); }
                if (cx.bid < Gg) {
                pg8::StaticOrder S; S.init(Mact, D, Gg, cx.bid);
                const float* modl_ = (const float*)(ws + WS_CTL + CTL_MOD) + (size_t)l * 3 * 12288;
                if (i8o) {
                    pg8::Gemm g{(const bf16_t*)(ws + WS_HX8), D / 2, (const bf16_t*)(ws + (size_t)l * WSET_BYTES + WS_WO), 0, D / 2};
                    const float sw = __uint_as_float(((const unsigned*)(ws + WS_CTL))[CW_GMAX + 4 + l]) * (1.0f / 127.0f); const float* sx = (const float*)(ws + WS_SX);
                    if (l == 0) { pg8::EpiOut<true> E{cx.av.in_(0), cx.av.in_(2), XS, modl_, sx, sw}; pg8::gemm_phase<pg8::EpiOut<true>, pg8::StaticOrder, false, true>(cx.lds, g, S, E); }
                    else { pg8::EpiOut<false> E{nullptr, nullptr, XS, modl_, sx, sw}; pg8::gemm_phase<pg8::EpiOut<false>, pg8::StaticOrder, false, true>(cx.lds, g, S, E); }
                } else {
                pg8::Gemm g{(const bf16_t*)(ws + WS_T), D, (const bf16_t*)(ws + (size_t)l * WSET_BYTES + WS_WO), 0, D};
                if (l == 0) { pg8::EpiOut<true> E{cx.av.in_(0), cx.av.in_(2), XS, modl_, nullptr, 0.f}; pg8::gemm_phase(cx.lds, g, S, E); }
                else { pg8::EpiOut<false> E{nullptr, nullptr, XS, modl_, nullptr, 0.f}; pg8::gemm_phase(cx.lds, g, S, E); } } }
                if (l == 0 && (MK_BUILD & 2)) { FRESH(); conv_side(cx, Gg, CQ_C1B, CQ_C2); __syncthreads(); }
            } else copy_x_phase(cx, l, Mact);
        }
        SEAM(pb + 4);
        if ((MK_BUILD & 0x100) && IN(pb + 5) && moe_on) { if (MK_DUP & 0x400) { FRESH(); route_phase(cx, l, Mact, 1 + ((MK_DUP >> 13) & 3)); __syncthreads(); } FRESH(); route_phase(cx, l, Mact); }
        SEAM(pb + 5);
        if ((MK_BUILD & 0x200) && IN(pb + 6) && moe_on) for (int rep = 0; rep < DUPN(6); ++rep) { FRESH(); load_tprefix(cx, l); dispatch_phase(cx, l, Mact); __syncthreads(); if (l == 1 && (MK_BUILD & 2)) conv_range(cx, CQ_A1, CQ_TOTAL, cx.bid, cx.G); }
        SEAM(pb + 6);
        if ((MK_BUILD & 0x400) && IN(pb + 7) && moe_on) for (int rep = 0; rep < DUPN(7); ++rep) { FRESH();
            load_tprefix(cx, l); unsigned char* ws = cx.av.ws_();
            const int Gg = gemm_wgs(((const LAS int*)(cx.lds + LDS_TP))[32] * (1024 / 256), cx.G);
            if (cx.bid < Gg) {
            pg8::GroupedOrder S; S.init((const LAS int*)(cx.lds + LDS_TP), 1024, Gg, cx.bid);
            if (I8SEL(MK_I8E, l)) {
                pg8::Gemm g{(const bf16_t*)(ws + WS_HX8), D / 2, (const bf16_t*)(ws + (size_t)l * WSET_BYTES + WS_WGU), (size_t)1024 * D / 2, D / 2};
                pg8::EpiGateUp8 E{(bf16_t*)(ws + WS_HID), (const int*)(ws + WS_ROUTE + RT_TS), (const float*)(ws + WS_SX), (const unsigned*)(ws + WS_CTL) + CW_EMAX + 64 * l};
                pg8::gemm_phase<pg8::EpiGateUp8, pg8::GroupedOrder, true, true>(cx.lds, g, S, E, (const int*)(ws + WS_ROUTE + RT_TS));
            } else {
            pg8::Gemm g{(const bf16_t*)(ws + WS_HX)  , D, (const bf16_t*)(ws + (size_t)l * WSET_BYTES + WS_WGU), (size_t)1024 * D, D};
            pg8::EpiGateUp E{(bf16_t*)(ws + WS_HID)};
            pg8::gemm_phase<pg8::EpiGateUp, pg8::GroupedOrder, true>(cx.lds, g, S, E, (const int*)(ws + WS_ROUTE + RT_TS)); } }
            if (l == 0 && (MK_BUILD & 2)) { FRESH(); conv_side(cx, Gg, CQ_C2, CQ_E0); __syncthreads(); }
        }
        SEAM(pb + 7);
        if ((MK_BUILD & 0x800) && IN(pb + 8) && moe_on) for (int rep = 0; rep < DUPN(8); ++rep) { FRESH();
            load_tprefix(cx, l); unsigned char* ws = cx.av.ws_();
            const bool i8d = I8SEL(MK_I8D, l);
            if (i8d) {
                quant_rows512(cx, (const bf16_t*)(ws + WS_HID), ws + WS_T, (float*)(ws + WS_T + ((size_t)32 << 20)), (const float*)(ws + WS_ROUTE + RT_WS), ((const LAS int*)(cx.lds + LDS_TP))[32] * 256);
                VM_WAIT(); xcd_barrier(bar); FRESH(); ws = cx.av.ws_(); }
            const int Gg = gemm_wgs(((const LAS int*)(cx.lds + LDS_TP))[32] * (D / 256), cx.G);
            if (cx.bid < Gg) {
            pg8::GroupedOrder S; S.init((const LAS int*)(cx.lds + LDS_TP), D, Gg, cx.bid);
            if (i8d) {
                int kk = DEXP / 2; asm volatile("" : "+s"(kk));
                pg8::Gemm g{(const bf16_t*)(ws + WS_T), kk, (const bf16_t*)(ws + (size_t)l * WSET_BYTES + WS_WD), (size_t)D * DEXP / 2, kk};
                pg8::EpiDown<true> E{(bf16_t*)(ws + WS_G)  , (const int*)(ws + WS_ROUTE + RT_TS), (const float*)(ws + WS_T + ((size_t)32 << 20)), (const unsigned*)(ws + WS_CTL) + CW_DMAX + 32 * l};
                pg8::gemm_phase<pg8::EpiDown<true>, pg8::GroupedOrder, false, true>(cx.lds, g, S, E);
            } else {
            pg8::Gemm g{(const bf16_t*)(ws + WS_HID), DEXP, (const bf16_t*)(ws + (size_t)l * WSET_BYTES + WS_WD), (size_t)D * DEXP, DEXP};
            pg8::EpiDown<false> E{(bf16_t*)(ws + WS_G)  , (const int*)(ws + WS_ROUTE + RT_TS), (const float*)(ws + WS_ROUTE + RT_WS), nullptr};
            pg8::gemm_phase(cx.lds, g, S, E); } }
            if (l == 0 && (MK_BUILD & 2)) { FRESH(); conv_side(cx, Gg, CQ_E0, CQ_F0); __syncthreads(); }
        }
        SEAM(pb + 8);
    }
    if ((MK_BUILD & 0x1000) && IN(19)) for (int rep = 0; rep < DUPN(9); ++rep) { FRESH(); norm_phase<2>(cx, MLAT); }
#undef IN
#undef SEAM
#undef FRESH
}

extern "C" void kernel_launch(void* const* d_in, const int* in_sizes, int n_in, void* d_out, int out_size, void* d_ws, size_t ws_size, hipStream_t stream) {
    static int grid = 0;
    if (grid == 0) {
        if (n_in != 26 || out_size != MLAT * D || ws_size < WS_END) { fprintf(stderr, "kernel_launch: unexpected problem (n_in %d, out %d, ws %zu < %zu)\n", n_in, out_size, ws_size, (size_t)WS_END); grid = -1; return; }
        int dev = 0, cus = 0, per_cu = 0;
        if (hipGetDevice(&dev) != hipSuccess || hipDeviceGetAttribute(&cus, hipDeviceAttributeMultiprocessorCount, dev) != hipSuccess) { grid = -1; return; }
        if (hipFuncSetAttribute((const void*)fwd_kernel, hipFuncAttributeMaxDynamicSharedMemorySize, LDS_BYTES) != hipSuccess) { fprintf(stderr, "kernel_launch: hipFuncSetAttribute failed\n"); grid = -1; return; }
        if (hipOccupancyMaxActiveBlocksPerMultiprocessor(&per_cu, (const void*)fwd_kernel, NTHR, LDS_BYTES) != hipSuccess || per_cu < 1) { fprintf(stderr, "kernel_launch: occupancy query says %d\n", per_cu); }
        (void)hipGetLastError();
        grid = cus;
    }
    if (grid < 0) return;
    (void)hipMemsetAsync((char*)d_ws + WS_CTL, 0, 65536, stream);
    Args a{};
    for (int i = 0; i < 26; ++i) a.in[i] = (const float*)d_in[i];
    a.out = (float*)d_out; a.ws = (unsigned char*)d_ws;
#if MK_PER_PHASE
    for (int p = 0; p < NPHASE; ++p) { a.ph_lo = p; a.ph_hi = p + 1; hipLaunchKernelGGL(fwd_kernel, dim3(grid), dim3(NTHR), LDS_BYTES, stream, a); }
#else
    a.ph_lo = 0; a.ph_hi = NPHASE; hipLaunchKernelGGL(fwd_kernel, dim3(grid), dim3(NTHR), LDS_BYTES, stream, a);
#endif
}
```

```cpp
#include <hip/hip_runtime.h>
#include <cstdio>
#include <cstdint>

#ifndef MK_PER_PHASE
#define MK_PER_PHASE 0
#endif
#ifndef MK_I8GATE
#define MK_I8GATE 1
#endif
#ifndef MK_I8IN
#define MK_I8E 3
#define MK_I8O 3
#define I8SEL(mask, l) ((mask) == 3 ? true : ((mask) == 0 ? false : ((((mask) >> (l)) & 1) != 0)))
#define MK_I8M 3
#define MK_I8D 3
#define MK_I8IN 1
#endif
#ifndef MK_DUP
#define MK_DUP 0
#endif
#define DUPN(k) (1 + ((MK_DUP >> (k)) & 1))
#ifndef MK_BUILD
#define MK_BUILD 0xFFFF
#endif
#ifndef MK_MASK
#define MK_MASK 15
#endif

#define LAS __attribute__((address_space(3)))
typedef unsigned short bf16_t;
typedef short bf16x8 __attribute__((ext_vector_type(8)));
typedef short s16x4 __attribute__((ext_vector_type(4)));
typedef float f32x4 __attribute__((ext_vector_type(4)));
typedef float f32x2 __attribute__((ext_vector_type(2)));
typedef unsigned u32x4 __attribute__((ext_vector_type(4)));
typedef unsigned u32x2 __attribute__((ext_vector_type(2)));

constexpr int D = 2048, SEQ = 8192, GRID_W = 64, GROWS = 128, CTXL = 256;
constexpr int MLAT = 16384, MCTX = 512, MALL = 16896;
constexpr int SGUW = 1024, NH = 8, HDIM = 128, INW = 5120, GATEW = 4096, NCOMB = 9216;
constexpr int NEXP = 32, DEXP = 512, SLOTS = 41984;
constexpr float RMS_EPS = 1e-6f;
constexpr int NWAVES = 8, NTHR = 512;
#ifndef CQ_SET
#define CQ_SET 0
#endif
#if CQ_SET == 0
constexpr int CQ_A0 = 7500, CQ_C1A = 0, CQ_C1B = 22500, CQ_C2 = 38500, CQ_E0 = 43500, CQ_F0 = 45500, CQ_A1 = 55808;
#elif CQ_SET == 1
constexpr int CQ_A0 = 7000, CQ_C1A = 10000, CQ_C1B = 13000, CQ_C2 = 24576, CQ_E0 = 30000, CQ_F0 = 32000, CQ_A1 = 42000;
#else
constexpr int CQ_A0 = 13000, CQ_C1A = 19000, CQ_C1B = 25000, CQ_C2 = 39000, CQ_E0 = 49000, CQ_F0 = 53000, CQ_A1 = 55808;
#endif

constexpr size_t MiB = 1u << 20;
constexpr size_t WS_CTL = 0, CTL_BYTES = 1 * MiB;
constexpr size_t WS_WC = 1 * MiB;
constexpr size_t WS_WA = WS_WC + 36 * MiB;
constexpr size_t WS_WB = WS_WA + 4 * MiB;
constexpr size_t WS_WO = WS_WB + 4 * MiB;
constexpr size_t WS_WGU = WS_WO + 8 * MiB;
constexpr size_t WS_WD = WS_WGU + 128 * MiB;
constexpr size_t WS_WR = WS_WD + 64 * MiB;
constexpr size_t WSET_BYTES = 245 * MiB;
constexpr size_t WS_XS = WS_WR + 1 * MiB + WSET_BYTES;
constexpr size_t WS_HX = WS_XS + 132 * MiB;
constexpr size_t WS_P = WS_HX + 66 * MiB;
constexpr size_t WS_G = WS_P + 165 * MiB;
constexpr size_t WS_A = WS_G + 132 * MiB;
constexpr size_t WS_O = WS_A + 33 * MiB;
constexpr size_t WS_T = WS_O + 33 * MiB;
constexpr size_t WS_HID = WS_T + 66 * MiB;
constexpr size_t WS_ROUTE = WS_HID + 41 * MiB;
constexpr size_t WS_ROPE = WS_ROUTE + 2 * MiB;
constexpr size_t WS_HX8 = WS_ROPE + 1 * MiB;
constexpr size_t WS_SX = WS_HX8 + 33 * MiB;
constexpr size_t WS_END = WS_SX + 1 * MiB;
constexpr int CW_BAR = 4096;
constexpr int CW_CNT = 8192;
constexpr int CW_PDONE = 12288;
constexpr int CW_EMAX = 12288 + 512;
constexpr float GMAX_MARGIN = 1.1f;
constexpr float EMAX_MARGIN = 1.2f;
constexpr int CW_DMAX = 12288 + 640;
constexpr int CW_PD8 = 12288 + 1280;
constexpr int CW_GMAX = 12288 + 256;
constexpr int CW_QB = 12288 + 128;
constexpr size_t CTL_MOD = 65536;
constexpr size_t RT_E = 0, RT_W = RT_E + 2 * MALL * 4, RT_P = RT_W + 2 * MALL * 4, RT_TS = RT_P + 2 * MALL * 4, RT_WS = RT_TS + SLOTS * 4;
static_assert(RT_WS + SLOTS * 4 <= 2 * MiB, "route map");

constexpr int RING_BYTES = 131072;
constexpr int LDSCTL_OFF = 139264;
constexpr int LDS_TP = LDSCTL_OFF + 0;
constexpr int LDS_MISC = LDSCTL_OFF + 256;
constexpr int LDS_LCNT = LDSCTL_OFF + 512;
constexpr int LDS_BYTES = 147456;

#define LDS_WAIT() asm volatile("s_waitcnt lgkmcnt(0)" ::: "memory")
#define VM_WAIT() asm volatile("s_waitcnt vmcnt(0)" ::: "memory")
__device__ __forceinline__ unsigned cvt_pk_bf16(float lo, float hi) { unsigned r; asm volatile("v_cvt_pk_bf16_f32 %0, %1, %2" : "=v"(r) : "v"(lo), "v"(hi)); return r; }
__device__ __forceinline__ float bflo(unsigned w) { return __uint_as_float(w << 16); }
__device__ __forceinline__ float bfhi(unsigned w) { return __uint_as_float(w & 0xffff0000u); }
__device__ __forceinline__ float wave_sum(float v) {
#pragma unroll
    for (int o = 1; o < 64; o <<= 1) v += __shfl_xor(v, o);
    return v;
}
__device__ __forceinline__ float fast_sigmoid(float x) { return __builtin_amdgcn_rcpf(1.0f + __builtin_amdgcn_exp2f(-1.44269504f * x)); }
__device__ __forceinline__ float gelu_tanh(float x) { const float u = 0.7978845608f * (x + 0.044715f * x * x * x); return x * fast_sigmoid(2.0f * u); }
__device__ __forceinline__ float silu_f(float x) { return x * fast_sigmoid(x); }
__device__ __forceinline__ unsigned offb(unsigned row, unsigned ch) { return 256u * row + 16u * (ch ^ (((row & 3u) << 2) | ((row >> 2) & 3u))); }
__device__ __forceinline__ bf16x8 tr_frag(unsigned tile_base, unsigned rowbase, unsigned c, unsigned lane) {
    const unsigned g = lane >> 4, q = (lane & 15u) >> 2, p = lane & 3u;
    const unsigned a0 = tile_base + offb(rowbase + 8u * g + q, 2u * c + (p >> 1)) + 8u * (p & 1u);
    const unsigned a1 = tile_base + offb(rowbase + 8u * g + 4u + q, 2u * c + (p >> 1)) + 8u * (p & 1u);
    s16x4 r0, r1;
    asm volatile("ds_read_b64_tr_b16 %0, %2\n\tds_read_b64_tr_b16 %1, %3\n\ts_waitcnt lgkmcnt(0)" : "=&v"(r0), "=&v"(r1) : "v"(a0), "v"(a1) : "memory");
    bf16x8 f; f[0] = r0[0]; f[1] = r0[1]; f[2] = r0[2]; f[3] = r0[3]; f[4] = r1[0]; f[5] = r1[1]; f[6] = r1[2]; f[7] = r1[3];
    return f;
}

#define XB_TMO      128
#define XB_XCNT(j)  (256  + 64 * (j))
#define XB_XSUB(j)  (1280 + 64 * (j))
#define XB_XGEN(j)  (2304 + 64 * (j))
#define XB_TOP      3328
#define XB_TOPGEN   3392
#define XCD_BAR_WORDS 3456
#define XB_SPIN_CAP (1u << 24)

__device__ __forceinline__ unsigned xb_ld(unsigned* p)              { return __hip_atomic_load(p, __ATOMIC_RELAXED, __HIP_MEMORY_SCOPE_AGENT); }
__device__ __forceinline__ unsigned xb_add(unsigned* p, unsigned v) { return __hip_atomic_fetch_add(p, v, __ATOMIC_RELAXED, __HIP_MEMORY_SCOPE_AGENT); }
__device__ __forceinline__ unsigned xb_xcc_id() { return (unsigned)__builtin_amdgcn_s_getreg((3 << 11) | 20) & 0xFu; }
#define XB_SPIN(cond, bar) do { unsigned _sp = 0; while (cond) { __builtin_amdgcn_s_sleep(1); \
    if ((++_sp & 255u) == 0u) { if (xb_ld(&(bar)[XB_TMO])) break; if (_sp > XB_SPIN_CAP) { atomicAdd(&(bar)[XB_TMO], 1u); break; } } } } while (0)

struct XcdBarrier {
    unsigned* bar; unsigned x;
    volatile LAS unsigned* st;
};

__device__ __forceinline__ XcdBarrier xcd_barrier_post(unsigned* bar, volatile LAS unsigned* st) {
    XcdBarrier b; b.bar = bar; b.x = xb_xcc_id(); b.st = st;
    if (threadIdx.x == 0) (void)xb_add(&bar[XB_XCNT(b.x)], 1u);
    return b;
}
__device__ __forceinline__ void xcd_barrier_complete(unsigned* bar, unsigned x, unsigned& nloc, unsigned& nx) {
    const unsigned G = gridDim.x * gridDim.y * gridDim.z;
    unsigned sum, cnt, mine, sp = 0u;
    for (;;) {
        sum = 0u; cnt = 0u; mine = 0u;
#pragma unroll
        for (unsigned j = 0; j < 16; ++j) { const unsigned c = xb_ld(&bar[XB_XCNT(j)]); sum += c; cnt += (c > 0u) ? 1u : 0u; mine = (j == x) ? c : mine; }
        if (sum == G) break;
        __builtin_amdgcn_s_sleep(1);
        if ((++sp & 255u) == 0u) { if (xb_ld(&bar[XB_TMO])) break; if (sp > XB_SPIN_CAP) { atomicAdd(&bar[XB_TMO], 1u); break; } }
    }
    nloc = mine > 0u ? mine : 1u; nx = cnt > 0u ? cnt : 1u;
}

__device__ __forceinline__ void xcd_barrier(const XcdBarrier& b) {
    asm volatile("s_waitcnt vmcnt(0)" ::: "memory");
    __syncthreads();
    if (threadIdx.x == 0) {
        unsigned* bar = b.bar;
        __builtin_amdgcn_s_waitcnt(0);
        unsigned nloc = b.st[0], nx = b.st[1];
        if (nloc == 0u) { xcd_barrier_complete(bar, b.x, nloc, nx); b.st[0] = nloc; b.st[1] = nx; }
        const unsigned old = xb_add(&bar[XB_XSUB(b.x)], 1u);
        const unsigned gen = old / nloc;
        if (old + 1u == (gen + 1u) * nloc) {
            __builtin_amdgcn_fence(__ATOMIC_RELEASE, "agent");
            asm volatile("s_waitcnt vmcnt(0)" ::: "memory");
            const unsigned og = xb_add(&bar[XB_TOP], 1u);
            const unsigned tg = og / nx;
            if (og + 1u == (tg + 1u) * nx) xb_add(&bar[XB_TOPGEN], 1u);
            else XB_SPIN(xb_ld(&bar[XB_TOPGEN]) == tg, bar);
            __builtin_amdgcn_fence(__ATOMIC_ACQUIRE, "agent");
            xb_add(&bar[XB_XGEN(b.x)], 1u);
            asm volatile("s_waitcnt vmcnt(0)" ::: "memory");
        } else {
            XB_SPIN(xb_ld(&bar[XB_XGEN(b.x)]) == gen, bar);
            __builtin_amdgcn_fence(__ATOMIC_ACQUIRE, "agent");
            asm volatile("s_waitcnt vmcnt(0)" ::: "memory");
        }
    }
    __syncthreads();
}

namespace pg8 {
constexpr int BM = 256, BK = 64, HALF = 128, HTB = HALF * BK * 2, STAGE_BYTES = 8 * HTB, NXCD = 8, WGM = 2;
__host__ __device__ __forceinline__ int lds_byte(int r, int c) { const int st = (r >> 4) * 2 + (c >> 5), rr = r & 15, cc = c & 31, ob = rr * 64 + cc * 2; return st * 1024 + (ob ^ (((ob >> 9) & 1) << 5)); }
__host__ __device__ __forceinline__ void stage_rc(int b, int& R, int& C) { const int st = b / 1024, sb = b % 1024, swz = sb ^ (((sb >> 9) & 1) << 5); R = (st >> 1) * 16 + swz / 64; C = (st & 1) * 32 + (swz % 64) / 2; }
__host__ __device__ __forceinline__ int perm32(int rho) { const int n = rho >> 4, i = rho & 15; return 8 * (i >> 2) + 4 * n + (i & 3); }

struct Unit { int pm, pn, e; };
struct Gemm { const bf16_t* A; int lda; const bf16_t* Bt; size_t bstride; int K; };

__device__ __forceinline__ int xcd_remap(int wgid, int nwg) { const int q = nwg / NXCD, r = nwg % NXCD, xcd = wgid % NXCD, off = wgid / NXCD; return (xcd < r ? xcd * (q + 1) : r * (q + 1) + (xcd - r) * q) + off; }
struct StaticOrder {
    int nM, nN, nwg, G, c;
    __device__ __forceinline__ void init(int M, int N, int G_, int c_) { nM = M / BM; nN = N / BM; nwg = nM * nN; G = G_; c = c_; }
    __device__ __forceinline__ bool next(int i, Unit& u) const {
        const long L = (long)i * G + c; if (L >= nwg) return false;
        const int wgid = xcd_remap((int)L, nwg);
        const int nig = WGM * nN, gid = wgid / nig, fm = gid * WGM, gsz = (nM - fm) < WGM ? (nM - fm) : WGM;
        u.pm = fm + ((wgid % nig) % gsz); u.pn = (wgid % nig) / gsz; u.e = 0; return true;
    }
};
struct SplitOrder {
    int nM, nN1, nN2, nwg1, nwg2, G, c;
    __device__ __forceinline__ void init(int M, int N1, int N2, int G_, int c_) { nM = M / BM; nN1 = N1 / BM; nN2 = N2 / BM; nwg1 = nM * nN1; nwg2 = nM * nN2; G = G_; c = c_; }
    __device__ __forceinline__ void map(int L, int nwg, int nN, Unit& u) const {
        const int wgid = xcd_remap(L, nwg);
        const int nig = WGM * nN, gid = wgid / nig, fm = gid * WGM, gsz = (nM - fm) < WGM ? (nM - fm) : WGM;
        u.pm = fm + ((wgid % nig) % gsz); u.pn = (wgid % nig) / gsz; u.e = 0; }
    __device__ __forceinline__ bool next(int i, Unit& u) const {
        const long L = (long)i * G + c; if (L >= nwg1 + nwg2) return false;
        if (L < nwg1) map((int)L, nwg1, nN1, u); else { map((int)L - nwg1, nwg2, nN2, u); u.pn += nN1; }
        return true;
    }
};
struct GroupedOrder {
    const LAS int* tp; int nN, nwg, G, c;
    __device__ __forceinline__ void init(const LAS int* tp_, int N, int G_, int c_) { tp = tp_; nN = N / BM; nwg = tp_[32] * nN; G = G_; c = c_; }
    __device__ __forceinline__ bool next(int i, Unit& u) const {
        const long L = (long)i * G + c; if (L >= nwg) return false;
        const int wgid = xcd_remap((int)L, nwg);
        const int mt = wgid / nN; u.pm = mt; u.pn = wgid % nN;
        int e = 0;
        for (int j = 1; j < 32; ++j) e += (tp[j] <= mt) ? 1 : 0;
        u.e = e; return true;
    }
};

typedef int i32x4v __attribute__((ext_vector_type(4)));
template <class Epi, class Sched, bool GATHER = false, bool INT8 = false>
__device__ __forceinline__ void gemm_phase(LAS unsigned char* lds, const Gemm g, const Sched& S, const Epi& E, const int* rowmap = nullptr) {
    int tid_ = threadIdx.x; asm volatile("" : "+v"(tid_));
    const int tid = tid_, wid = __builtin_amdgcn_readfirstlane(tid >> 6), lane = tid & 63, wr = wid >> 2, wc = wid & 3, fr = lane & 15, fq = lane >> 4;
    const int K = g.K, nt = K / BK, lda = g.lda;
    unsigned voffA[2], voffB[2];
#pragma unroll
    for (int i = 0; i < 2; ++i) { int R, C; stage_rc(tid * 16 + i * 8192, R, C); const int Rb = Epi::PERM ? ((R & ~31) + perm32(R & 31)) : R;
        voffA[i] = (unsigned)(R * lda + C) * 2u; voffB[i] = (unsigned)(Rb * K + C) * 2u; }
    const size_t kstep = (size_t)(BK * 2);
    const size_t hstepA = GATHER ? (size_t)0 : (size_t)HALF * lda * 2, tstepA = 2 * hstepA;
    unsigned gcur[2][2], gnxt[2][2];
    auto gather_offs = [&](int pm, unsigned (&o)[2][2]) {
#pragma unroll
        for (int h = 0; h < 2; ++h)
#pragma unroll
            for (int i = 0; i < 2; ++i) { int R, C; stage_rc(tid * 16 + i * 8192, R, C); const int ts = rowmap[256 * pm + 128 * h + R]; const int row = ts < 0 ? 0 : (ts >> 1);
                o[h][i] = (unsigned)(row * lda + C) * 2u; }
    };
    const size_t hstepB = (size_t)HALF * K * 2, tstepB = 2 * hstepB;
    const unsigned ldsw = (unsigned)wid * 1024u;
    const int aoff = lds_byte(wr * 64 + fr, fq * 8), boff = lds_byte(wc * 32 + fr, fq * 8);
#define PG8_SA(b, h) (((b) * 2 + (h)) * HTB)
#define PG8_SB(b, h) ((4 + (b) * 2 + (h)) * HTB)
#define PG8_STAGE(bufoff, gbase, voff) do { _Pragma("unroll") for (int _i = 0; _i < 2; ++_i) \
        __builtin_amdgcn_global_load_lds((const unsigned*)((const char*)(gbase) + (voff)[_i]), (LAS unsigned*)(lds + (bufoff) + ldsw + _i * 8192), 16, 0, 0); } while (0)
#define PG8_LDA(dst, b, h) do { _Pragma("unroll") for (int m = 0; m < 4; ++m) _Pragma("unroll") for (int k = 0; k < 2; ++k) dst[m][k] = *(const LAS bf16x8*)(lds + PG8_SA(b, h) + aoff + m * 2048 + k * 1024); } while (0)
#define PG8_LDB(dst, b, h) do { _Pragma("unroll") for (int n = 0; n < 2; ++n) _Pragma("unroll") for (int k = 0; k < 2; ++k) dst[n][k] = *(const LAS bf16x8*)(lds + PG8_SB(b, h) + boff + n * 2048 + k * 1024); } while (0)
#define PG8_MMA(ai, bj, At, Bt) do { __builtin_amdgcn_s_setprio(1); _Pragma("unroll") for (int m = 0; m < 4; ++m) _Pragma("unroll") for (int n = 0; n < 2; ++n) _Pragma("unroll") for (int k = 0; k < 2; ++k) { \
        if constexpr (INT8) acc[ai][bj][m][n] = __builtin_bit_cast(f32x4, __builtin_amdgcn_mfma_i32_16x16x64_i8(__builtin_bit_cast(i32x4v, Bt[n][k]), __builtin_bit_cast(i32x4v, At[m][k]), __builtin_bit_cast(i32x4v, acc[ai][bj][m][n]), 0, 0, 0)); \
        else acc[ai][bj][m][n] = __builtin_amdgcn_mfma_f32_16x16x32_bf16(Bt[n][k], At[m][k], acc[ai][bj][m][n], 0, 0, 0); } __builtin_amdgcn_s_setprio(0); } while (0)
#define PG8_WAIT_V(n) asm volatile("s_waitcnt vmcnt(" #n ")" ::: "memory")
#define PG8_WAIT_L(n) asm volatile("s_waitcnt lgkmcnt(" #n ")" ::: "memory")
#define PG8_BAR __builtin_amdgcn_s_barrier()
#define PG8_SCHED __builtin_amdgcn_sched_barrier(0)
    Unit cur, nxt; int ui = 0; bool pend = false;
    if (!S.next(0, cur)) return;
    f32x4 acc[2][2][4][2];
#pragma unroll
    for (int a = 0; a < 2; ++a)
#pragma unroll
        for (int b = 0; b < 2; ++b)
#pragma unroll
            for (int m = 0; m < 4; ++m)
#pragma unroll
                for (int n = 0; n < 2; ++n) acc[a][b][m][n] = (f32x4){0.f, 0.f, 0.f, 0.f};
    bf16x8 At[4][2], B0[2][2], B1[2][2];
    const char* cA = (const char*)g.A + (size_t)cur.pm * tstepA; const char* cB = (const char*)g.Bt + (size_t)cur.e * g.bstride * 2 + (size_t)cur.pn * tstepB;
    if constexpr (GATHER) gather_offs(cur.pm, gcur);
#define PG8_OC(h) (GATHER ? gcur[h] : voffA)
    PG8_STAGE(PG8_SB(0, 0), cB, voffB); PG8_STAGE(PG8_SB(0, 1), cB + hstepB, voffB); PG8_STAGE(PG8_SA(0, 0), cA, PG8_OC(0)); PG8_STAGE(PG8_SA(0, 1), cA + hstepA, PG8_OC(1));
    if (wr == 1) PG8_BAR;
    PG8_WAIT_V(2); PG8_BAR;
    PG8_STAGE(PG8_SB(1, 0), cB + kstep, voffB); PG8_STAGE(PG8_SA(1, 0), cA + kstep, PG8_OC(0)); PG8_STAGE(PG8_SB(1, 1), cB + hstepB + kstep, voffB);
    PG8_WAIT_V(6); PG8_BAR;
    for (;;) {
        const bool has_next = S.next(ui + 1, nxt);
        const char* nA = has_next ? (const char*)g.A + (size_t)nxt.pm * tstepA : cA;
        const char* nB = has_next ? (const char*)g.Bt + (size_t)nxt.e * g.bstride * 2 + (size_t)nxt.pn * tstepB : cB;
        if constexpr (GATHER) { if (has_next) gather_offs(nxt.pm, gnxt); else {
#pragma unroll
            for (int h = 0; h < 2; ++h)
#pragma unroll
                for (int i = 0; i < 2; ++i) gnxt[h][i] = gcur[h][i]; } }
        for (int t = 0; t < nt; t += 2) {
            if constexpr (Epi::MID) { if (t == nt / 2) E.mid(acc, cur, wr, wc, fr, fq); }
            const bool last = (t == nt - 2);
            const char* a1 = cA + (size_t)(t + 1) * kstep;
            const char* a2 = last ? nA : cA + (size_t)(t + 2) * kstep; const char* b2 = last ? nB : cB + (size_t)(t + 2) * kstep;
            const char* a3 = a2 + kstep; const char* b3 = b2 + kstep;
            unsigned osel[2][2];
#pragma unroll
            for (int h = 0; h < 2; ++h)
#pragma unroll
                for (int i = 0; i < 2; ++i) osel[h][i] = GATHER ? (last ? gnxt[h][i] : gcur[h][i]) : voffA[i];
            PG8_LDB(B0, 0, 0); PG8_LDB(B1, 0, 1); PG8_SCHED; PG8_LDA(At, 0, 0); PG8_STAGE(PG8_SA(1, 1), a1 + hstepA, PG8_OC(1));
            PG8_WAIT_V(8); PG8_WAIT_L(0); PG8_BAR; PG8_MMA(0, 0, At, B0); PG8_MMA(0, 1, At, B1); PG8_BAR; PG8_SCHED;
            PG8_LDA(At, 0, 1); PG8_STAGE(PG8_SB(0, 0), b2, voffB); PG8_STAGE(PG8_SB(0, 1), b2 + hstepB, voffB); PG8_STAGE(PG8_SA(0, 0), a2, osel[0]);
            PG8_WAIT_V(8); PG8_WAIT_L(0); PG8_BAR; PG8_MMA(1, 0, At, B0); PG8_MMA(1, 1, At, B1); PG8_BAR; PG8_SCHED;
            PG8_LDB(B0, 1, 0); PG8_LDB(B1, 1, 1); PG8_SCHED; PG8_LDA(At, 1, 0); PG8_STAGE(PG8_SA(0, 1), a2 + hstepA, osel[1]);
            PG8_WAIT_V(8); PG8_WAIT_L(0); PG8_BAR; PG8_MMA(0, 0, At, B0); PG8_MMA(0, 1, At, B1); PG8_BAR; PG8_SCHED;
            PG8_LDA(At, 1, 1); PG8_STAGE(PG8_SB(1, 0), b3, voffB); PG8_STAGE(PG8_SB(1, 1), b3 + hstepB, voffB); PG8_STAGE(PG8_SA(1, 0), a3, osel[0]);
            PG8_WAIT_V(8); PG8_WAIT_L(0); PG8_BAR; PG8_MMA(1, 0, At, B0); PG8_MMA(1, 1, At, B1); PG8_BAR; PG8_SCHED;
        }
        if (wr == 0) PG8_BAR;
        if constexpr (Epi::SIGNAL) { if (pend) E.signal(lane); }
        E(acc, cur, wr, wc, fr, fq);
        if constexpr (Epi::SIGNAL) pend = E.wants(cur);
        if (!has_next) break;
#pragma unroll
        for (int a = 0; a < 2; ++a)
#pragma unroll
            for (int b = 0; b < 2; ++b)
#pragma unroll
                for (int m = 0; m < 4; ++m)
#pragma unroll
                    for (int n = 0; n < 2; ++n) acc[a][b][m][n] = (f32x4){0.f, 0.f, 0.f, 0.f};
        cur = nxt; cA = nA; cB = nB; ++ui;
        if constexpr (GATHER) {
#pragma unroll
            for (int h = 0; h < 2; ++h)
#pragma unroll
                for (int i = 0; i < 2; ++i) gcur[h][i] = gnxt[h][i]; }
        if (wr == 1) PG8_BAR;
    }
    PG8_WAIT_V(0);
    if constexpr (Epi::SIGNAL) { if (pend) E.signal(lane); }
    PG8_BAR;
#undef PG8_OC
#undef PG8_SA
#undef PG8_SB
#undef PG8_STAGE
#undef PG8_LDA
#undef PG8_LDB
#undef PG8_MMA
#undef PG8_WAIT_V
#undef PG8_WAIT_L
#undef PG8_BAR
#undef PG8_SCHED
}

__device__ __forceinline__ u32x4 pack8(const f32x4 v0, const f32x4 v1) { u32x4 w; w.x = cvt_pk_bf16(v0[0], v0[1]); w.y = cvt_pk_bf16(v0[2], v0[3]); w.z = cvt_pk_bf16(v1[0], v1[1]); w.w = cvt_pk_bf16(v1[2], v1[3]); return w; }
__device__ __forceinline__ void unpack8(const u32x4 w, f32x4& v0, f32x4& v1) { v0 = (f32x4){bflo(w.x), bfhi(w.x), bflo(w.y), bfhi(w.y)}; v1 = (f32x4){bflo(w.z), bfhi(w.z), bflo(w.w), bfhi(w.w)}; }

struct EpiInProj {
    static constexpr bool PERM = true, MID = false, SIGNAL = true;
    bf16_t* P; bf16_t* G; const float* bgate; const f32x2* rope; unsigned* pdone; const float* sx; float sw;
    __device__ __forceinline__ void stP(const __amdgpu_buffer_rsrc_t rs, size_t elem, const u32x4 v) const { __builtin_amdgcn_raw_buffer_store_b128(v, rs, (unsigned)(elem * 2), 0, 16); }
    __device__ __forceinline__ bool wants(const Unit& u) const { return u.pn < 20; }
    __device__ __forceinline__ void signal(int lane) const { if (lane == 0) { const int w_ = __builtin_amdgcn_readfirstlane((int)(threadIdx.x >> 6)); __hip_atomic_fetch_add(pdone + 16 * w_, 1u, __ATOMIC_RELAXED, __HIP_MEMORY_SCOPE_AGENT); } }
    __device__ __forceinline__ void operator()(const f32x4 (&acc)[2][2][4][2], const Unit& u, int wr, int wc, int fr, int fq) const {
        const int row0 = u.pm * BM + wr * 64 + fr, colt = u.pn * BM + wc * 32 + 8 * fq;
        const int mode = (u.pn < 8) ? 0 : (u.pn < 12 ? 1 : (u.pn < 16 ? 3 : (u.pn < 20 ? 1 : 2)));
        const __amdgpu_buffer_rsrc_t prs = __builtin_amdgcn_make_buffer_rsrc(P, 0, (unsigned)((size_t)MALL * INW * 2), 0x00020000);
        float scv[2][4];
#pragma unroll
        for (int ai = 0; ai < 2; ++ai)
#pragma unroll
            for (int m = 0; m < 4; ++m) scv[ai][m] = sx ? sx[row0 + ai * HALF + m * 16] * sw : 0.f;
        asm volatile("" ::: "memory");
        if (mode == 3) {
            const int hh = wc >> 1, ax = wc & 1, c1 = u.pn * BM + 128 * hh + 64 * ax + 8 * fq;
#pragma unroll
            for (int ai = 0; ai < 2; ++ai)
#pragma unroll
                for (int m = 0; m < 4; ++m) {
                    const int row = row0 + ai * HALF + m * 16;
                    f32x4 x1a = acc[ai][0][m][0], x1b = acc[ai][0][m][1], x2a = acc[ai][1][m][0], x2b = acc[ai][1][m][1];
                    if (sx) { const float sc = scv[ai][m];
#pragma unroll
                        for (int j = 0; j < 4; ++j) { x1a[j] = (float)__float_as_int(x1a[j]) * sc; x1b[j] = (float)__float_as_int(x1b[j]) * sc; x2a[j] = (float)__float_as_int(x2a[j]) * sc; x2b[j] = (float)__float_as_int(x2b[j]) * sc; } }
                    if (row < MLAT) {
                        const int t = row & (SEQ - 1), pos = ax ? (t & 63) : (t >> 6);
                        const f32x4* tp = (const f32x4*)(rope + pos * 32 + 8 * fq);
                        const f32x4 t0 = tp[0], t1 = tp[1], t2 = tp[2], t3 = tp[3];
                        const f32x4 ca = (f32x4){t0[0], t0[2], t1[0], t1[2]}, sa = (f32x4){t0[1], t0[3], t1[1], t1[3]};
                        const f32x4 cb = (f32x4){t2[0], t2[2], t3[0], t3[2]}, sb = (f32x4){t2[1], t2[3], t3[1], t3[3]};
                        const f32x4 y1a = x1a * ca - x2a * sa, y2a = x2a * ca + x1a * sa, y1b = x1b * cb - x2b * sb, y2b = x2b * cb + x1b * sb;
                        x1a = y1a; x2a = y2a; x1b = y1b; x2b = y2b;
                    }
                    stP(prs, (size_t)row * INW + c1, pack8(x1a, x1b)); stP(prs, (size_t)row * INW + c1 + 32, pack8(x2a, x2b));
                }
            return;
        }
        if (mode == 2) {
            const int cc = 128 * (u.pn - 20) + wc * 32 + 8 * fq;
            f32x4 ba[2], bb[2];
#pragma unroll
            for (int n = 0; n < 2; ++n) { ba[n] = *(const f32x4*)(bgate + cc + 4 * n); bb[n] = *(const f32x4*)(bgate + D + cc + 4 * n); }
#pragma unroll
            for (int ai = 0; ai < 2; ++ai)
#pragma unroll
                for (int m = 0; m < 4; ++m) {
                    const size_t row = (size_t)(row0 + ai * HALF + m * 16);
                    f32x4 rr[2], gb[2];
#pragma unroll
                    for (int n = 0; n < 2; ++n)
#pragma unroll
                        for (int j = 0; j < 4; ++j) { const float ga = fast_sigmoid(acc[ai][0][m][n][j] + ba[n][j]); const float g2 = fmaxf(fast_sigmoid(acc[ai][1][m][n][j] + bb[n][j]), 5.9604645e-8f);
                            gb[n][j] = g2; rr[n][j] = ga * __builtin_amdgcn_rcpf(g2); }
                    *(u32x4*)(G + row * GATEW + cc) = pack8(rr[0], rr[1]); *(u32x4*)(G + row * GATEW + D + cc) = pack8(gb[0], gb[1]);
                }
            return;
        }
        f32x4 bv[2][2];
#pragma unroll
        for (int bj = 0; bj < 2; ++bj)
#pragma unroll
            for (int n = 0; n < 2; ++n) bv[bj][n] = (f32x4){0.f, 0.f, 0.f, 0.f};
#pragma unroll
        for (int ai = 0; ai < 2; ++ai)
#pragma unroll
            for (int m = 0; m < 4; ++m) {
                const size_t row = (size_t)(row0 + ai * HALF + m * 16); const float sc = scv[ai][m];
#pragma unroll
                for (int bj = 0; bj < 2; ++bj) { f32x4 v0 = acc[ai][bj][m][0] + bv[bj][0], v1 = acc[ai][bj][m][1] + bv[bj][1];
                    if (sx) {
#pragma unroll
                        for (int j = 0; j < 4; ++j) { v0[j] = (float)__float_as_int(acc[ai][bj][m][0][j]) * sc; v1[j] = (float)__float_as_int(acc[ai][bj][m][1][j]) * sc; } }
                    if (mode == 0) {
#pragma unroll
                        for (int j = 0; j < 4; ++j) { v0[j] = gelu_tanh(v0[j]); v1[j] = gelu_tanh(v1[j]); } }
                    stP(prs, row * INW + colt + bj * HALF, pack8(v0, v1)); } }
    }
};
struct EpiGate8 {
    static constexpr bool PERM = true, MID = false, SIGNAL = false;
    bf16_t* G; const float* bgate; const float* sx; float sw;
    __device__ __forceinline__ void operator()(const f32x4 (&acc)[2][2][4][2], const Unit& u, int wr, int wc, int fr, int fq) const {
        const int row0 = u.pm * BM + wr * 64 + fr, cc = 128 * u.pn + wc * 32 + 8 * fq;
        f32x4 ba[2], bb[2];
#pragma unroll
        for (int n = 0; n < 2; ++n) { ba[n] = *(const f32x4*)(bgate + cc + 4 * n); bb[n] = *(const f32x4*)(bgate + D + cc + 4 * n); }
        float scv[2][4];
#pragma unroll
        for (int ai = 0; ai < 2; ++ai)
#pragma unroll
            for (int m = 0; m < 4; ++m) scv[ai][m] = sx[row0 + ai * HALF + m * 16] * sw;
        asm volatile("" ::: "memory");
#pragma unroll
        for (int ai = 0; ai < 2; ++ai)
#pragma unroll
            for (int m = 0; m < 4; ++m) {
                const size_t row = (size_t)(row0 + ai * HALF + m * 16); const float sc = scv[ai][m];
                f32x4 rr[2], gb[2];
#pragma unroll
                for (int n = 0; n < 2; ++n)
#pragma unroll
                    for (int j = 0; j < 4; ++j) { const float za = (float)__float_as_int(acc[ai][0][m][n][j]) * sc + ba[n][j], zb = (float)__float_as_int(acc[ai][1][m][n][j]) * sc + bb[n][j];
                        const float ta = 1.0f + __builtin_amdgcn_exp2f(-1.44269504f * za), tb = fminf(1.0f + __builtin_amdgcn_exp2f(-1.44269504f * zb), 16777216.0f);
                        gb[n][j] = __builtin_amdgcn_rcpf(tb); rr[n][j] = tb * __builtin_amdgcn_rcpf(ta); }
                *(u32x4*)(G + row * GATEW + cc) = pack8(rr[0], rr[1]); *(u32x4*)(G + row * GATEW + D + cc) = pack8(gb[0], gb[1]);
            }
    }
};
struct EpiMergeF {
    static constexpr bool PERM = true, MID = true, SIGNAL = false;
    bf16_t* T; const bf16_t* G;
    __device__ __forceinline__ void mid(f32x4 (&acc)[2][2][4][2], const Unit& u, int wr, int wc, int fr_, int fq_) const {
        int fr = fr_, fq = fq_; asm volatile("" : "+v"(fr), "+v"(fq));
        const int row0 = u.pm * BM + wr * 64 + fr, colt = u.pn * BM + wc * 32 + 8 * fq;
#pragma unroll
        for (int ai = 0; ai < 2; ++ai)
#pragma unroll
            for (int mh = 0; mh < 2; ++mh) {
                u32x4 raw[2][2];
#pragma unroll
                for (int mm = 0; mm < 2; ++mm)
#pragma unroll
                    for (int bj = 0; bj < 2; ++bj) raw[mm][bj] = __builtin_nontemporal_load((const u32x4*)(G + (size_t)(row0 + ai * HALF + (2 * mh + mm) * 16) * GATEW + colt + bj * HALF));
#pragma unroll
                for (int mm = 0; mm < 2; ++mm)
#pragma unroll
                    for (int bj = 0; bj < 2; ++bj) { f32x4 r0, r1; unpack8(raw[mm][bj], r0, r1); acc[ai][bj][2 * mh + mm][0] *= r0; acc[ai][bj][2 * mh + mm][1] *= r1; }
                asm volatile("" ::: "memory");
            }
    }
    __device__ __forceinline__ void operator()(const f32x4 (&acc)[2][2][4][2], const Unit& u, int wr, int wc, int fr, int fq) const {
        const int row0 = u.pm * BM + wr * 64 + fr, colt = u.pn * BM + wc * 32 + 8 * fq;
#pragma unroll
        for (int ai = 0; ai < 2; ++ai) {
            u32x4 gb[4][2];
#pragma unroll
            for (int m = 0; m < 4; ++m)
#pragma unroll
                for (int bj = 0; bj < 2; ++bj) gb[m][bj] = __builtin_nontemporal_load((const u32x4*)(G + (size_t)(row0 + ai * HALF + m * 16) * GATEW + D + colt + bj * HALF));
            asm volatile("" ::: "memory");
#pragma unroll
            for (int m = 0; m < 4; ++m) {
                bf16_t* tp = T + (size_t)(row0 + ai * HALF + m * 16) * D + colt;
#pragma unroll
                for (int bj = 0; bj < 2; ++bj) { f32x4 g0, g1; unpack8(gb[m][bj], g0, g1);
                    *(u32x4*)(tp + bj * HALF) = pack8(acc[ai][bj][m][0] * g0, acc[ai][bj][m][1] * g1); } }
            asm volatile("" ::: "memory");
        }
    }
};
struct EpiMergeI8 {
    static constexpr bool PERM = true, MID = true, SIGNAL = false;
    bf16_t* T; const bf16_t* G; const float* cab; const float* sob;
    __device__ __forceinline__ void mid(f32x4 (&acc)[2][2][4][2], const Unit& u, int wr, int wc, int fr_, int fq_) const {
        int fr = fr_, fq = fq_; asm volatile("" : "+v"(fr), "+v"(fq));
        const int row0 = u.pm * BM + wr * 64 + fr, colt = u.pn * BM + wc * 32 + 8 * fq;
#pragma unroll
        for (int ai = 0; ai < 2; ++ai)
#pragma unroll
            for (int mh = 0; mh < 2; ++mh) {
                u32x4 raw[2][2]; float c[2];
#pragma unroll
                for (int mm = 0; mm < 2; ++mm) { c[mm] = cab[row0 + ai * HALF + (2 * mh + mm) * 16];
#pragma unroll
                    for (int bj = 0; bj < 2; ++bj) raw[mm][bj] = __builtin_nontemporal_load((const u32x4*)(G + (size_t)(row0 + ai * HALF + (2 * mh + mm) * 16) * GATEW + colt + bj * HALF)); }
#pragma unroll
                for (int mm = 0; mm < 2; ++mm)
#pragma unroll
                    for (int bj = 0; bj < 2; ++bj) { f32x4 r0, r1; unpack8(raw[mm][bj], r0, r1);
#pragma unroll
                        for (int j = 0; j < 4; ++j) {
                            acc[ai][bj][2 * mh + mm][0][j] = __int_as_float((int)__builtin_amdgcn_fmed3f((float)__float_as_int(acc[ai][bj][2 * mh + mm][0][j]) * c[mm] * r0[j], -1.0e9f, 1.0e9f));
                            acc[ai][bj][2 * mh + mm][1][j] = __int_as_float((int)__builtin_amdgcn_fmed3f((float)__float_as_int(acc[ai][bj][2 * mh + mm][1][j]) * c[mm] * r1[j], -1.0e9f, 1.0e9f)); } }
                asm volatile("" ::: "memory");
            }
    }
    __device__ __forceinline__ void operator()(const f32x4 (&acc)[2][2][4][2], const Unit& u, int wr, int wc, int fr, int fq) const {
        const int row0 = u.pm * BM + wr * 64 + fr, colt = u.pn * BM + wc * 32 + 8 * fq;
#pragma unroll
        for (int ai = 0; ai < 2; ++ai) {
            u32x4 gb[4][2]; float sc[4];
#pragma unroll
            for (int m = 0; m < 4; ++m) { sc[m] = sob[row0 + ai * HALF + m * 16];
#pragma unroll
                for (int bj = 0; bj < 2; ++bj) gb[m][bj] = __builtin_nontemporal_load((const u32x4*)(G + (size_t)(row0 + ai * HALF + m * 16) * GATEW + D + colt + bj * HALF)); }
            asm volatile("" ::: "memory");
#pragma unroll
            for (int m = 0; m < 4; ++m) {
                bf16_t* tp = T + (size_t)(row0 + ai * HALF + m * 16) * D + colt;
#pragma unroll
                for (int bj = 0; bj < 2; ++bj) { f32x4 g0, g1; unpack8(gb[m][bj], g0, g1); f32x4 a0, a1;
#pragma unroll
                    for (int j = 0; j < 4; ++j) { a0[j] = (float)__float_as_int(acc[ai][bj][m][0][j]) * sc[m] * g0[j]; a1[j] = (float)__float_as_int(acc[ai][bj][m][1][j]) * sc[m] * g1[j]; }
                    *(u32x4*)(tp + bj * HALF) = pack8(a0, a1); } }
            asm volatile("" ::: "memory");
        }
    }
};
template <bool FIRST> struct EpiOut {
    static constexpr bool PERM = true, MID = false, SIGNAL = false;
    const float* xlat; const float* xctx; bf16_t* xs; const float* mod;
    const float* sx; float sw;
    __device__ __forceinline__ void operator()(const f32x4 (&acc)[2][2][4][2], const Unit& u, int wr, int wc, int fr, int fq) const {
        const int row0 = u.pm * BM + wr * 64 + fr, colt = u.pn * BM + wc * 32 + 8 * fq;
        const int cls = (u.pm < 32) ? 0 : (u.pm < 64 ? 1 : 2);
        const float* gate = mod + cls * 12288 + 2 * D;
        f32x4 gv[2][2];
#pragma unroll
        for (int bj = 0; bj < 2; ++bj)
#pragma unroll
            for (int n = 0; n < 2; ++n) gv[bj][n] = *(const f32x4*)(gate + colt + bj * HALF + 4 * n);
        constexpr int MB = FIRST ? 2 : 4;
#pragma unroll
        for (int ai = 0; ai < 2; ++ai)
#pragma unroll
        for (int mb = 0; mb < 4; mb += MB) {
            f32x4 xf[MB][2][2]; u32x4 xb[MB][2]; float sc[MB];
#pragma unroll
            for (int mm = 0; mm < MB; ++mm) {
                const int row = row0 + ai * HALF + (mb + mm) * 16;
                if (sx) sc[mm] = sx[row];
#pragma unroll
                for (int bj = 0; bj < 2; ++bj) {
                    if (FIRST) { const float* xr = ((row < MLAT) ? (xlat + (size_t)row * D) : (xctx + (size_t)(row - MLAT) * D)) + colt + bj * HALF; xf[mm][bj][0] = __builtin_nontemporal_load((const f32x4*)xr); xf[mm][bj][1] = __builtin_nontemporal_load((const f32x4*)(xr + 4)); }
                    else xb[mm][bj] = *(const u32x4*)(xs + (size_t)row * D + colt + bj * HALF); } }
            asm volatile("" ::: "memory");
#pragma unroll
            for (int mm = 0; mm < MB; ++mm) {
                const int m = mb + mm, row = row0 + ai * HALF + m * 16;
                bf16_t* op = xs + (size_t)row * D + colt;
#pragma unroll
                for (int bj = 0; bj < 2; ++bj) { f32x4 x0, x1;
                    if (FIRST) { x0 = xf[mm][bj][0]; x1 = xf[mm][bj][1]; } else unpack8(xb[mm][bj], x0, x1);
                    if (sx) { const float s_ = sc[mm] * sw; f32x4 a0, a1;
#pragma unroll
                        for (int j = 0; j < 4; ++j) { a0[j] = (float)__float_as_int(acc[ai][bj][m][0][j]) * s_; a1[j] = (float)__float_as_int(acc[ai][bj][m][1][j]) * s_; }
                        *(u32x4*)(op + bj * HALF) = pack8(x0 + gv[bj][0] * a0, x1 + gv[bj][1] * a1);
                    } else
                    *(u32x4*)(op + bj * HALF) = pack8(x0 + gv[bj][0] * acc[ai][bj][m][0], x1 + gv[bj][1] * acc[ai][bj][m][1]); } }
            asm volatile("" ::: "memory");
        }
    }
};
struct EpiGateUp {
    static constexpr bool PERM = true, MID = false, SIGNAL = false;
    bf16_t* HID;
    __device__ __forceinline__ void operator()(const f32x4 (&acc)[2][2][4][2], const Unit& u, int wr, int wc, int fr, int fq) const {
        const int row0 = u.pm * BM + wr * 64 + fr, col0 = u.pn * 128 + wc * 32 + 8 * fq;
#pragma unroll
        for (int ai = 0; ai < 2; ++ai)
#pragma unroll
            for (int m = 0; m < 4; ++m) {
                const size_t row = (size_t)(row0 + ai * HALF + m * 16);
                f32x4 v0, v1;
#pragma unroll
                for (int j = 0; j < 4; ++j) { v0[j] = silu_f(acc[ai][0][m][0][j]) * acc[ai][1][m][0][j]; v1[j] = silu_f(acc[ai][0][m][1][j]) * acc[ai][1][m][1][j]; }
                *(u32x4*)(HID + row * DEXP + col0) = pack8(v0, v1); }
    }
};
struct EpiGateUp8 {
    static constexpr bool PERM = true, MID = false, SIGNAL = false;
    bf16_t* HID; const int* ts; const float* sx; const unsigned* emax;
    __device__ __forceinline__ void operator()(const f32x4 (&acc)[2][2][4][2], const Unit& u, int wr, int wc, int fr, int fq) const {
        const int row0 = u.pm * BM + wr * 64 + fr, col0 = u.pn * 128 + wc * 32 + 8 * fq;
        const float sg = __uint_as_float(emax[2 * u.e]) * (1.0f / 127.0f), su = __uint_as_float(emax[2 * u.e + 1]) * (1.0f / 127.0f);
        int tv[2][4]; float scv[2][4];
#pragma unroll
        for (int ai = 0; ai < 2; ++ai)
#pragma unroll
            for (int m = 0; m < 4; ++m) tv[ai][m] = ts[row0 + ai * HALF + m * 16];
#pragma unroll
        for (int ai = 0; ai < 2; ++ai)
#pragma unroll
            for (int m = 0; m < 4; ++m) scv[ai][m] = sx[max(tv[ai][m], 0) >> 1];
        asm volatile("" ::: "memory");
#pragma unroll
        for (int ai = 0; ai < 2; ++ai)
#pragma unroll
            for (int m = 0; m < 4; ++m) {
                const size_t row = (size_t)(row0 + ai * HALF + m * 16);
                const float sc = tv[ai][m] >= 0 ? scv[ai][m] : 0.f; const float cg = sc * sg, cu = sc * su;
                f32x4 v0, v1;
#pragma unroll
                for (int j = 0; j < 4; ++j) { v0[j] = silu_f((float)__float_as_int(acc[ai][0][m][0][j]) * cg) * ((float)__float_as_int(acc[ai][1][m][0][j]) * cu);
                                              v1[j] = silu_f((float)__float_as_int(acc[ai][0][m][1][j]) * cg) * ((float)__float_as_int(acc[ai][1][m][1][j]) * cu); }
                *(u32x4*)(HID + row * DEXP + col0) = pack8(v0, v1); }
    }
};
template <bool I8> struct EpiDown {
    static constexpr bool PERM = true, MID = false, SIGNAL = false;
    bf16_t* Y; const int* tokslot; const float* wslot;
    const unsigned* dmax;
    __device__ __forceinline__ void operator()(const f32x4 (&acc)[2][2][4][2], const Unit& u, int wr, int wc, int fr, int fq) const {
        const int row0 = u.pm * BM + wr * 64 + fr, colt = u.pn * BM + wc * 32 + 8 * fq;
        float swd = 1.0f; if (I8) swd = __uint_as_float(dmax[u.e]) * (1.0f / 127.0f);
        int tv[2][4]; float wv[2][4];
#pragma unroll
        for (int ai = 0; ai < 2; ++ai)
#pragma unroll
            for (int m = 0; m < 4; ++m) { tv[ai][m] = tokslot[row0 + ai * HALF + m * 16]; wv[ai][m] = wslot[row0 + ai * HALF + m * 16]; }
        asm volatile("" ::: "memory");
#pragma unroll
        for (int ai = 0; ai < 2; ++ai)
#pragma unroll
            for (int m = 0; m < 4; ++m) {
                const int ts = tv[ai][m]; const float w = I8 ? wv[ai][m] * swd : wv[ai][m];
                if (ts >= 0) {
                    bf16_t* yp = Y + (size_t)ts * D + colt;
#pragma unroll
                    for (int bj = 0; bj < 2; ++bj) {
                        if (I8) { f32x4 a0, a1;
#pragma unroll
                            for (int j = 0; j < 4; ++j) { a0[j] = (float)__float_as_int(acc[ai][bj][m][0][j]) * w; a1[j] = (float)__float_as_int(acc[ai][bj][m][1][j]) * w; }
                            *(u32x4*)(yp + bj * HALF) = pack8(a0, a1);
                        } else *(u32x4*)(yp + bj * HALF) = pack8(acc[ai][bj][m][0] * w, acc[ai][bj][m][1] * w); } } }
    }
};
}

struct Args {
    const float* in[26];
    float* out; unsigned char* ws;
    int ph_lo, ph_hi;
};
constexpr int NPHASE = 20;

#define CAS __attribute__((address_space(4)))
struct ArgView {
    const CAS unsigned char* kp;
    __device__ __forceinline__ const float* in_(int i) const { return *(const float* const CAS*)(kp + 8 * i); }
    __device__ __forceinline__ float* out_() const { return *(float* const CAS*)(kp + 208); }
    __device__ __forceinline__ unsigned char* ws_() const { return *(unsigned char* const CAS*)(kp + 216); }
};
struct Ctx {
    LAS unsigned char* lds; int tid, lane, wave, G, bid;
    ArgView av;
};
static_assert(sizeof(Args) == 232, "Args layout vs ArgView offsets");

__device__ __forceinline__ void p0_adaln(const Ctx& cx) {
    const ArgView a = cx.av;
    const float* w_ada = a.in_(4); const float* b_ada = a.in_(5); const float* cvec = a.in_(1); const float* cctx = a.in_(3);
    float* mod = (float*)(a.ws_() + WS_CTL + CTL_MOD);
    const int lane = cx.lane, w = cx.wave;
    LAS float* red = (LAS float*)cx.lds;
    for (int task = cx.bid; task < 2 * 96; task += cx.G) {
        const int l = task / 96, cg = task % 96;
        const int k0 = w * 256, n0 = cg * 128 + lane * 2;
        const float* W = w_ada + ((size_t)l * D + k0) * 12288 + n0;
        f32x2 acc[3] = {(f32x2){0.f, 0.f}, (f32x2){0.f, 0.f}, (f32x2){0.f, 0.f}};
        for (int h = 0; h < 4; ++h) {
            const float s0 = silu_f(cvec[k0 + 64 * h + lane]), s1 = silu_f(cvec[D + k0 + 64 * h + lane]), s2 = silu_f(cctx[k0 + 64 * h + lane]);
#pragma unroll
            for (int jb = 0; jb < 2; ++jb) {
                f32x2 wv[32];
#pragma unroll
                for (int j = 0; j < 32; ++j) wv[j] = __builtin_nontemporal_load((const f32x2*)(W + (size_t)(64 * h + 32 * jb + j) * 12288));
                asm volatile("" ::: "memory");
#pragma unroll
                for (int j = 0; j < 32; ++j) {
                    acc[0] += wv[j] * __int_as_float(__builtin_amdgcn_readlane(__float_as_int(s0), 32 * jb + j));
                    acc[1] += wv[j] * __int_as_float(__builtin_amdgcn_readlane(__float_as_int(s1), 32 * jb + j));
                    acc[2] += wv[j] * __int_as_float(__builtin_amdgcn_readlane(__float_as_int(s2), 32 * jb + j));
                }
            }
        }
#pragma unroll
        for (int r = 0; r < 3; ++r) *(LAS f32x2*)(red + (w * 3 + r) * 128 + 2 * lane) = acc[r];
        __syncthreads();
        for (int idx = cx.tid; idx < 384; idx += NTHR) { const int r = idx >> 7, c = idx & 127;
            float sum = b_ada[(size_t)l * 12288 + cg * 128 + c];
#pragma unroll
            for (int ww = 0; ww < 8; ++ww) sum += red[(ww * 3 + r) * 128 + c];
            mod[((size_t)l * 3 + r) * 12288 + cg * 128 + c] = sum; }
        __syncthreads();
    }
    f32x2* tab = (f32x2*)(a.ws_() + WS_ROPE);
    for (int idx = cx.bid * NTHR + cx.tid; idx < 128 * 32; idx += cx.G * NTHR) {
        const int pos = idx >> 5, i = idx & 31;
        const float invf = powf(10000.0f, -(float)i / 32.0f); const float ang = (float)pos * invf;
        tab[idx] = (f32x2){cosf(ang), sinf(ang)};
    }
}

__device__ __forceinline__ void tr_item(const float* src, int N, int k0, int n0, bf16_t* dst, int ldd, int drow0, LAS float* scr, int lane, int shift32 = 0) {
    f32x4 v[16];
    const float* p = src + (size_t)(k0 + (lane >> 4)) * N + n0 + 4 * (lane & 15);
#pragma unroll
    for (int i = 0; i < 16; ++i) v[i] = __builtin_nontemporal_load((const f32x4*)(p + (size_t)(4 * i) * N));
#pragma unroll
    for (int i = 0; i < 16; ++i) { LAS float* s = scr + (4 * i + (lane >> 4)) * 65 + 4 * (lane & 15); s[0] = v[i][0]; s[1] = v[i][1]; s[2] = v[i][2]; s[3] = v[i][3]; }
    LDS_WAIT();
    const int c = lane & 7;
#pragma unroll
    for (int jj = 0; jj < 8; ++jj) { const int n = (lane >> 3) + 8 * jj; const LAS float* s = scr + (8 * c) * 65 + n;
        u32x4 o; o.x = cvt_pk_bf16(s[0], s[65]); o.y = cvt_pk_bf16(s[2 * 65], s[3 * 65]); o.z = cvt_pk_bf16(s[4 * 65], s[5 * 65]); o.w = cvt_pk_bf16(s[6 * 65], s[7 * 65]);
        *(u32x4*)(dst + (size_t)(drow0 + n + (n >= 32 ? shift32 : 0)) * ldd + k0 + 8 * c) = o; }
    LDS_WAIT();
}
__device__ __forceinline__ unsigned pk4_i8(float a, float b, float c, float d) {
    const int q0 = (int)fminf(fmaxf(__builtin_rintf(a), -127.f), 127.f), q1 = (int)fminf(fmaxf(__builtin_rintf(b), -127.f), 127.f);
    const int q2 = (int)fminf(fmaxf(__builtin_rintf(c), -127.f), 127.f), q3 = (int)fminf(fmaxf(__builtin_rintf(d), -127.f), 127.f);
    return (unsigned)(q0 & 255) | ((unsigned)(q1 & 255) << 8) | ((unsigned)(q2 & 255) << 16) | ((unsigned)(q3 & 255) << 24); }
__device__ __forceinline__ void tr_item_i8(const float* src, int N, int k0, int n0, unsigned char* dst, int ldd, int drow0, const unsigned* amaxp, LAS float* scr, int lane, int shift32 = 0) {
    const unsigned ab = __hip_atomic_load(amaxp, __ATOMIC_RELAXED, __HIP_MEMORY_SCOPE_AGENT);
    f32x4 v[16];
    const float* p = src + (size_t)(k0 + (lane >> 4)) * N + n0 + 4 * (lane & 15);
#pragma unroll
    for (int i = 0; i < 16; ++i) v[i] = __builtin_nontemporal_load((const f32x4*)(p + (size_t)(4 * i) * N));
#pragma unroll
    for (int i = 0; i < 16; ++i) { LAS float* s_ = scr + (4 * i + (lane >> 4)) * 65 + 4 * (lane & 15); s_[0] = v[i][0]; s_[1] = v[i][1]; s_[2] = v[i][2]; s_[3] = v[i][3]; }
    LDS_WAIT();
    const float inv = 127.0f / fmaxf(__uint_as_float(ab), 1e-20f);
    const int c = lane & 7;
#pragma unroll
    for (int jj = 0; jj < 8; ++jj) { const int n = (lane >> 3) + 8 * jj; const LAS float* s_ = scr + (8 * c) * 65 + n;
        const u32x2 o = (u32x2){pk4_i8(s_[0] * inv, s_[65] * inv, s_[2 * 65] * inv, s_[3 * 65] * inv), pk4_i8(s_[4 * 65] * inv, s_[5 * 65] * inv, s_[6 * 65] * inv, s_[7 * 65] * inv)};
        *(u32x2*)(dst + (size_t)(drow0 + n + (n >= 32 ? shift32 : 0)) * ldd + k0 + 8 * c) = o; }
    LDS_WAIT();
}
constexpr int CV_IN = 32 * 80, CV_GT = 32 * 64, CV_A = 16 * 32, CV_O = 32 * 32, CV_EG = 32 * 32 * 8, CV_ED = 32 * 8 * 32;
constexpr int CV_DENSE = CV_IN + CV_GT + 2 * CV_A + CV_O, CV_EXP = 2 * CV_EG + CV_ED, CV_LAYER = CV_DENSE + CV_EXP;
static_assert(CV_DENSE == 6656 && CV_LAYER == 31232, "conversion item counts");
constexpr int CQ_TOTAL = CV_EXP + CV_LAYER;
__device__ __forceinline__ void conv_item(const ArgView a, int l, int r, LAS float* scr, int lane) {
    unsigned char* wset = a.ws_() + (size_t)l * WSET_BYTES;
    bf16_t* WC = (bf16_t*)(wset + WS_WC);
    if (r < CV_IN) { const int kb = r / 80, nb = r % 80, n0 = 64 * nb;
        int drow0 = n0, sh = 0;
        if (n0 >= 3072 && n0 < 4096) { const int lo = n0 - 3072; drow0 = 3072 + (lo & ~255) + 64 * ((lo >> 7) & 1) + 32 * ((lo >> 6) & 1); sh = 96; }
        if (MK_I8IN) {
            tr_item_i8(a.in_(8) + (size_t)l * D * INW, INW, 64 * kb, n0, (unsigned char*)(wset + WS_WC), D, drow0, (const unsigned*)(a.ws_() + WS_CTL) + CW_GMAX + 2 + l, scr, lane, sh);
        } else
        tr_item(a.in_(8) + (size_t)l * D * INW, INW, 64 * kb, n0, WC, D, drow0, scr, lane, sh); return; } r -= CV_IN;
    if (r < CV_GT) { const int kb = r / 64, nb = r % 64, n0 = 64 * nb, c = n0 & (D - 1);
        if (MK_I8GATE) {
            tr_item_i8(a.in_(13) + (size_t)l * D * GATEW, GATEW, 64 * kb, n0, (unsigned char*)(wset + WS_WC) + (size_t)INW * D * 2, D, 256 * (c >> 7) + (c & 127) + 128 * (n0 >> 11), (const unsigned*)(a.ws_() + WS_CTL) + CW_GMAX + l, scr, lane);
        } else
        tr_item(a.in_(13) + (size_t)l * D * GATEW, GATEW, 64 * kb, n0, WC, D, INW + 256 * (c >> 7) + (c & 127) + 128 * (n0 >> 11), scr, lane); return; } r -= CV_GT;
    if (r < 2 * CV_A) { const int b = r / CV_A; r %= CV_A; const int kb = r / 32, nb = r % 32;
        if (I8SEL(MK_I8M, l))
            tr_item_i8(a.in_(15 + b) + (size_t)l * SGUW * D, D, 64 * kb, 64 * nb, wset + WS_WA + (size_t)b * SGUW, D, 64 * nb, (const unsigned*)(a.ws_() + WS_CTL) + CW_GMAX + 6 + 2 * l + b, scr, lane);
        else
        tr_item(a.in_(15 + b) + (size_t)l * SGUW * D, D, 64 * kb, 64 * nb, (bf16_t*)(wset + WS_WA) + (size_t)b * SGUW, D, 64 * nb, scr, lane); return; } r -= 2 * CV_A;
    if (r < CV_O) { const int kb = r / 32, nb = r % 32;
        if (I8SEL(MK_I8O, l)) {
            tr_item_i8(a.in_(17) + (size_t)l * D * D, D, 64 * kb, 64 * nb, wset + WS_WO, D, 64 * nb, (const unsigned*)(a.ws_() + WS_CTL) + CW_GMAX + 4 + l, scr, lane);
        } else
        tr_item(a.in_(17) + (size_t)l * D * D, D, 64 * kb, 64 * nb, (bf16_t*)(wset + WS_WO), D, 64 * nb, scr, lane); return; } r -= CV_O;
    if (r < 2 * CV_EG) { const int up = r / CV_EG; r %= CV_EG; const int e = r / 256, q = r % 256, kb = q / 8, nb = q % 8, n0 = 64 * nb;
        const float* src = a.in_(22 + up) + ((size_t)l * NEXP + e) * D * DEXP;
        if (I8SEL(MK_I8E, l)) {
            tr_item_i8(src, DEXP, 64 * kb, n0, wset + WS_WGU + (size_t)e * 1024 * D, D, 256 * (n0 >> 7) + (n0 & 127) + 128 * up, (const unsigned*)(a.ws_() + WS_CTL) + CW_EMAX + 64 * l + 2 * e + up, scr, lane);
        } else
        tr_item(src, DEXP, 64 * kb, n0, (bf16_t*)(wset + WS_WGU) + (size_t)e * 1024 * D, D, 256 * (n0 >> 7) + (n0 & 127) + 128 * up, scr, lane); return; } r -= 2 * CV_EG;
    { const int e = r / 256, q = r % 256, kb = q / 32, nb = q % 32;
      if (I8SEL(MK_I8D, l)) {
          tr_item_i8(a.in_(24) + ((size_t)l * NEXP + e) * DEXP * D, D, 64 * kb, 64 * nb, wset + WS_WD + (size_t)e * D * DEXP, DEXP, 64 * nb, (const unsigned*)(a.ws_() + WS_CTL) + CW_DMAX + 32 * l + e, scr, lane);
      } else
      tr_item(a.in_(24) + ((size_t)l * NEXP + e) * DEXP * D, D, 64 * kb, 64 * nb, (bf16_t*)(wset + WS_WD) + (size_t)e * D * DEXP, DEXP, 64 * nb, scr, lane); }
}
__device__ __forceinline__ void conv_range(const Ctx& cx, int qlo, int qhi, int rank, int nblk) {
    LAS float* scr = (LAS float*)(cx.lds + cx.wave * 16640);
    for (int q = qlo + rank * NWAVES + cx.wave; q < qhi; q += nblk * NWAVES) {
        if (q < CV_EXP) conv_item(cx.av, 0, CV_DENSE + q, scr, cx.lane); else conv_item(cx.av, 1, q - CV_EXP, scr, cx.lane); }
}
__device__ __forceinline__ void conv_tail(const Ctx& cx, int nwg, int qlo, int qhi) {
    const int rem = nwg % cx.G;
    if (rem == 0) conv_range(cx, qlo, qhi, cx.bid, cx.G);
    else if (cx.bid >= rem) conv_range(cx, qlo, qhi, cx.bid - rem, cx.G - rem);
}
__device__ __forceinline__ void conv_gate0(const Ctx& cx) {
    LAS float* scr = (LAS float*)(cx.lds + cx.wave * 16640);
    for (int r = (MK_I8IN ? 0 : CV_IN) + cx.bid * NWAVES + cx.wave; r < CV_IN + CV_GT; r += cx.G * NWAVES) conv_item(cx.av, 0, r, scr, cx.lane);
    if (MK_I8O & 1) for (int r = CV_DENSE - CV_O + cx.bid * NWAVES + cx.wave; r < CV_DENSE; r += cx.G * NWAVES) conv_item(cx.av, 0, r, scr, cx.lane);
    if (MK_I8M & 1) for (int r = CV_IN + CV_GT + cx.bid * NWAVES + cx.wave; r < CV_DENSE - CV_O; r += cx.G * NWAVES) conv_item(cx.av, 0, r, scr, cx.lane);
}
__device__ __forceinline__ int gemm_wgs(int nwg, int G) { const int rounds = (nwg + G - 1) / G; int g = rounds > 0 ? (nwg + rounds - 1) / rounds : G; g = (g + 7) & ~7; return g < G ? g : G; }
__device__ __forceinline__ void conv_side(const Ctx& cx, int Gg, int qlo, int qhi) {
    if (qhi <= qlo) return;
    if (Gg >= cx.G) conv_range(cx, qlo, qhi, cx.bid, cx.G);
    else if (cx.bid >= Gg) conv_range(cx, qlo, qhi, cx.bid - Gg, cx.G - Gg);
}
__device__ __forceinline__ void pw_convert0(const Ctx& cx) {
    const ArgView a = cx.av;
    LAS float* scr = (LAS float*)(cx.lds + cx.wave * 16640);
#define CV_SKIP_GATE(r) ((MK_I8GATE && (r) >= CV_IN && (r) < CV_IN + CV_GT) || (MK_I8IN && (r) < CV_IN) || ((MK_I8O & 1) && (r) >= CV_DENSE - CV_O) || ((MK_I8M & 1) && (r) >= CV_IN + CV_GT && (r) < CV_DENSE - CV_O))
    if (cx.G >= 224) { if (cx.bid >= 192) for (int r = (cx.bid - 192) * NWAVES + cx.wave; r < CV_DENSE; r += (cx.G - 192) * NWAVES) { if (!CV_SKIP_GATE(r)) conv_item(a, 0, r, scr, cx.lane); } }
    else for (int r = cx.bid * NWAVES + cx.wave; r < CV_DENSE; r += cx.G * NWAVES) { if (!CV_SKIP_GATE(r)) conv_item(a, 0, r, scr, cx.lane); }
#undef CV_SKIP_GATE
#define WG_PUSH_MAX(val, word) do { LAS float* r_ = (LAS float*)(cx.lds + LDS_MISC + 128); if (cx.lane == 0) r_[cx.wave] = (val); __syncthreads(); \
        if (cx.tid == 0) { float mm_ = r_[0]; for (int i_ = 1; i_ < NWAVES; ++i_) mm_ = fmaxf(mm_, r_[i_]); \
            __hip_atomic_fetch_max((unsigned*)(a.ws_() + WS_CTL) + (word), __float_as_uint(mm_), __ATOMIC_RELAXED, __HIP_MEMORY_SCOPE_AGENT); } __syncthreads(); } while (0)
    if (MK_I8GATE) {
        for (int l = 0; l < 2; ++l) { const f32x4* w = (const f32x4*)(a.in_(13) + (size_t)l * D * GATEW); float m = 0.f;
            for (int i = cx.bid * NTHR + cx.tid; i < (D / 8) * (GATEW / 4); i += cx.G * NTHR) { const f32x4 v = w[(size_t)(i / (GATEW / 4)) * 8 * (GATEW / 4) + i % (GATEW / 4)]; m = fmaxf(m, fmaxf(fmaxf(fabsf(v[0]), fabsf(v[1])), fmaxf(fabsf(v[2]), fabsf(v[3])))); }
#pragma unroll
            for (int o = 1; o < 64; o <<= 1) m = fmaxf(m, __shfl_xor(m, o));
            WG_PUSH_MAX(m * GMAX_MARGIN, CW_GMAX + l); }
    }
    if (MK_I8IN) {
        for (int l = 0; l < 2; ++l) { const f32x4* w = (const f32x4*)(a.in_(8) + (size_t)l * D * INW); float m = 0.f;
            for (int i = cx.bid * NTHR + cx.tid; i < (D / 8) * (INW / 4); i += cx.G * NTHR) { const f32x4 v = w[(size_t)(i / (INW / 4)) * 8 * (INW / 4) + i % (INW / 4)]; m = fmaxf(m, fmaxf(fmaxf(fabsf(v[0]), fabsf(v[1])), fmaxf(fabsf(v[2]), fabsf(v[3])))); }
#pragma unroll
            for (int o = 1; o < 64; o <<= 1) m = fmaxf(m, __shfl_xor(m, o));
            WG_PUSH_MAX(m * GMAX_MARGIN, CW_GMAX + 2 + l); }
    }
    if (MK_I8M) {
        for (int mb = 0; mb < 4; ++mb) { const int l = mb >> 1, b = mb & 1; const f32x4* w = (const f32x4*)(a.in_(15 + b) + (size_t)l * SGUW * D); float m = 0.f;
            for (int i = cx.bid * NTHR + cx.tid; i < (SGUW / 8) * (D / 4); i += cx.G * NTHR) { const f32x4 v = w[(size_t)(i / (D / 4)) * 8 * (D / 4) + i % (D / 4)]; m = fmaxf(m, fmaxf(fmaxf(fabsf(v[0]), fabsf(v[1])), fmaxf(fabsf(v[2]), fabsf(v[3])))); }
#pragma unroll
            for (int o = 1; o < 64; o <<= 1) m = fmaxf(m, __shfl_xor(m, o));
            WG_PUSH_MAX(m * GMAX_MARGIN, CW_GMAX + 6 + 2 * l + b); }
    }
    if (MK_I8O) {
        for (int l = 0; l < 2; ++l) { const f32x4* w = (const f32x4*)(a.in_(17) + (size_t)l * D * D); float m = 0.f;
            for (int i = cx.bid * NTHR + cx.tid; i < (D / 8) * (D / 4); i += cx.G * NTHR) { const f32x4 v = w[(size_t)(i / (D / 4)) * 8 * (D / 4) + i % (D / 4)]; m = fmaxf(m, fmaxf(fmaxf(fabsf(v[0]), fabsf(v[1])), fmaxf(fabsf(v[2]), fabsf(v[3])))); }
#pragma unroll
            for (int o = 1; o < 64; o <<= 1) m = fmaxf(m, __shfl_xor(m, o));
            WG_PUSH_MAX(m * GMAX_MARGIN, CW_GMAX + 4 + l); }
    }
    if (MK_I8D) {
        for (int uu = cx.bid * NWAVES + cx.wave; uu < 1024; uu += cx.G * NWAVES) {
            const int mat = uu >> 4, part = uu & 15, l = mat >> 5, e = mat & 31;
            if (!(I8SEL(MK_I8D, l))) continue;
            const float* src = a.in_(24) + ((size_t)l * NEXP + e) * DEXP * D + (size_t)(part * 32) * D;
            f32x4 v[8];
#pragma unroll
            for (int j = 0; j < 8; ++j) v[j] = *(const f32x4*)(src + 4 * (j * 64 + cx.lane));
            float m = 0.f;
#pragma unroll
            for (int j = 0; j < 8; ++j) m = fmaxf(m, fmaxf(fmaxf(fabsf(v[j][0]), fabsf(v[j][1])), fmaxf(fabsf(v[j][2]), fabsf(v[j][3]))));
#pragma unroll
            for (int o = 1; o < 64; o <<= 1) m = fmaxf(m, __shfl_xor(m, o));
            if (cx.lane == 0) __hip_atomic_fetch_max((unsigned*)(a.ws_() + WS_CTL) + CW_DMAX + 32 * l + e, __float_as_uint(m * EMAX_MARGIN), __ATOMIC_RELAXED, __HIP_MEMORY_SCOPE_AGENT);
        }
    }
    if (MK_I8E) {
        for (int uu = cx.bid * NWAVES + cx.wave; uu < 2048; uu += cx.G * NWAVES) {
            const int mat = uu >> 4, part = uu & 15, l = mat >> 6, up = (mat >> 5) & 1, e = mat & 31;
            if (!(I8SEL(MK_I8E, l))) continue;
            const float* src = a.in_(22 + up) + ((size_t)l * NEXP + e) * D * DEXP;
            f32x4 v[8];
#pragma unroll
            for (int j = 0; j < 8; ++j) { const int idx = j * 64 + cx.lane; v[j] = *(const f32x4*)(src + (size_t)((part * 4 + (idx >> 7)) * 32) * DEXP + 4 * (idx & 127)); }
            float m = 0.f;
#pragma unroll
            for (int j = 0; j < 8; ++j) m = fmaxf(m, fmaxf(fmaxf(fabsf(v[j][0]), fabsf(v[j][1])), fmaxf(fabsf(v[j][2]), fabsf(v[j][3]))));
#pragma unroll
            for (int o = 1; o < 64; o <<= 1) m = fmaxf(m, __shfl_xor(m, o));
            if (cx.lane == 0) __hip_atomic_fetch_max((unsigned*)(a.ws_() + WS_CTL) + CW_EMAX + 64 * l + 2 * e + up, __float_as_uint(m * EMAX_MARGIN), __ATOMIC_RELAXED, __HIP_MEMORY_SCOPE_AGENT);
        }
    }
    for (int idx = cx.bid * NTHR + cx.tid; idx < 2 * 48 * D; idx += cx.G * NTHR) {
        const int l = idx / (48 * D), id = idx % (48 * D), row = id / D, k = id % D;
        const float* wre = a.in_(20) + (size_t)l * D * NEXP; const float* wrg = a.in_(18) + (size_t)l * D * 4;
        bf16_t* WR = (bf16_t*)(a.ws_() + (size_t)l * WSET_BYTES + WS_WR);
        const float v = row < 32 ? wre[(size_t)k * NEXP + row] : (row < 36 ? wrg[(size_t)k * 4 + (row - 32)] : 0.f);
        const int mt = row >> 4, fr = row & 15, ki = k >> 5, fq = (k >> 3) & 3, j = k & 7;
        WR[(((size_t)mt * 64 + ki) * 64 + fq * 16 + fr) * 8 + j] = (bf16_t)(cvt_pk_bf16(v, 0.f) & 0xffffu);
    }
}

#define ROW_E(jj) (8 * (lane + 64 * ((jj) >> 1)) + 4 * ((jj) & 1))
template <int MODE>
__device__ __forceinline__ void norm_phase(const Ctx& cx, int T) {
    const ArgView a = cx.av;
    const int gw = cx.bid * NWAVES + cx.wave, NGW = cx.G * NWAVES, lane = cx.lane;
    const int t0 = (int)((long)gw * T / NGW), t1 = (int)((long)(gw + 1) * T / NGW);
    bf16_t* xs = (bf16_t*)(a.ws_() + WS_XS); bf16_t* hx = (bf16_t*)(a.ws_() + WS_HX); const bf16_t* yb = (const bf16_t*)(a.ws_() + WS_G);
    const float* modbase = (const float*)(a.ws_() + WS_CTL + CTL_MOD);
    const int lcur = (MODE == 0) ? 0 : 1;
    const float* nw = (MODE == 2) ? a.in_(25) : (a.in_(6) + (size_t)lcur * D);
    const bool do_comb = (MODE == 1) ? ((MK_MASK & 2) != 0) : ((MODE == 2) ? ((MK_MASK & 8) != 0) : false);
    const int lprev = (MODE == 2) ? 1 : 0;
    f32x4 vA[8], vB[8], vG[8]; int curcls = -1;
    f32x4 nxf[8]; u32x4 nxs[4], ny0[4], ny1[4];
    auto fetch = [&](int tk) {
        if (MODE == 0) {
            const float* xr = tk < MLAT ? a.in_(0) + (size_t)tk * D : a.in_(2) + (size_t)(tk - MLAT) * D;
#pragma unroll
            for (int j = 0; j < 8; ++j) nxf[j] = __builtin_nontemporal_load((const f32x4*)(xr + ROW_E(j)));
        } else {
#pragma unroll
            for (int j = 0; j < 4; ++j) nxs[j] = __builtin_nontemporal_load((const u32x4*)(xs + (size_t)tk * D + 8 * (lane + 64 * j)));
            if (do_comb) { const bf16_t* y0 = yb + (size_t)tk * 2 * D;
#pragma unroll
                for (int j = 0; j < 4; ++j) { ny0[j] = __builtin_nontemporal_load((const u32x4*)(y0 + 8 * (lane + 64 * j))); ny1[j] = __builtin_nontemporal_load((const u32x4*)(y0 + D + 8 * (lane + 64 * j))); } }
        }
    };
    if (gw < T) fetch(gw);
    for (int tok = gw; tok < T; tok += NGW) {
        const int cls = tok < SEQ ? 0 : (tok < MLAT ? 1 : 2);
        if (cls != curcls) { curcls = cls;
#define NP_TAB(R) _Pragma("unroll") for (int jj = 0; jj < 8; ++jj) { const int j = (jj + (R)) & 7; const int e = ROW_E(j); const f32x4 w = *(const f32x4*)(nw + e); \
                if (MODE == 2) { vA[j] = w; vB[j] = (f32x4){0.f, 0.f, 0.f, 0.f}; } \
                else { const float* mp = modbase + ((size_t)lcur * 3 + cls) * 12288; vA[j] = w * (*(const f32x4*)(mp + D + e) + 1.0f); vB[j] = *(const f32x4*)(mp + e); } \
                if (MODE != 0) vG[j] = *(const f32x4*)(modbase + ((size_t)lprev * 3 + cls) * 12288 + 5 * D + e); }
            switch (cx.bid & 3) { case 0: NP_TAB(0) break; case 1: NP_TAB(2) break; case 2: NP_TAB(4) break; default: NP_TAB(6) break; }
#undef NP_TAB
        }
        f32x4 v[8]; float ss = 0.f;
        if (MODE == 0) {
#pragma unroll
            for (int j = 0; j < 8; ++j) v[j] = nxf[j];
        } else {
#pragma unroll
            for (int j = 0; j < 4; ++j) pg8::unpack8(nxs[j], v[2 * j], v[2 * j + 1]);
        }
        u32x4 cy0[4], cy1[4];
        if (MODE != 0 && do_comb) {
#pragma unroll
            for (int j = 0; j < 4; ++j) { cy0[j] = ny0[j]; cy1[j] = ny1[j]; }
        }
        if (tok + NGW < T) fetch(tok + NGW);
        asm volatile("" ::: "memory");
        if (MODE != 0 && do_comb) {
#pragma unroll
            for (int j = 0; j < 4; ++j) { const u32x4 p0 = cy0[j], p1 = cy1[j];
                f32x4 a0, a1, b0, b1; pg8::unpack8(p0, a0, a1); pg8::unpack8(p1, b0, b1);
                v[2 * j] += vG[2 * j] * (a0 + b0); v[2 * j + 1] += vG[2 * j + 1] * (a1 + b1); }
            if (MODE == 1) {
#pragma unroll
                for (int j = 0; j < 4; ++j) { const u32x4 pk = pg8::pack8(v[2 * j], v[2 * j + 1]); *(u32x4*)(xs + (size_t)tok * D + 8 * (lane + 64 * j)) = pk;
                    pg8::unpack8(pk, v[2 * j], v[2 * j + 1]); }
            }
        }
#pragma unroll
        for (int j = 0; j < 8; ++j) ss += (v[j][0] * v[j][0] + v[j][1] * v[j][1]) + (v[j][2] * v[j][2] + v[j][3] * v[j][3]);
        const float rstd = 1.0f / sqrtf(wave_sum(ss) * (1.0f / D) + RMS_EPS);
        if (MODE == 2) {
#pragma unroll
            for (int j = 0; j < 8; ++j) *(f32x4*)(a.out_() + (size_t)tok * D + ROW_E(j)) = v[j] * rstd * vA[j];
        } else {
            float hmax = 0.f;
#pragma unroll
            for (int j = 0; j < 8; ++j) { v[j] = v[j] * rstd * vA[j] + vB[j]; hmax = fmaxf(hmax, fmaxf(fmaxf(fabsf(v[j][0]), fabsf(v[j][1])), fmaxf(fabsf(v[j][2]), fabsf(v[j][3])))); }
            if (!(MK_I8GATE && MK_I8IN)) {
#pragma unroll
            for (int j = 0; j < 4; ++j) *(u32x4*)(hx + (size_t)tok * D + 8 * (lane + 64 * j)) = pg8::pack8(v[2 * j], v[2 * j + 1]); }
            if (MK_I8GATE) {
#pragma unroll
                for (int o = 1; o < 64; o <<= 1) hmax = fmaxf(hmax, __shfl_xor(hmax, o));
                hmax = fmaxf(hmax, 1e-20f); const float inv = 127.0f / hmax;
                unsigned char* h8 = a.ws_() + WS_HX8 + (size_t)tok * D;
#pragma unroll
                for (int j = 0; j < 4; ++j) *(u32x2*)(h8 + 8 * (lane + 64 * j)) = (u32x2){pk4_i8(v[2 * j][0] * inv, v[2 * j][1] * inv, v[2 * j][2] * inv, v[2 * j][3] * inv), pk4_i8(v[2 * j + 1][0] * inv, v[2 * j + 1][1] * inv, v[2 * j + 1][2] * inv, v[2 * j + 1][3] * inv)};
                if (lane == 0) ((float*)(a.ws_() + WS_SX))[tok] = hmax * (1.0f / 127.0f);
            }
        }
    }
}

__device__ __forceinline__ void quant_rows2048(const Ctx& cx, const bf16_t* src, unsigned char* dst, float* scale, int nrows) {
    const int gw = cx.bid * NWAVES + cx.wave, NGW = cx.G * NWAVES, lane = cx.lane;
    u32x4 nx[4];
    if (gw < nrows) {
#pragma unroll
        for (int j = 0; j < 4; ++j) nx[j] = *(const u32x4*)(src + (size_t)gw * D + 8 * (lane + 64 * j)); }
    for (int row = gw; row < nrows; row += NGW) {
        f32x4 v[8];
#pragma unroll
        for (int j = 0; j < 4; ++j) pg8::unpack8(nx[j], v[2 * j], v[2 * j + 1]);
        if (row + NGW < nrows) {
#pragma unroll
            for (int j = 0; j < 4; ++j) nx[j] = *(const u32x4*)(src + (size_t)(row + NGW) * D + 8 * (lane + 64 * j)); }
        float hmax = 0.f;
#pragma unroll
        for (int j = 0; j < 8; ++j) hmax = fmaxf(hmax, fmaxf(fmaxf(fabsf(v[j][0]), fabsf(v[j][1])), fmaxf(fabsf(v[j][2]), fabsf(v[j][3]))));
#pragma unroll
        for (int o = 1; o < 64; o <<= 1) hmax = fmaxf(hmax, __shfl_xor(hmax, o));
        hmax = fmaxf(hmax, 1e-20f); const float inv = 127.0f / hmax;
        unsigned char* h8 = dst + (size_t)row * D;
#pragma unroll
        for (int j = 0; j < 4; ++j) *(u32x2*)(h8 + 8 * (lane + 64 * j)) = (u32x2){pk4_i8(v[2 * j][0] * inv, v[2 * j][1] * inv, v[2 * j][2] * inv, v[2 * j][3] * inv), pk4_i8(v[2 * j + 1][0] * inv, v[2 * j + 1][1] * inv, v[2 * j + 1][2] * inv, v[2 * j + 1][3] * inv)};
        if (lane == 0) scale[row] = hmax * (1.0f / 127.0f);
    }
}

__device__ __forceinline__ void quant_rows_ao(const Ctx& cx, const bf16_t* src, unsigned char* dst, float* cab, float* sob, float swa, float swb, int nrows) {
    const int gw = cx.bid * NWAVES + cx.wave, NGW = cx.G * NWAVES, lane = cx.lane;
    u32x4 nx[4];
    if (gw < nrows) {
#pragma unroll
        for (int j = 0; j < 4; ++j) nx[j] = *(const u32x4*)(src + (size_t)gw * D + 8 * (lane + 64 * j)); }
    for (int row = gw; row < nrows; row += NGW) {
        f32x4 v[8];
#pragma unroll
        for (int j = 0; j < 4; ++j) pg8::unpack8(nx[j], v[2 * j], v[2 * j + 1]);
        if (row + NGW < nrows) {
#pragma unroll
            for (int j = 0; j < 4; ++j) nx[j] = *(const u32x4*)(src + (size_t)(row + NGW) * D + 8 * (lane + 64 * j)); }
        float ma = 0.f, mo = 0.f;
#pragma unroll
        for (int j = 0; j < 4; ++j) { ma = fmaxf(ma, fmaxf(fmaxf(fabsf(v[j][0]), fabsf(v[j][1])), fmaxf(fabsf(v[j][2]), fabsf(v[j][3])))); mo = fmaxf(mo, fmaxf(fmaxf(fabsf(v[4 + j][0]), fabsf(v[4 + j][1])), fmaxf(fabsf(v[4 + j][2]), fabsf(v[4 + j][3])))); }
#pragma unroll
        for (int o = 1; o < 64; o <<= 1) { ma = fmaxf(ma, __shfl_xor(ma, o)); mo = fmaxf(mo, __shfl_xor(mo, o)); }
        ma = fmaxf(ma, 1e-20f); mo = fmaxf(mo, 1e-20f); const float ia = 127.0f / ma, io = 127.0f / mo;
        unsigned char* h8 = dst + (size_t)row * D;
#pragma unroll
        for (int j = 0; j < 4; ++j) { const float inv = j < 2 ? ia : io;
            *(u32x2*)(h8 + 8 * (lane + 64 * j)) = (u32x2){pk4_i8(v[2 * j][0] * inv, v[2 * j][1] * inv, v[2 * j][2] * inv, v[2 * j][3] * inv), pk4_i8(v[2 * j + 1][0] * inv, v[2 * j + 1][1] * inv, v[2 * j + 1][2] * inv, v[2 * j + 1][3] * inv)}; }
        if (lane == 0) { const float sa = ma * (1.0f / 127.0f) * swa, so_ = mo * (1.0f / 127.0f) * swb; cab[row] = sa / so_; sob[row] = so_; }
    }
}
__device__ __forceinline__ void quant_rows512(const Ctx& cx, const bf16_t* src, unsigned char* dst, float* scale, const float* wslot, int nrows) {
    const int gw = cx.bid * NWAVES + cx.wave, NGW = cx.G * NWAVES, lane = cx.lane;
    u32x4 nxt[4];
    if (gw * 4 < nrows) {
#pragma unroll
        for (int i = 0; i < 4; ++i) nxt[i] = __builtin_nontemporal_load((const u32x4*)(src + (size_t)(gw * 4 + i) * DEXP + 8 * lane)); }
    for (int r0 = gw * 4; r0 < nrows; r0 += NGW * 4) {
        u32x4 raw[4];
#pragma unroll
        for (int i = 0; i < 4; ++i) raw[i] = nxt[i];
        if (r0 + NGW * 4 < nrows) {
#pragma unroll
            for (int i = 0; i < 4; ++i) nxt[i] = __builtin_nontemporal_load((const u32x4*)(src + (size_t)(r0 + NGW * 4 + i) * DEXP + 8 * lane)); }
        asm volatile("" ::: "memory");
#pragma unroll
        for (int i = 0; i < 4; ++i) {
            f32x4 a0, a1; pg8::unpack8(raw[i], a0, a1);
            float hmax = fmaxf(fmaxf(fmaxf(fabsf(a0[0]), fabsf(a0[1])), fmaxf(fabsf(a0[2]), fabsf(a0[3]))), fmaxf(fmaxf(fabsf(a1[0]), fabsf(a1[1])), fmaxf(fabsf(a1[2]), fabsf(a1[3]))));
#pragma unroll
            for (int o = 1; o < 64; o <<= 1) hmax = fmaxf(hmax, __shfl_xor(hmax, o));
            hmax = fmaxf(hmax, 1e-20f); const float inv = 127.0f / hmax;
            *(u32x2*)(dst + (size_t)(r0 + i) * DEXP + 8 * lane) = (u32x2){pk4_i8(a0[0] * inv, a0[1] * inv, a0[2] * inv, a0[3] * inv), pk4_i8(a1[0] * inv, a1[1] * inv, a1[2] * inv, a1[3] * inv)};
            if (lane == 0) scale[r0 + i] = hmax * (1.0f / 127.0f) * wslot[r0 + i];
        }
    }
}

__device__ __forceinline__ unsigned offa(unsigned row, unsigned ch);
template <int OFF> __device__ __forceinline__ void tr4(unsigned a0, unsigned a1, bf16x8 (&f)[4]);
__device__ __forceinline__ void sgu_item(const Ctx& cx, int l, int item) {
    const ArgView a = cx.av;
    const int lane = cx.lane, w = cx.wave, fq = lane >> 4, fr = lane & 15;
    int ck, g0, ng;
    if (item < 256) { ck = item >> 1; g0 = 4 * (item & 1); ng = 4; } else { const int ci = item - 256; ck = 128 + (ci >> 3); g0 = ci & 7; ng = 1; }
    const int row0 = ck < 128 ? ck * 128 : MLAT + (ck - 128) * 128;
    const bf16_t* P = (const bf16_t*)(a.ws_() + WS_P); bf16_t* AB = (bf16_t*)(a.ws_() + WS_A);
    const float* nw = a.in_(9) + (size_t)l * SGUW; const float* Ws = a.in_(10) + (size_t)l * 8 * 128 * 128; const float* bs = a.in_(11) + (size_t)l * 8 * 128;
    LAS float* rstdS = (LAS float*)cx.lds; LAS unsigned char* Vt = cx.lds + 1024; const unsigned vt_base = (unsigned)(size_t)Vt;
    auto stage = [&](int g, int buf) {
#pragma unroll
        for (int i = 0; i < 4; ++i) { const unsigned o = 1024u * (4 * w + i) + 16u * lane, srow = 8u * (o >> 11) + ((o >> 6) & 7u), sch = 4u * ((o >> 9) & 3u) + (((o >> 4) & 3u) ^ ((srow >> 2) & 3u));
            __builtin_amdgcn_global_load_lds((const unsigned*)(P + (size_t)(row0 + srow) * INW + SGUW + 128 * g + 8 * sch), (LAS unsigned*)(Vt + buf * 32768 + 1024 * (4 * w + i)), 16, 0, 0); }
    };
    stage(g0, 0);
#pragma unroll 8
    for (int i = 0; i < 16; ++i) { const int m = 16 * w + i; const bf16_t* vp = P + (size_t)(row0 + m) * INW + SGUW + 16 * lane;
        const u32x4 x0 = *(const u32x4*)vp, x1 = *(const u32x4*)(vp + 8); float ss = 0.f;
#pragma unroll
        for (int j = 0; j < 4; ++j) { const float p0 = bflo(x0[j]), p1 = bfhi(x0[j]), p2 = bflo(x1[j]), p3 = bfhi(x1[j]); ss += (p0 * p0 + p1 * p1) + (p2 * p2 + p3 * p3); }
        ss = wave_sum(ss);
        if (lane == 0) rstdS[m] = 1.0f / sqrtf(ss * (1.0f / SGUW) + RMS_EPS); }
    __syncthreads();
    for (int gi = 0; gi < ng; ++gi) {
        const int g = g0 + gi, buf = gi & 1;
        bf16x8 Wf[4];
#pragma unroll
        for (int ks = 0; ks < 4; ++ks) { const float* wp = Ws + ((size_t)g * 128 + 16 * w + fr) * 128 + 32 * ks + 8 * fq;
            const f32x4 r0 = *(const LAS f32x4*)(rstdS + 32 * ks + 8 * fq), r1 = *(const LAS f32x4*)(rstdS + 32 * ks + 8 * fq + 4);
            const f32x4 w0 = *(const f32x4*)wp * r0, w1 = *(const f32x4*)(wp + 4) * r1; const u32x4 pk = pg8::pack8(w0, w1);
            Wf[ks] = __builtin_bit_cast(bf16x8, pk); }
        __syncthreads();
        if (gi + 1 < ng) stage(g + 1, buf ^ 1);
        const int tok = row0 + 16 * w + fr; const float bias = bs[g * 128 + 16 * w + fr];
        u32x2 uuv[8]; f32x4 nvv[8];
#pragma unroll
        for (int ct = 0; ct < 8; ++ct) { const int c = 128 * g + 16 * ct + 4 * fq; uuv[ct] = *(const u32x2*)(P + (size_t)tok * INW + c); nvv[ct] = *(const f32x4*)(nw + c); }
        asm volatile("" ::: "memory");
        f32x4 acc[8];
#pragma unroll
        for (int ct = 0; ct < 8; ++ct) acc[ct] = (f32x4){0.f, 0.f, 0.f, 0.f};
        { unsigned ln = cx.lane; asm volatile("" : "+v"(ln));
          const unsigned fq_o = ln >> 4, q_o = (ln & 15u) >> 2, p_o = ln & 3u;
#pragma unroll
          for (int ks = 0; ks < 4; ++ks)
#pragma unroll
            for (int par = 0; par < 2; ++par) {
                const unsigned vrow0 = 32u * ks + 8u * fq_o + q_o;
                const unsigned a0 = vt_base + buf * 32768 + offa(vrow0, 2u * par + (p_o >> 1)) + 8u * (p_o & 1u);
                const unsigned a1 = vt_base + buf * 32768 + offa(vrow0 + 4u, 2u * par + (p_o >> 1)) + 8u * (p_o & 1u);
                bf16x8 vf[4]; tr4<0>(a0, a1, vf);
#pragma unroll
                for (int i = 0; i < 4; ++i) acc[par + 2 * i] = __builtin_amdgcn_mfma_f32_16x16x32_bf16(vf[i], Wf[ks], acc[par + 2 * i], 0, 0, 0); } }
#pragma unroll
        for (int ct = 0; ct < 8; ++ct) { const int c = 128 * g + 16 * ct + 4 * fq;
            const u32x2 uu = uuv[ct]; const f32x4 nv = nvv[ct];
            const float o0 = bflo(uu.x) * (acc[ct][0] * nv[0] + bias), o1 = bfhi(uu.x) * (acc[ct][1] * nv[1] + bias), o2 = bflo(uu.y) * (acc[ct][2] * nv[2] + bias), o3 = bfhi(uu.y) * (acc[ct][3] * nv[3] + bias);
            *(u32x2*)(AB + (size_t)tok * D + c) = (u32x2){cvt_pk_bf16(o0, o1), cvt_pk_bf16(o2, o3)}; }
    }
}

__device__ __forceinline__ unsigned offa(unsigned row, unsigned ch) { return 2048u * (row >> 3) + 512u * (ch >> 2) + 64u * (row & 7u) + 16u * ((ch & 3u) ^ ((row >> 2) & 3u)); }
template <int OFF>
__device__ __forceinline__ void tr4(unsigned a0, unsigned a1, bf16x8 (&f)[4]) {
    s16x4 r0, r1, r2, r3, r4, r5, r6, r7;
    asm volatile("ds_read_b64_tr_b16 %0, %8 offset:%10\n\tds_read_b64_tr_b16 %1, %9 offset:%10\n\t"
                 "ds_read_b64_tr_b16 %2, %8 offset:%11\n\tds_read_b64_tr_b16 %3, %9 offset:%11\n\t"
                 "ds_read_b64_tr_b16 %4, %8 offset:%12\n\tds_read_b64_tr_b16 %5, %9 offset:%12\n\t"
                 "ds_read_b64_tr_b16 %6, %8 offset:%13\n\tds_read_b64_tr_b16 %7, %9 offset:%13\n\t"
                 "s_waitcnt lgkmcnt(0)"
                 : "=&v"(r0), "=&v"(r1), "=&v"(r2), "=&v"(r3), "=&v"(r4), "=&v"(r5), "=&v"(r6), "=&v"(r7)
                 : "v"(a0), "v"(a1), "i"(OFF), "i"(OFF + 512), "i"(OFF + 1024), "i"(OFF + 1536) : "memory");
    f[0] = (bf16x8){r0[0], r0[1], r0[2], r0[3], r1[0], r1[1], r1[2], r1[3]}; f[1] = (bf16x8){r2[0], r2[1], r2[2], r2[3], r3[0], r3[1], r3[2], r3[3]};
    f[2] = (bf16x8){r4[0], r4[1], r4[2], r4[3], r5[0], r5[1], r5[2], r5[3]}; f[3] = (bf16x8){r6[0], r6[1], r6[2], r6[3], r7[0], r7[1], r7[2], r7[3]};
}
__device__ __forceinline__ void na_item2(const Ctx& cx, int l, int item) {
    const ArgView a = cx.av;
    const int tid = cx.tid, lane = cx.lane, w = cx.wave, fq = lane >> 4, fr = lane & 15;
    const bf16_t* P = (const bf16_t*)(a.ws_() + WS_P); bf16_t* OB = (bf16_t*)(a.ws_() + WS_A) + SGUW;
    const f32x2* rope = (const f32x2*)(a.ws_() + WS_ROPE);
    const bool isctx = item >= 512;
    int b, h, rq = 0;
    if (!isctx) { b = item >> 8; h = (item >> 5) & 7; rq = item & 31; } else { const int it = item - 512; b = it >> 3; h = it & 7; }
    LAS unsigned char* Kt = cx.lds; LAS unsigned char* Vt = cx.lds + 16384; LAS float* biasS = (LAS float*)(cx.lds + 131072);
    const unsigned vt_base = (unsigned)(size_t)Vt;
    const int R0 = 4 * rq, cseg = w & 3, qc = 16 * cseg + fr;
    const int r0a = min(max(R0 - 4, 0), GROWS - 8), r0e = min(max(R0 + 3 - 4, 0), GROWS - 8) + 7;
    const int nloc = isctx ? 0 : (r0e - r0a + 1), ntile = nloc + 4;
    int rA[2], r0w[2], qrow[2];
#pragma unroll
    for (int qt = 0; qt < 2; ++qt) { rA[qt] = R0 + 2 * (w >> 2) + qt; r0w[qt] = min(max(rA[qt] - 4, 0), GROWS - 8);
        qrow[qt] = isctx ? (MLAT + b * CTXL + 32 * w + 16 * qt + fr) : (b * SEQ + rA[qt] * GRID_W + qc); }
    const int cs = (cseg == 0) ? 0 : (cseg == 1 ? 8 : (cseg == 2 ? 24 : 32));
    const int cstart = min(max(qc - 8, 0), GRID_W - 16);
    if (!isctx) { const float* rpb = a.in_(12) + ((size_t)l * NH + h) * 15 * 31; for (int i = tid; i < 465; i += NTHR) biasS[i] = rpb[i] * 1.44269504f; }
    bf16x8 q[2][4];
    if (!isctx) {
#pragma unroll
        for (int qt = 0; qt < 2; ++qt) {
            const bf16_t* qsrc = P + (size_t)qrow[qt] * INW + 2048 + 128 * h + 8 * fq;
            u32x4 raw[4];
#pragma unroll
            for (int ks = 0; ks < 4; ++ks) raw[ks] = *(const u32x4*)(qsrc + 32 * ks);
#pragma unroll
            for (int ax = 0; ax < 2; ++ax) {
                const int pos = ax ? qc : rA[qt]; const f32x2* tp = rope + pos * 32 + 8 * fq;
                f32x4 x1a, x1b, x2a, x2b; pg8::unpack8(raw[2 * ax], x1a, x1b); pg8::unpack8(raw[2 * ax + 1], x2a, x2b);
                f32x4 o1a, o1b, o2a, o2b;
#pragma unroll
                for (int j = 0; j < 4; ++j) { const f32x2 csA = tp[j], csB = tp[4 + j];
                    o1a[j] = x1a[j] * csA.x - x2a[j] * csA.y; o2a[j] = x2a[j] * csA.x + x1a[j] * csA.y;
                    o1b[j] = x1b[j] * csB.x - x2b[j] * csB.y; o2b[j] = x2b[j] * csB.x + x1b[j] * csB.y; }
                const u32x4 p1 = pg8::pack8(o1a, o1b), p2 = pg8::pack8(o2a, o2b);
                q[qt][2 * ax] = __builtin_bit_cast(bf16x8, p1); q[qt][2 * ax + 1] = __builtin_bit_cast(bf16x8, p2);
            }
        }
    }
    auto stage = [&](int ti) {
        const bool loc = ti < nloc; const int buf = ti & 3;
        const size_t row0 = loc ? (size_t)(b * SEQ + (r0a + ti) * GRID_W) : (size_t)(MLAT + b * CTXL + 64 * (ti - nloc));
        unsigned ln = cx.lane; asm volatile("" : "+v"(ln));
#pragma unroll
        for (int i = 0; i < 2; ++i) {
            const unsigned o = 1024u * (2 * w + i) + 16u * ln, srow = 8u * (o >> 11) + ((o >> 6) & 7u), sch = 4u * ((o >> 9) & 3u) + (((o >> 4) & 3u) ^ ((srow >> 2) & 3u));
            const bf16_t* src = P + (row0 + srow) * INW + 3072 + 128 * h + 8 * sch;
            __builtin_amdgcn_global_load_lds((const unsigned*)src, (LAS unsigned*)(Kt + buf * 32768 + 1024 * (2 * w + i)), 16, 0, 0);
            __builtin_amdgcn_global_load_lds((const unsigned*)(src + 1024), (LAS unsigned*)(Vt + buf * 32768 + 1024 * (2 * w + i)), 16, 0, 0);
        }
    };
    float mrun[2] = {-1e30f, -1e30f}, lrun[2] = {0.f, 0.f};
    f32x4 oacc[2][8];
#pragma unroll
    for (int qt = 0; qt < 2; ++qt)
#pragma unroll
        for (int dt = 0; dt < 8; ++dt) oacc[qt][dt] = (f32x4){0.f, 0.f, 0.f, 0.f};
    const float sc_l2 = 0.08838834764831845f * 1.44269504f;

#define NA_SOFTMAX(QT, NT, SARR, PF) do { \
        float lm_ = -INFINITY; \
        _Pragma("unroll") for (int t_ = 0; t_ < NT; ++t_) _Pragma("unroll") for (int j_ = 0; j_ < 4; ++j_) lm_ = fmaxf(lm_, SARR[t_][j_]); \
        if (__any(lm_ > mrun[QT] + 8.0f)) { \
            float tm_ = fmaxf(lm_, __shfl_xor(lm_, 16)); tm_ = fmaxf(tm_, __shfl_xor(tm_, 32)); \
            const float mn_ = fmaxf(mrun[QT], tm_), al_ = __builtin_amdgcn_exp2f(mrun[QT] - mn_); mrun[QT] = mn_; lrun[QT] *= al_; \
            _Pragma("unroll") for (int dt_ = 0; dt_ < 8; ++dt_) oacc[QT][dt_] *= al_; } \
        float ps_ = 0.f; \
        _Pragma("unroll") for (int kb_ = 0; kb_ < NT / 2; ++kb_) { f32x4 p0_, p1_; \
            _Pragma("unroll") for (int j_ = 0; j_ < 4; ++j_) { p0_[j_] = __builtin_amdgcn_exp2f(SARR[2 * kb_][j_] - mrun[QT]); p1_[j_] = __builtin_amdgcn_exp2f(SARR[2 * kb_ + 1][j_] - mrun[QT]); ps_ += p0_[j_] + p1_[j_]; } \
            const u32x4 pk_ = pg8::pack8(p0_, p1_); PF[kb_] = __builtin_bit_cast(bf16x8, pk_); } \
        lrun[QT] += ps_; } while (0)

    stage(0); stage(1); stage(2);
#define NA_TILE_HEAD() \
        const int buf = ti & 3; \
        { const int rem = ntile - 1 - ti; \
          if (rem >= 2) asm volatile("s_waitcnt vmcnt(8) lgkmcnt(0)" ::: "memory"); else if (rem == 1) asm volatile("s_waitcnt vmcnt(4) lgkmcnt(0)" ::: "memory"); else asm volatile("s_waitcnt vmcnt(0) lgkmcnt(0)" ::: "memory"); } \
        __builtin_amdgcn_s_barrier(); asm volatile("" ::: "memory"); \
        if (ti + 3 < ntile) stage(ti + 3);
    for (int ti = 0; ti < nloc; ++ti) {
        NA_TILE_HEAD()
        unsigned lane_o = cx.lane; asm volatile("" : "+v"(lane_o));
        const unsigned fq_o = lane_o >> 4, fr_o = lane_o & 15u, krow_sel = 8u * (fr_o >> 2) + (fr_o & 3u), q_o = fr_o >> 2, p_o = lane_o & 3u;
        const LAS unsigned char* Kb = Kt + buf * 32768;
        const int kr = r0a + ti;
        auto block32 = [&](const unsigned keybase, const bool masked, const bool act0, const bool act1) {
            f32x4 s[2][2];
#pragma unroll
            for (int qt = 0; qt < 2; ++qt)
#pragma unroll
                for (int t = 0; t < 2; ++t) s[qt][t] = (f32x4){0.f, 0.f, 0.f, 0.f};
#pragma unroll
            for (int t = 0; t < 2; ++t) { const LAS unsigned char* kp_ = Kb + offa(keybase + krow_sel + 4 * t, fq_o);
#pragma unroll
                for (int ks = 0; ks < 4; ++ks) { const bf16x8 kf = *(const LAS bf16x8*)(kp_ + 512 * ks);
                    s[0][t] = __builtin_amdgcn_mfma_f32_16x16x32_bf16(kf, q[0][ks], s[0][t], 0, 0, 0);
                    s[1][t] = __builtin_amdgcn_mfma_f32_16x16x32_bf16(kf, q[1][ks], s[1][t], 0, 0, 0); }
                __builtin_amdgcn_sched_barrier(0); }
            bf16x8 pf[2][1];
#pragma unroll
            for (int qt = 0; qt < 2; ++qt) {
                if (masked) {
                    const bool act = qt ? act1 : act0;
                    const LAS float* brow = biasS + (kr - rA[qt] + 7) * 31 + 15 - qc;
#pragma unroll
                    for (int t = 0; t < 2; ++t)
#pragma unroll
                        for (int j = 0; j < 4; ++j) { const int kc = (int)keybase + 8 * (int)fq_o + 4 * t + j; const bool ok = act && (kc >= cstart) && (kc < cstart + 16);
                            const float bv = ok ? brow[kc] : 0.f; s[qt][t][j] = ok ? (s[qt][t][j] * sc_l2 + bv) : -INFINITY; }
                } else {
#pragma unroll
                    for (int t = 0; t < 2; ++t) s[qt][t] *= sc_l2;
                }
                if (qt == 0) NA_SOFTMAX(0, 2, s[0], pf[0]); else NA_SOFTMAX(1, 2, s[1], pf[1]);
            }
            const unsigned vrow0 = keybase + 8u * fq_o + q_o;
#pragma unroll
            for (int par = 0; par < 2; ++par) {
                const unsigned a0 = vt_base + buf * 32768 + offa(vrow0, 2u * par + (p_o >> 1)) + 8u * (p_o & 1u);
                const unsigned a1 = vt_base + buf * 32768 + offa(vrow0 + 4u, 2u * par + (p_o >> 1)) + 8u * (p_o & 1u);
                bf16x8 vf[4]; tr4<0>(a0, a1, vf);
#pragma unroll
                for (int i = 0; i < 4; ++i) { oacc[0][par + 2 * i] = __builtin_amdgcn_mfma_f32_16x16x32_bf16(vf[i], pf[0][0], oacc[0][par + 2 * i], 0, 0, 0);
                                              oacc[1][par + 2 * i] = __builtin_amdgcn_mfma_f32_16x16x32_bf16(vf[i], pf[1][0], oacc[1][par + 2 * i], 0, 0, 0); }
            }
        };
        const bool act0 = (kr >= r0w[0] && kr < r0w[0] + 8), act1 = (kr >= r0w[1] && kr < r0w[1] + 8);
        if (act0 || act1) block32((unsigned)cs, true, act0, act1);
    }
#pragma unroll
    for (int qt = 0; qt < 2; ++qt) { const bf16_t* qsrc = P + (size_t)qrow[qt] * INW + 2048 + 128 * h + 8 * fq;
#pragma unroll
        for (int ks = 0; ks < 4; ++ks) { const u32x4 raw = *(const u32x4*)(qsrc + 32 * ks); q[qt][ks] = __builtin_bit_cast(bf16x8, raw); } }
    for (int ti = nloc; ti < ntile; ++ti) {
        NA_TILE_HEAD()
        unsigned lane_o = cx.lane; asm volatile("" : "+v"(lane_o));
        const unsigned fq_o = lane_o >> 4, fr_o = lane_o & 15u, krow_sel = 8u * (fr_o >> 2) + (fr_o & 3u), q_o = fr_o >> 2, p_o = lane_o & 3u;
        const LAS unsigned char* Kb = Kt + buf * 32768;
        const int kr = r0a + ti;
        auto block32 = [&](const unsigned keybase, const bool masked, const bool act0, const bool act1) {
            f32x4 s[2][2];
#pragma unroll
            for (int qt = 0; qt < 2; ++qt)
#pragma unroll
                for (int t = 0; t < 2; ++t) s[qt][t] = (f32x4){0.f, 0.f, 0.f, 0.f};
#pragma unroll
            for (int t = 0; t < 2; ++t) { const LAS unsigned char* kp_ = Kb + offa(keybase + krow_sel + 4 * t, fq_o);
#pragma unroll
                for (int ks = 0; ks < 4; ++ks) { const bf16x8 kf = *(const LAS bf16x8*)(kp_ + 512 * ks);
                    s[0][t] = __builtin_amdgcn_mfma_f32_16x16x32_bf16(kf, q[0][ks], s[0][t], 0, 0, 0);
                    s[1][t] = __builtin_amdgcn_mfma_f32_16x16x32_bf16(kf, q[1][ks], s[1][t], 0, 0, 0); }
                __builtin_amdgcn_sched_barrier(0); }
            bf16x8 pf[2][1];
#pragma unroll
            for (int qt = 0; qt < 2; ++qt) {
                if (masked) {
                    const bool act = qt ? act1 : act0;
                    const LAS float* brow = biasS + (kr - rA[qt] + 7) * 31 + 15 - qc;
#pragma unroll
                    for (int t = 0; t < 2; ++t)
#pragma unroll
                        for (int j = 0; j < 4; ++j) { const int kc = (int)keybase + 8 * (int)fq_o + 4 * t + j; const bool ok = act && (kc >= cstart) && (kc < cstart + 16);
                            const float bv = ok ? brow[kc] : 0.f; s[qt][t][j] = ok ? (s[qt][t][j] * sc_l2 + bv) : -INFINITY; }
                } else {
#pragma unroll
                    for (int t = 0; t < 2; ++t) s[qt][t] *= sc_l2;
                }
                if (qt == 0) NA_SOFTMAX(0, 2, s[0], pf[0]); else NA_SOFTMAX(1, 2, s[1], pf[1]);
            }
            const unsigned vrow0 = keybase + 8u * fq_o + q_o;
#pragma unroll
            for (int par = 0; par < 2; ++par) {
                const unsigned a0 = vt_base + buf * 32768 + offa(vrow0, 2u * par + (p_o >> 1)) + 8u * (p_o & 1u);
                const unsigned a1 = vt_base + buf * 32768 + offa(vrow0 + 4u, 2u * par + (p_o >> 1)) + 8u * (p_o & 1u);
                bf16x8 vf[4]; tr4<0>(a0, a1, vf);
#pragma unroll
                for (int i = 0; i < 4; ++i) { oacc[0][par + 2 * i] = __builtin_amdgcn_mfma_f32_16x16x32_bf16(vf[i], pf[0][0], oacc[0][par + 2 * i], 0, 0, 0);
                                              oacc[1][par + 2 * i] = __builtin_amdgcn_mfma_f32_16x16x32_bf16(vf[i], pf[1][0], oacc[1][par + 2 * i], 0, 0, 0); }
            }
        };
        block32(0u, false, true, true);
        block32(32u, false, true, true);
    }
#undef NA_TILE_HEAD
#undef NA_SOFTMAX
#pragma unroll
    for (int qt = 0; qt < 2; ++qt) {
        float lt = lrun[qt]; lt += __shfl_xor(lt, 16); lt += __shfl_xor(lt, 32);
        const float inv = 1.0f / lt;
        bf16_t* op = OB + (size_t)qrow[qt] * D + 128 * h + 4 * fq;
#pragma unroll
        for (int dt = 0; dt < 8; ++dt) { const f32x4 o = oacc[qt][dt] * inv; *(u32x2*)(op + 16 * dt) = (u32x2){cvt_pk_bf16(o[0], o[1]), cvt_pk_bf16(o[2], o[3])}; }
    }
}

__device__ __forceinline__ void route_phase(const Ctx& cx, int l, int T, int dummy = 0) {
    const ArgView a = cx.av;
    const int lane = cx.lane, w = cx.wave, tid = cx.tid, fq = lane >> 4, fr = lane & 15;
    const bf16_t* xs = (const bf16_t*)(a.ws_() + WS_XS); bf16_t* hx = (bf16_t*)(a.ws_() + WS_HX); const bf16_t* WR = (const bf16_t*)(a.ws_() + (size_t)l * WSET_BYTES + WS_WR);
    const float* modl = (const float*)(a.ws_() + WS_CTL + CTL_MOD) + (size_t)l * 3 * 12288; const float* nw = a.in_(7) + (size_t)l * D;
    unsigned* cnt = (unsigned*)(a.ws_() + WS_CTL) + CW_CNT + 64 * l + 2048 * (dummy ? 1 : 0);
    int* re = (int*)(a.ws_() + WS_ROUTE + RT_E); float* rw = (float*)(a.ws_() + WS_ROUTE + RT_W); int* rpz = (int*)(a.ws_() + WS_ROUTE + RT_P);
    LAS int* lcnt = (LAS int*)(cx.lds + LDS_LCNT); LAS int* lbase = lcnt + 32;
    LAS float* red = (LAS float*)cx.lds;
    LAS float* lgS = (LAS float*)(cx.lds + 61440);
    if (tid < 32) lcnt[tid] = 0;
    const int bt0 = (int)((long)cx.bid * T / cx.G), bt1 = (int)((long)(cx.bid + 1) * T / cx.G), nb = bt1 - bt0;
    const int t0 = bt0 + w * nb / 8, t1 = bt0 + (w + 1) * nb / 8;
    if (dummy != 3) {
        f32x4 vA[8], vB[8]; int curcls = -1;
        for (int tok = t0; tok < t1; ++tok) {
            const int cls = tok < SEQ ? 0 : (tok < MLAT ? 1 : 2);
            if (cls != curcls) { curcls = cls; const float* mp = modl + cls * 12288;
#pragma unroll
                for (int j = 0; j < 8; ++j) { const int e = ROW_E(j); vA[j] = *(const f32x4*)(nw + e) * (*(const f32x4*)(mp + 4 * D + e) + 1.0f); vB[j] = *(const f32x4*)(mp + 3 * D + e); } }
            f32x4 v[8]; float ss = 0.f;
#pragma unroll
            for (int j = 0; j < 4; ++j) { const u32x4 r = __builtin_nontemporal_load((const u32x4*)(xs + (size_t)tok * D + 8 * (lane + 64 * j))); pg8::unpack8(r, v[2 * j], v[2 * j + 1]); }
#pragma unroll
            for (int j = 0; j < 8; ++j) ss += (v[j][0] * v[j][0] + v[j][1] * v[j][1]) + (v[j][2] * v[j][2] + v[j][3] * v[j][3]);
            const float rstd = 1.0f / sqrtf(wave_sum(ss) * (1.0f / D) + RMS_EPS);
#pragma unroll
            for (int j = 0; j < 4; ++j) *(u32x4*)(hx + (size_t)tok * D + 8 * (lane + 64 * j)) = pg8::pack8(v[2 * j] * rstd * vA[2 * j] + vB[2 * j], v[2 * j + 1] * rstd * vA[2 * j + 1] + vB[2 * j + 1]);
            if (I8SEL(MK_I8E, l)) {
                float hmax = 0.f;
#pragma unroll
                for (int j = 0; j < 8; ++j) { v[j] = v[j] * rstd * vA[j] + vB[j]; hmax = fmaxf(hmax, fmaxf(fmaxf(fabsf(v[j][0]), fabsf(v[j][1])), fmaxf(fabsf(v[j][2]), fabsf(v[j][3])))); }
#pragma unroll
                for (int o = 1; o < 64; o <<= 1) hmax = fmaxf(hmax, __shfl_xor(hmax, o));
                hmax = fmaxf(hmax, 1e-20f); const float inv = 127.0f / hmax;
                unsigned char* h8 = a.ws_() + WS_HX8 + (size_t)tok * D;
#pragma unroll
                for (int j = 0; j < 4; ++j) *(u32x2*)(h8 + 8 * (lane + 64 * j)) = (u32x2){pk4_i8(v[2 * j][0] * inv, v[2 * j][1] * inv, v[2 * j][2] * inv, v[2 * j][3] * inv), pk4_i8(v[2 * j + 1][0] * inv, v[2 * j + 1][1] * inv, v[2 * j + 1][2] * inv, v[2 * j + 1][3] * inv)};
                if (lane == 0) ((float*)(a.ws_() + WS_SX))[tok] = hmax * (1.0f / 127.0f);
            }
        }
    }
    VM_WAIT();
    __syncthreads();
    if (dummy != 2) {
        const int kq = w & 3, th = w >> 2, tile0 = th ? 3 : 0, ntl = th ? 2 : 3;
        const bf16_t* hp[3];
#pragma unroll
        for (int i = 0; i < 3; ++i) { const int tk = min(bt0 + 16 * (tile0 + i) + fr, bt1 - 1); hp[i] = hx + (size_t)tk * D + 512 * kq + 8 * fq; }
        const bf16_t* wp = WR + ((size_t)(16 * kq) * 64 + lane) * 8;
        f32x4 acc[3][3];
#pragma unroll
        for (int i = 0; i < 3; ++i)
#pragma unroll
            for (int mt = 0; mt < 3; ++mt) acc[i][mt] = (f32x4){0.f, 0.f, 0.f, 0.f};
        const int ksrot = cx.bid & 15;
#pragma unroll 4
        for (int ks0 = 0; ks0 < 16; ++ks0) { const int ks = (ks0 + ksrot) & 15;
            bf16x8 af[3], bfv[3];
#pragma unroll
            for (int mt = 0; mt < 3; ++mt) { const u32x4 t_ = *(const u32x4*)(wp + ((size_t)mt * 64 + ks) * 512); af[mt] = __builtin_bit_cast(bf16x8, t_); }
#pragma unroll
            for (int i = 0; i < 3; ++i) if (i < ntl) { const u32x4 t_ = *(const u32x4*)(hp[i] + 32 * ks); bfv[i] = __builtin_bit_cast(bf16x8, t_); }
#pragma unroll
            for (int i = 0; i < 3; ++i) if (i < ntl)
#pragma unroll
                for (int mt = 0; mt < 3; ++mt) acc[i][mt] = __builtin_amdgcn_mfma_f32_16x16x32_bf16(af[mt], bfv[i], acc[i][mt], 0, 0, 0);
        }
#pragma unroll
        for (int i = 0; i < 3; ++i) if (i < ntl)
#pragma unroll
            for (int mt = 0; mt < 3; ++mt) *(LAS f32x4*)(red + (((kq * 5 + tile0 + i) * 3 + mt) * 64 + lane) * 4) = acc[i][mt];
    }
    __syncthreads();
    for (int idx = tid; idx < 80 * 48; idx += NTHR) { const int ts = idx / 48, o = idx % 48, tile = ts >> 4, f_r = ts & 15, mt = o >> 4, r = o & 15, ln = (r >> 2) * 16 + f_r, rg = r & 3;
        float sum = 0.f;
#pragma unroll
        for (int kq = 0; kq < 4; ++kq) sum += red[(((kq * 5 + tile) * 3 + mt) * 64 + ln) * 4 + rg];
        lgS[idx] = sum; }
    __syncthreads();
    int e0 = 0, e1 = 0; float w0 = 0.f, w1 = 0.f; int p0 = 0, p1 = 0;
    if (tid < nb) {
        const float* bre = a.in_(21) + (size_t)l * NEXP; const float* brg = a.in_(19) + (size_t)l * 4;
        const LAS float* lg = lgS + tid * 48;
        float g[4]; int gi = 0; float gm = -INFINITY;
#pragma unroll
        for (int j = 0; j < 4; ++j) { g[j] = lg[32 + j] + brg[j]; if (g[j] > gm) { gm = g[j]; gi = j; } }
        float gs = 0.f;
#pragma unroll
        for (int j = 0; j < 4; ++j) { float ev = __expf(g[j] - gm); asm volatile("" : "+v"(ev)); gs += ev; }
        const float gp = __builtin_amdgcn_rcpf(gs);
        float v0 = -INFINITY, v1 = -INFINITY; int i0 = 0, i1 = 0;
        for (int j = 0; j < 8; ++j) { const float x = lg[8 * gi + j] + bre[8 * gi + j];
            if (x > v0) { v1 = v0; i1 = i0; v0 = x; i0 = j; } else if (x > v1) { v1 = x; i1 = j; } }
        float ex = __expf(v1 - v0); asm volatile("" : "+v"(ex)); const float den = __builtin_amdgcn_rcpf(1.0f + ex);
        e0 = 8 * gi + i0; e1 = 8 * gi + i1; w0 = gp * den; w1 = gp * ex * den;
        p0 = atomicAdd((int*)&lcnt[e0], 1); p1 = atomicAdd((int*)&lcnt[e1], 1);
    }
    __syncthreads();
    if (tid < 32) { const int c = lcnt[tid]; lbase[tid] = c ? (int)__hip_atomic_fetch_add(cnt + tid, (unsigned)c, __ATOMIC_RELAXED, __HIP_MEMORY_SCOPE_AGENT) : 0; }
    __syncthreads();
    if (tid < nb) { const int tok = bt0 + tid;
        re[tok] = e0; re[MALL + tok] = e1; rw[tok] = w0; rw[MALL + tok] = w1; rpz[tok] = lbase[e0] + p0; rpz[MALL + tok] = lbase[e1] + p1; }
    __syncthreads();
}

__device__ __forceinline__ void load_tprefix(const Ctx& cx, int l) {
    const unsigned* cnt = (const unsigned*)(cx.av.ws_() + WS_CTL) + CW_CNT + 64 * l;
    LAS int* tp = (LAS int*)(cx.lds + LDS_TP);
    if (cx.tid < 64) {
        const int c = cx.tid < 32 ? ((int)__hip_atomic_load(cnt + (cx.tid & 31), __ATOMIC_RELAXED, __HIP_MEMORY_SCOPE_AGENT) + 255) >> 8 : 0;
        int v = c;
#pragma unroll
        for (int o = 1; o < 32; o <<= 1) { const int t = __shfl_up(v, o); if ((int)cx.lane >= o) v += t; }
        if (cx.tid < 32) tp[cx.tid] = v - c;
        if (cx.tid == 31) tp[32] = v;
    }
    __syncthreads();
}
__device__ __forceinline__ void dispatch_phase(const Ctx& cx, int l, int T) {
    const ArgView a = cx.av;
    const int lane = cx.lane;
    const unsigned* cnt = (const unsigned*)(a.ws_() + WS_CTL) + CW_CNT + 64 * l;
    const LAS int* tp = (const LAS int*)(cx.lds + LDS_TP);
    const int* re = (const int*)(a.ws_() + WS_ROUTE + RT_E); const float* rw = (const float*)(a.ws_() + WS_ROUTE + RT_W); const int* rpz = (const int*)(a.ws_() + WS_ROUTE + RT_P);
    int* tokslot = (int*)(a.ws_() + WS_ROUTE + RT_TS); float* wslot = (float*)(a.ws_() + WS_ROUTE + RT_WS);
    const int gw = cx.bid * NWAVES + cx.wave, NGW = cx.G * NWAVES;
    const int t0 = (int)((long)gw * T / NGW), t1 = (int)((long)(gw + 1) * T / NGW);
    for (int tok = t0 + lane; tok < t1; tok += 64) {
        const int ea = re[tok], eb = re[MALL + tok];
        const int sa = 256 * tp[ea] + rpz[tok], sb = 256 * tp[eb] + rpz[MALL + tok];
        tokslot[sa] = 2 * tok; tokslot[sb] = 2 * tok + 1; wslot[sa] = rw[tok]; wslot[sb] = rw[MALL + tok];
    }
    {
        const int e = gw & 31, sub = gw >> 5, nsub = NGW >> 5;
        const int c = (int)__hip_atomic_load(cnt + e, __ATOMIC_RELAXED, __HIP_MEMORY_SCOPE_AGENT), base = 256 * tp[e], padn = (256 - (c & 255)) & 255;
        for (int j = sub + nsub * lane; j < padn; j += 64 * nsub) { const int s = base + c + j; tokslot[s] = -1; wslot[s] = 0.f; }
    }
}
__device__ __forceinline__ void copy_x_phase(const Ctx& cx, int l, int T) {
    const ArgView a = cx.av; if (l != 0) return;
    bf16_t* xs = (bf16_t*)(a.ws_() + WS_XS);
    for (size_t i = (size_t)cx.bid * NTHR + cx.tid; i < (size_t)T * D / 4; i += (size_t)cx.G * NTHR) {
        const size_t e = i * 4; const float* src = e < (size_t)MLAT * D ? a.in_(0) + e : a.in_(2) + (e - (size_t)MLAT * D);
        const f32x4 v = *(const f32x4*)src; *(u32x2*)(xs + e) = (u32x2){cvt_pk_bf16(v[0], v[1]), cvt_pk_bf16(v[2], v[3])}; }
}

__global__ void __launch_bounds__(NTHR, 2) fwd_kernel(Args args) {
    extern __shared__ __attribute__((aligned(16))) unsigned char lds_raw[];
    Ctx cx; cx.lds = (LAS unsigned char*)lds_raw; cx.tid = threadIdx.x; cx.lane = cx.tid & 63; cx.wave = __builtin_amdgcn_readfirstlane(cx.tid >> 6); cx.G = gridDim.x; cx.bid = blockIdx.x;
    cx.av.kp = (const CAS unsigned char*)__builtin_amdgcn_kernarg_segment_ptr();
#define FRESH() do { int t_ = threadIdx.x; asm volatile("" : "+v"(t_)); cx.tid = t_; cx.lane = t_ & 63; cx.wave = __builtin_amdgcn_readfirstlane(t_ >> 6); \
        const CAS unsigned char* k_ = (const CAS unsigned char*)__builtin_amdgcn_kernarg_segment_ptr(); asm volatile("" : "+s"(k_)); cx.av.kp = k_; \
        int g_ = gridDim.x; asm volatile("" : "+s"(g_)); cx.G = g_; int b_ = blockIdx.x; asm volatile("" : "+s"(b_)); cx.bid = b_; } while (0)
    for (int u = cx.tid; u < (LDS_BYTES - LDSCTL_OFF) / 4; u += NTHR) ((LAS unsigned*)(cx.lds + LDSCTL_OFF))[u] = 0u;
    __syncthreads();
    XcdBarrier bar; bar.bar = (unsigned*)(args.ws + WS_CTL) + CW_BAR; bar.x = 0; bar.st = nullptr;
    if (!MK_PER_PHASE) bar = xcd_barrier_post((unsigned*)(args.ws + WS_CTL) + CW_BAR, (volatile LAS unsigned*)(cx.lds + LDS_MISC));
    const int lo = args.ph_lo, hi = args.ph_hi;
#define IN(k) (lo <= (k) && (k) < hi)
#define SEAM(k) do { if (IN(k) && IN((k) + 1)) xcd_barrier(bar); } while (0)

    if (IN(0)) for (int rep = 0; rep < DUPN(0); ++rep) { FRESH(); if (MK_BUILD & 1) p0_adaln(cx); if (MK_BUILD & 2) pw_convert0(cx); __syncthreads(); }
    SEAM(0);
    for (int l = 0; l < 2; ++l) {
        const int pb = 1 + 9 * l;
        const bool mix_on = (MK_MASK >> (2 * l)) & 1, moe_on = (MK_MASK >> (2 * l + 1)) & 1;
        const int Mact = l == 0 ? MALL : MLAT;
        if (IN(pb + 0)) { FRESH(); if (MK_BUILD & 4) { if (l == 0) { for (int rep = 0; rep < DUPN(1); ++rep) norm_phase<0>(cx, MALL); if ((MK_I8GATE != 0) && ((MK_BUILD & 2) != 0)) { __syncthreads(); conv_gate0(cx); } } else { norm_phase<1>(cx, MALL); __syncthreads(); if ((MK_BUILD & 2) && CQ_F0 < CV_EXP + CV_DENSE) conv_range(cx, CQ_F0, CV_EXP + CV_DENSE, cx.bid, cx.G); } } }
        SEAM(pb + 0);
        if ((MK_BUILD & 0x38) && IN(pb + 1) && mix_on) { FRESH();
            unsigned char* ws = cx.av.ws_();
            unsigned* pdone = (unsigned*)(ws + WS_CTL) + CW_PD8 + 128 * l; unsigned* qhead = (unsigned*)(ws + WS_CTL) + CW_QB + 64 * l;
            const int Gg = gemm_wgs((MALL / 256) * (NCOMB / 256), cx.G);
            if (cx.bid < Gg) {
            if (MK_I8GATE) {
                if (MK_I8IN) { pg8::Gemm g{(const bf16_t*)(ws + WS_HX8), D / 2, (const bf16_t*)(ws + (size_t)l * WSET_BYTES + WS_WC), 0, D / 2}; pg8::StaticOrder S; S.init(MALL, INW, Gg, cx.bid);
                  const float amax_in = __uint_as_float(__hip_atomic_load((const unsigned*)(ws + WS_CTL) + CW_GMAX + 2 + l, __ATOMIC_RELAXED, __HIP_MEMORY_SCOPE_AGENT));
                  pg8::EpiInProj E{(bf16_t*)(ws + WS_P), (bf16_t*)(ws + WS_G), cx.av.in_(14) + (size_t)l * GATEW, (const f32x2*)(ws + WS_ROPE), pdone, (const float*)(ws + WS_SX), amax_in * (1.0f / 127.0f)};
                  pg8::gemm_phase<pg8::EpiInProj, pg8::StaticOrder, false, true>(cx.lds, g, S, E); }
                else { pg8::Gemm g{(const bf16_t*)(ws + WS_HX), D, (const bf16_t*)(ws + (size_t)l * WSET_BYTES + WS_WC), 0, D}; pg8::StaticOrder S; S.init(MALL, INW, Gg, cx.bid);
                  pg8::EpiInProj E{(bf16_t*)(ws + WS_P), (bf16_t*)(ws + WS_G), cx.av.in_(14) + (size_t)l * GATEW, (const f32x2*)(ws + WS_ROPE), pdone, nullptr, 0.f};
                  pg8::gemm_phase(cx.lds, g, S, E); }
                { FRESH(); unsigned char* ws2 = cx.av.ws_();
                  pg8::Gemm g{(const bf16_t*)(ws2 + WS_HX8), D / 2, (const bf16_t*)(ws2 + (size_t)l * WSET_BYTES + WS_WC + (size_t)INW * D * 2), 0, D / 2}; pg8::StaticOrder S; S.init(MALL, GATEW, Gg, cx.bid);
                  const float amax = __uint_as_float(__hip_atomic_load((const unsigned*)(ws2 + WS_CTL) + CW_GMAX + l, __ATOMIC_RELAXED, __HIP_MEMORY_SCOPE_AGENT));
                  pg8::EpiGate8 E{(bf16_t*)(ws2 + WS_G), cx.av.in_(14) + (size_t)l * GATEW, (const float*)(ws2 + WS_SX), amax * (1.0f / 127.0f)};
                  pg8::gemm_phase<pg8::EpiGate8, pg8::StaticOrder, false, true>(cx.lds, g, S, E); }
            } else {
            pg8::Gemm g{(const bf16_t*)(ws + WS_HX), D, (const bf16_t*)(ws + (size_t)l * WSET_BYTES + WS_WC), 0, D}; pg8::SplitOrder S; S.init(MALL, INW, GATEW, Gg, cx.bid);
            pg8::EpiInProj E{(bf16_t*)(ws + WS_P), (bf16_t*)(ws + WS_G), cx.av.in_(14) + (size_t)l * GATEW, (const f32x2*)(ws + WS_ROPE), pdone, nullptr, 0.f};
            pg8::gemm_phase(cx.lds, g, S, E); } }
            if (MK_BUILD & 2) { FRESH(); if (l == 0) conv_side(cx, Gg, 0, CQ_A0); else conv_side(cx, Gg, CQ_F0 > CV_EXP + CV_DENSE ? CQ_F0 : CV_EXP + CV_DENSE, CQ_A1); __syncthreads(); }
            FRESH();
            if (cx.wave == 0) {
                const unsigned need = (unsigned)((MALL / 256) * (INW / 256)); unsigned sp = 0;
                for (;;) { const unsigned v_ = cx.lane < NWAVES ? __hip_atomic_load(pdone + 16 * (cx.lane & 7), __ATOMIC_RELAXED, __HIP_MEMORY_SCOPE_AGENT) : need;
                    if (__builtin_amdgcn_ballot_w64(v_ < need) == 0ull) break; __builtin_amdgcn_s_sleep(2); if (++sp > XB_SPIN_CAP) break; }
                __builtin_amdgcn_fence(__ATOMIC_ACQUIRE, "agent");
                asm volatile("s_waitcnt vmcnt(0)" ::: "memory");
            }
            __syncthreads();
            const int n_na = 512, n_sgu = 256, n_cna = (l == 0 ? 16 : 0), n_csg = (l == 0 ? 32 : 0), n_items = n_na + n_sgu + n_cna + n_csg;
            LAS int* qslot = (LAS int*)(cx.lds + LDS_MISC + 64);
            for (;;) {
                if (cx.tid == 0) qslot[0] = (int)__hip_atomic_fetch_add(qhead, 1u, __ATOMIC_RELAXED, __HIP_MEMORY_SCOPE_AGENT);
                __syncthreads();
                const int it = qslot[0];
                __syncthreads();
                if (it >= n_items) break;
                FRESH();
                const bool is_na = it < n_na || (it >= n_na + n_sgu && it < n_na + n_sgu + n_cna);
                const int id = it < n_na ? it : (it < n_na + n_sgu ? it - n_na : (it < n_na + n_sgu + n_cna ? 512 + (it - n_na - n_sgu) : 256 + (it - n_na - n_sgu - n_cna)));
                if (is_na) na_item2(cx, l, id); else sgu_item(cx, l, id);
                __syncthreads();
            }
        }
        SEAM(pb + 2);
        if ((MK_BUILD & 0x40) && IN(pb + 3) && mix_on) for (int rep = 0; rep < DUPN(4); ++rep) {
            FRESH(); unsigned char* ws = cx.av.ws_();
            const bool i8m = I8SEL(MK_I8M, l);
            if (i8m) {
                const unsigned* ctl = (const unsigned*)(ws + WS_CTL);
                const float swa = __uint_as_float(ctl[CW_GMAX + 6 + 2 * l]) * (1.0f / 127.0f), swb = __uint_as_float(ctl[CW_GMAX + 7 + 2 * l]) * (1.0f / 127.0f);
                quant_rows_ao(cx, (const bf16_t*)(ws + WS_A), ws + WS_HX8, (float*)(ws + WS_SX), (float*)(ws + WS_SX) + MALL, swa, swb, Mact);
                VM_WAIT(); xcd_barrier(bar); FRESH(); ws = cx.av.ws_(); }
            const int Gg = gemm_wgs((Mact / 256) * (D / 256), cx.G);
            if (cx.bid < Gg) {
            pg8::StaticOrder S; S.init(Mact, D, Gg, cx.bid);
            if (i8m) {
                pg8::Gemm g{(const bf16_t*)(ws + WS_HX8), D / 2, (const bf16_t*)(ws + (size_t)l * WSET_BYTES + WS_WA), 0, D / 2};
                pg8::EpiMergeI8 E{(bf16_t*)(ws + WS_T), (const bf16_t*)(ws + WS_G), (const float*)(ws + WS_SX), (const float*)(ws + WS_SX) + MALL};
                pg8::gemm_phase<pg8::EpiMergeI8, pg8::StaticOrder, false, true>(cx.lds, g, S, E);
            } else {
            pg8::Gemm g{(const bf16_t*)(ws + WS_A), D, (const bf16_t*)(ws + (size_t)l * WSET_BYTES + WS_WA), 0, D};
            pg8::EpiMergeF E{(bf16_t*)(ws + WS_T), (const bf16_t*)(ws + WS_G)}; pg8::gemm_phase(cx.lds, g, S, E); } }
            if (l == 0 && (MK_BUILD & 2)) { FRESH(); conv_side(cx, Gg, CQ_A0, CQ_C1B); __syncthreads(); }
        }
        SEAM(pb + 3);
        if (IN(pb + 4)) for (int rep = 0; rep < (l == 0 ? DUPN(5) : 1); ++rep) { FRESH();
            if ((MK_BUILD & 0x80) && mix_on) {
                unsigned char* ws = cx.av.ws_(); bf16_t* XS = (bf16_t*)(ws + WS_XS);
                const int Gg = gemm_wgs((Mact / 256) * (D / 256), cx.G);
                const bool i8o = I8SEL(MK_I8O, l);
                if (i8o) {
                    quant_rows2048(cx, (const bf16_t*)(ws + WS_T), ws + WS_HX8, (float*)(ws + WS_SX), Mact);
                    VM_WAIT(); xcd_barrier(bar); FRESH(); ws = cx.av.ws_(); XS = (bf16_t*)(ws + WS_XS); }
                if (cx.bid < Gg) {
                pg8::StaticOrder S; S.init(Mact, D, Gg, cx.bid);
                const float* modl_ = (const float*)(ws + WS_CTL + CTL_MOD) + (size_t)l * 3 * 12288;
                if (i8o) {
                    pg8::Gemm g{(const bf16_t*)(ws + WS_HX8), D / 2, (const bf16_t*)(ws + (size_t)l * WSET_BYTES + WS_WO), 0, D / 2};
                    const float sw = __uint_as_float(((const unsigned*)(ws + WS_CTL))[CW_GMAX + 4 + l]) * (1.0f / 127.0f); const float* sx = (const float*)(ws + WS_SX);
                    if (l == 0) { pg8::EpiOut<true> E{cx.av.in_(0), cx.av.in_(2), XS, modl_, sx, sw}; pg8::gemm_phase<pg8::EpiOut<true>, pg8::StaticOrder, false, true>(cx.lds, g, S, E); }
                    else { pg8::EpiOut<false> E{nullptr, nullptr, XS, modl_, sx, sw}; pg8::gemm_phase<pg8::EpiOut<false>, pg8::StaticOrder, false, true>(cx.lds, g, S, E); }
                } else {
                pg8::Gemm g{(const bf16_t*)(ws + WS_T), D, (const bf16_t*)(ws + (size_t)l * WSET_BYTES + WS_WO), 0, D};
                if (l == 0) { pg8::EpiOut<true> E{cx.av.in_(0), cx.av.in_(2), XS, modl_, nullptr, 0.f}; pg8::gemm_phase(cx.lds, g, S, E); }
                else { pg8::EpiOut<false> E{nullptr, nullptr, XS, modl_, nullptr, 0.f}; pg8::gemm_phase(cx.lds, g, S, E); } } }
                if (l == 0 && (MK_BUILD & 2)) { FRESH(); conv_side(cx, Gg, CQ_C1B, CQ_C2); __syncthreads(); }
            } else copy_x_phase(cx, l, Mact);
        }
        SEAM(pb + 4);
        if ((MK_BUILD & 0x100) && IN(pb + 5) && moe_on) { if (MK_DUP & 0x400) { FRESH(); route_phase(cx, l, Mact, 1 + ((MK_DUP >> 13) & 3)); __syncthreads(); } FRESH(); route_phase(cx, l, Mact); }
        SEAM(pb + 5);
        if ((MK_BUILD & 0x200) && IN(pb + 6) && moe_on) for (int rep = 0; rep < DUPN(6); ++rep) { FRESH(); load_tprefix(cx, l); dispatch_phase(cx, l, Mact); __syncthreads(); if (l == 1 && (MK_BUILD & 2)) conv_range(cx, CQ_A1, CQ_TOTAL, cx.bid, cx.G); }
        SEAM(pb + 6);
        if ((MK_BUILD & 0x400) && IN(pb + 7) && moe_on) for (int rep = 0; rep < DUPN(7); ++rep) { FRESH();
            load_tprefix(cx, l); unsigned char* ws = cx.av.ws_();
            const int Gg = gemm_wgs(((const LAS int*)(cx.lds + LDS_TP))[32] * (1024 / 256), cx.G);
            if (cx.bid < Gg) {
            pg8::GroupedOrder S; S.init((const LAS int*)(cx.lds + LDS_TP), 1024, Gg, cx.bid);
            if (I8SEL(MK_I8E, l)) {
                pg8::Gemm g{(const bf16_t*)(ws + WS_HX8), D / 2, (const bf16_t*)(ws + (size_t)l * WSET_BYTES + WS_WGU), (size_t)1024 * D / 2, D / 2};
                pg8::EpiGateUp8 E{(bf16_t*)(ws + WS_HID), (const int*)(ws + WS_ROUTE + RT_TS), (const float*)(ws + WS_SX), (const unsigned*)(ws + WS_CTL) + CW_EMAX + 64 * l};
                pg8::gemm_phase<pg8::EpiGateUp8, pg8::GroupedOrder, true, true>(cx.lds, g, S, E, (const int*)(ws + WS_ROUTE + RT_TS));
            } else {
            pg8::Gemm g{(const bf16_t*)(ws + WS_HX)  , D, (const bf16_t*)(ws + (size_t)l * WSET_BYTES + WS_WGU), (size_t)1024 * D, D};
            pg8::EpiGateUp E{(bf16_t*)(ws + WS_HID)};
            pg8::gemm_phase<pg8::EpiGateUp, pg8::GroupedOrder, true>(cx.lds, g, S, E, (const int*)(ws + WS_ROUTE + RT_TS)); } }
            if (l == 0 && (MK_BUILD & 2)) { FRESH(); conv_side(cx, Gg, CQ_C2, CQ_E0); __syncthreads(); }
        }
        SEAM(pb + 7);
        if ((MK_BUILD & 0x800) && IN(pb + 8) && moe_on) for (int rep = 0; rep < DUPN(8); ++rep) { FRESH();
            load_tprefix(cx, l); unsigned char* ws = cx.av.ws_();
            const bool i8d = I8SEL(MK_I8D, l);
            if (i8d) {
                quant_rows512(cx, (const bf16_t*)(ws + WS_HID), ws + WS_T, (float*)(ws + WS_T + ((size_t)32 << 20)), (const float*)(ws + WS_ROUTE + RT_WS), ((const LAS int*)(cx.lds + LDS_TP))[32] * 256);
                VM_WAIT(); xcd_barrier(bar); FRESH(); ws = cx.av.ws_(); }
            const int Gg = gemm_wgs(((const LAS int*)(cx.lds + LDS_TP))[32] * (D / 256), cx.G);
            if (cx.bid < Gg) {
            pg8::GroupedOrder S; S.init((const LAS int*)(cx.lds + LDS_TP), D, Gg, cx.bid);
            if (i8d) {
                int kk = DEXP / 2; asm volatile("" : "+s"(kk));
                pg8::Gemm g{(const bf16_t*)(ws + WS_T), kk, (const bf16_t*)(ws + (size_t)l * WSET_BYTES + WS_WD), (size_t)D * DEXP / 2, kk};
                pg8::EpiDown<true> E{(bf16_t*)(ws + WS_G)  , (const int*)(ws + WS_ROUTE + RT_TS), (const float*)(ws + WS_T + ((size_t)32 << 20)), (const unsigned*)(ws + WS_CTL) + CW_DMAX + 32 * l};
                pg8::gemm_phase<pg8::EpiDown<true>, pg8::GroupedOrder, false, true>(cx.lds, g, S, E);
            } else {
            pg8::Gemm g{(const bf16_t*)(ws + WS_HID), DEXP, (const bf16_t*)(ws + (size_t)l * WSET_BYTES + WS_WD), (size_t)D * DEXP, DEXP};
            pg8::EpiDown<false> E{(bf16_t*)(ws + WS_G)  , (const int*)(ws + WS_ROUTE + RT_TS), (const float*)(ws + WS_ROUTE + RT_WS), nullptr};
            pg8::gemm_phase(cx.lds, g, S, E); } }
            if (l == 0 && (MK_BUILD & 2)) { FRESH(); conv_side(cx, Gg, CQ_E0, CQ_F0); __syncthreads(); }
        }
        SEAM(pb + 8);
    }
    if ((MK_BUILD & 0x1000) && IN(19)) for (int rep = 0; rep < DUPN(9); ++rep) { FRESH(); norm_phase<2>(cx, MLAT); }
#undef IN
#undef SEAM
#undef FRESH
}

extern "C" void kernel_launch(void* const* d_in, const int* in_sizes, int n_in, void* d_out, int out_size, void* d_ws, size_t ws_size, hipStream_t stream) {
    static int grid = 0;
    if (grid == 0) {
        if (n_in != 26 || out_size != MLAT * D || ws_size < WS_END) { fprintf(stderr, "kernel_launch: unexpected problem (n_in %d, out %d, ws %zu < %zu)\n", n_in, out_size, ws_size, (size_t)WS_END); grid = -1; return; }
        int dev = 0, cus = 0, per_cu = 0;
        if (hipGetDevice(&dev) != hipSuccess || hipDeviceGetAttribute(&cus, hipDeviceAttributeMultiprocessorCount, dev) != hipSuccess) { grid = -1; return; }
        if (hipFuncSetAttribute((const void*)fwd_kernel, hipFuncAttributeMaxDynamicSharedMemorySize, LDS_BYTES) != hipSuccess) { fprintf(stderr, "kernel_launch: hipFuncSetAttribute failed\n"); grid = -1; return; }
        if (hipOccupancyMaxActiveBlocksPerMultiprocessor(&per_cu, (const void*)fwd_kernel, NTHR, LDS_BYTES) != hipSuccess || per_cu < 1) { fprintf(stderr, "kernel_launch: occupancy query says %d\n", per_cu); }
        (void)hipGetLastError();
        grid = cus;
    }
    if (grid < 0) return;
    (void)hipMemsetAsync((char*)d_ws + WS_CTL, 0, 65536, stream);
    Args a{};
    for (int i = 0; i < 26; ++i) a.in[i] = (const float*)d_in[i];
    a.out = (float*)d_out; a.ws = (unsigned char*)d_ws;
#if MK_PER_PHASE
    for (int p = 0; p < NPHASE; ++p) { a.ph_lo = p; a.ph_hi = p + 1; hipLaunchKernelGGL(fwd_kernel, dim3(grid), dim3(NTHR), LDS_BYTES, stream, a); }
#else
    a.ph_lo = 0; a.ph_hi = NPHASE; hipLaunchKernelGGL(fwd_kernel, dim3(grid), dim3(NTHR), LDS_BYTES, stream, a);
#endif
}
```
